# Optimizing an MI355X kernel written in HIP

```python
import jax
import jax.numpy as jnp
from jax import lax
import numpy as np

D_MODEL = 1024
BATCH = 8
SEQ = 8192
DEPTH = 2

GRID_W = 64
CTX_LEN = 256
CHUNK = 128
NORM_EPS = 1e-6
ROPE_BASE = 10000.0

GLA_HEADS = 4
GLA_K = D_MODEL // 2
GLA_V = D_MODEL
GLA_DK = GLA_K // GLA_HEADS
GLA_DV = GLA_V // GLA_HEADS
GLA_LOW_RANK = 16
GLA_TAU = 16.0

ATT_HEAD_DIM = 128
ATT_Q_HEADS = D_MODEL // ATT_HEAD_DIM
ATT_KV_HEADS = 2
ATT_WINDOW = 128
ATT_QBLOCK = 128

RET_HEADS = 4
RET_K = D_MODEL // 2
RET_V = D_MODEL
RET_DK = RET_K // RET_HEADS
RET_DV = RET_V // RET_HEADS

MOE_GROUPS = 4
MOE_EXPERTS_PER_GROUP = 8
MOE_EXPERTS = MOE_GROUPS * MOE_EXPERTS_PER_GROUP
MOE_TOP_K = 2
MOE_HIDDEN = D_MODEL
MOE_BLOCK = 256

IN_LAYOUT = (
    ('gla_q', GLA_K), ('gla_k', GLA_K), ('gla_v', GLA_V), ('gla_r', GLA_V), ('gla_lr', 2 * GLA_LOW_RANK),
    ('att_q', ATT_Q_HEADS * ATT_HEAD_DIM), ('att_k', ATT_KV_HEADS * ATT_HEAD_DIM), ('att_v', ATT_KV_HEADS * ATT_HEAD_DIM),
    ('ret_q', RET_K), ('ret_k', RET_K), ('ret_v', RET_V), ('ret_g', RET_V),
    ('gates', 3 * D_MODEL),
)
N_IN = (2 * GLA_K + 2 * GLA_V + 2 * GLA_LOW_RANK + ATT_Q_HEADS * ATT_HEAD_DIM + 2 * ATT_KV_HEADS * ATT_HEAD_DIM
        + 2 * RET_K + 2 * RET_V + 3 * D_MODEL)

kernel_name = 'hybrid_gla_swa_retention_hmoe_dit'


def rms_norm(x, g):
    x32 = x.astype(jnp.float32)
    y = x32 * lax.rsqrt(jnp.mean(x32 * x32, axis=-1, keepdims=True) + NORM_EPS)
    return y.astype(x.dtype) * g


def head_group_norm(y, g):
    b, t, h, dv = y.shape
    y32 = y.astype(jnp.float32)
    mu = jnp.mean(y32, axis=-1, keepdims=True)
    var = jnp.mean(jnp.square(y32 - mu), axis=-1, keepdims=True)
    yn = ((y32 - mu) * lax.rsqrt(var + NORM_EPS)).astype(y.dtype)
    return yn.reshape(b, t, h * dv) * g


def rope(x, pos):
    half = x.shape[-1] // 2
    inv_freq = ROPE_BASE ** (-jnp.arange(half, dtype=jnp.float32) / half)
    ang = pos.astype(jnp.float32)[:, None] * inv_freq[None, :]
    cos = jnp.cos(ang)[:, None, :].astype(x.dtype)
    sin = jnp.sin(ang)[:, None, :].astype(x.dtype)
    x1, x2 = x[..., :half], x[..., half:]
    return jnp.concatenate([x1 * cos - x2 * sin, x2 * cos + x1 * sin], axis=-1)


def axial_rope(x, rows, cols):
    h = x.shape[-1] // 2
    return jnp.concatenate([rope(x[..., :h], rows), rope(x[..., h:], cols)], axis=-1)


def chunk_recurrence(q, k, v, log_a, s0, strict):
    b_, t_, h_, dk = q.shape
    dv = v.shape[-1]
    n = t_ // CHUNK
    f32 = jnp.float32
    qc = q.astype(f32).reshape(b_, n, CHUNK, h_, dk)
    kc = k.astype(f32).reshape(b_, n, CHUNK, h_, dk)
    vc = v.astype(f32).reshape(b_, n, CHUNK, h_, dv)
    cum = jnp.cumsum(log_a.astype(f32).reshape(b_, n, CHUNK, h_, dk), axis=2)
    cum_last = cum[:, :, -1:]
    q_in = qc * jnp.exp(cum)
    k_in = kc * jnp.exp(-cum)
    k_out = kc * jnp.exp(cum_last - cum)
    idx = jnp.arange(CHUNK)
    mask = (idx[:, None] > idx[None, :]) if strict else (idx[:, None] >= idx[None, :])
    scores = jnp.where(mask, jnp.einsum('bnihd,bnjhd->bnhij', q_in, k_in), 0.0)
    o_intra = jnp.einsum('bnhij,bnjhe->bnihe', scores, vc)

    def step(s, xs):
        q_i, k_o, v_i, dec = xs
        o = jnp.einsum('bihd,bhde->bihe', q_i, s)
        s = s * dec[..., None] + jnp.einsum('bjhd,bjhe->bhde', k_o, v_i)
        return s, o

    xs = (jnp.moveaxis(q_in, 1, 0), jnp.moveaxis(k_out, 1, 0), jnp.moveaxis(vc, 1, 0),
          jnp.moveaxis(jnp.exp(cum_last[:, :, 0]), 1, 0))
    s_fin, o_inter = lax.scan(step, s0.astype(f32), xs)
    o = o_intra + jnp.moveaxis(o_inter, 0, 1)
    return o.reshape(b_, t_, h_, dv).astype(v.dtype), s_fin


def bidirectional_scan(q, k, v, la_fwd, la_bwd, n_ctx):
    b_, _, h_, dk = q.shape
    dv = v.shape[-1]
    la_fwd = jnp.broadcast_to(la_fwd, q.shape)
    la_bwd = jnp.broadcast_to(la_bwd, q.shape)
    s0 = jnp.zeros((b_, h_, dk, dv), jnp.float32)
    rev = lambda a: jnp.flip(a, axis=1)
    oc_f, sc_f = chunk_recurrence(q[:, :n_ctx], k[:, :n_ctx], v[:, :n_ctx], la_fwd[:, :n_ctx], s0, False)
    ol_f, _ = chunk_recurrence(q[:, n_ctx:], k[:, n_ctx:], v[:, n_ctx:], la_fwd[:, n_ctx:], sc_f, False)
    oc_b, sc_b = chunk_recurrence(rev(q[:, :n_ctx]), rev(k[:, :n_ctx]), rev(v[:, :n_ctx]), rev(la_bwd[:, :n_ctx]), s0, True)
    ol_b, _ = chunk_recurrence(rev(q[:, n_ctx:]), rev(k[:, n_ctx:]), rev(v[:, n_ctx:]), rev(la_bwd[:, n_ctx:]), sc_b, True)
    return jnp.concatenate([oc_f + rev(oc_b), ol_f + rev(ol_b)], axis=1)


def window_attention(q_lat, k_lat, v_lat, q_ctx, k_ctx, v_ctx, sink, with_ctx_queries):
    b_, l_, hq, hd = q_lat.shape
    g_ = hq // ATT_KV_HEADS
    c_ = k_ctx.shape[1]
    nb = l_ // ATT_QBLOCK
    span = ATT_QBLOCK + 2 * ATT_WINDOW
    scale = hd ** -0.5
    pad = ((0, 0), (ATT_WINDOW, ATT_WINDOW), (0, 0), (0, 0))
    k_pad = jnp.pad(k_lat, pad)
    v_pad = jnp.pad(v_lat, pad)
    sink_logit = sink.astype(jnp.float32).reshape(1, ATT_KV_HEADS, g_, 1, 1)
    q_blocks = jnp.moveaxis(q_lat.reshape(b_, nb, ATT_QBLOCK, ATT_KV_HEADS, g_, hd), 1, 0)

    def attend_block(args):
        qb, n = args
        start = n * ATT_QBLOCK
        kw = lax.dynamic_slice_in_dim(k_pad, start, span, axis=1)
        vw = lax.dynamic_slice_in_dim(v_pad, start, span, axis=1)
        q_pos = start + jnp.arange(ATT_QBLOCK)
        k_pos = start - ATT_WINDOW + jnp.arange(span)
        valid = ((jnp.abs(q_pos[:, None] - k_pos[None, :]) <= ATT_WINDOW)
                 & (k_pos >= 0)[None, :] & (k_pos < l_)[None, :])
        s_loc = jnp.where(valid, jnp.einsum('bqhgd,bkhd->bhgqk', qb, kw).astype(jnp.float32) * scale, -jnp.inf)
        s_ctx = jnp.einsum('bqhgd,bkhd->bhgqk', qb, k_ctx).astype(jnp.float32) * scale
        s_sink = jnp.broadcast_to(sink_logit, s_ctx.shape[:-1] + (1,))
        p = jax.nn.softmax(jnp.concatenate([s_sink, s_ctx, s_loc], axis=-1), axis=-1).astype(qb.dtype)
        return (jnp.einsum('bhgqk,bkhd->bqhgd', p[..., 1:1 + c_], v_ctx)
                + jnp.einsum('bhgqk,bkhd->bqhgd', p[..., 1 + c_:], vw))

    o_lat = lax.map(attend_block, (q_blocks, jnp.arange(nb)))
    o_lat = jnp.moveaxis(o_lat, 0, 1).reshape(b_, l_, hq * hd)
    if not with_ctx_queries:
        return o_lat
    qc = q_ctx.reshape(b_, c_, ATT_KV_HEADS, g_, hd)
    s = jnp.einsum('bqhgd,bkhd->bhgqk', qc, k_ctx).astype(jnp.float32) * scale
    s_sink = jnp.broadcast_to(sink_logit, s.shape[:-1] + (1,))
    p = jax.nn.softmax(jnp.concatenate([s_sink, s], axis=-1), axis=-1)[..., 1:].astype(q_ctx.dtype)
    o_ctx = jnp.einsum('bhgqk,bkhd->bqhgd', p, v_ctx).reshape(b_, c_, hq * hd)
    return jnp.concatenate([o_ctx, o_lat], axis=1)


def token_mixers(h, n_ctx, rows, cols, ret_pos, ret_log_decay, w_in, gla_wa2, gla_ba, gla_norm_g, attn_sink,
                 ret_norm_g, w_br_gla, w_br_attn, w_br_ret, w_out, latent_only):
    t0 = n_ctx if latent_only else 0
    offsets = {}
    start = 0
    for name, width in IN_LAYOUT:
        offsets[name] = (start, start + width)
        start += width

    def proj(name, hh):
        lo, hi = offsets[name]
        return hh @ w_in[:, lo:hi]

    def heads(a, n):
        return a.reshape(a.shape[0], a.shape[1], n, -1)

    h_out = h[:, t0:]

    lr_f, lr_b = jnp.split(proj('gla_lr', h), 2, axis=-1)
    la_f = jax.nn.log_sigmoid((lr_f @ gla_wa2[0] + gla_ba[0]).astype(jnp.float32)) / GLA_TAU
    la_b = jax.nn.log_sigmoid((lr_b @ gla_wa2[1] + gla_ba[1]).astype(jnp.float32)) / GLA_TAU
    o_gla = bidirectional_scan(heads(proj('gla_q', h), GLA_HEADS) * GLA_DK ** -0.5, heads(proj('gla_k', h), GLA_HEADS),
                               heads(proj('gla_v', h), GLA_HEADS), heads(la_f, GLA_HEADS), heads(la_b, GLA_HEADS), n_ctx)
    y_gla = head_group_norm(o_gla[:, t0:], gla_norm_g) * jax.nn.silu(proj('gla_r', h_out))

    aq = heads(proj('att_q', h), ATT_Q_HEADS)
    ak = heads(proj('att_k', h), ATT_KV_HEADS)
    av = heads(proj('att_v', h), ATT_KV_HEADS)
    y_att = window_attention(axial_rope(aq[:, n_ctx:], rows, cols), axial_rope(ak[:, n_ctx:], rows, cols), av[:, n_ctx:],
                             aq[:, :n_ctx], ak[:, :n_ctx], av[:, :n_ctx], attn_sink, not latent_only)

    rq = rope(heads(proj('ret_q', h), RET_HEADS), ret_pos)
    rk = rope(heads(proj('ret_k', h), RET_HEADS), ret_pos) * RET_DK ** -0.5
    o_ret = bidirectional_scan(rq, rk, heads(proj('ret_v', h), RET_HEADS), ret_log_decay, ret_log_decay, n_ctx)
    y_ret = head_group_norm(o_ret[:, t0:], ret_norm_g) * jax.nn.silu(proj('ret_g', h_out))

    g_gla, g_att, g_ret = jnp.split(jax.nn.sigmoid(proj('gates', h_out)), 3, axis=-1)
    merged = g_gla * (y_gla @ w_br_gla) + g_att * (y_att @ w_br_attn) + g_ret * (y_ret @ w_br_ret)
    return merged @ w_out


def hier_moe(h, w_grp, b_grp, w_exp, b_exp, w1, w3, w2):
    n_tok, d = h.shape
    grp_logits = (h @ w_grp + b_grp).astype(jnp.float32)
    grp = jnp.argmax(grp_logits, axis=-1)
    grp_prob = jnp.take_along_axis(jax.nn.softmax(grp_logits, axis=-1), grp[:, None], axis=-1)
    exp_logits = (h @ w_exp + b_exp).astype(jnp.float32).reshape(n_tok, MOE_GROUPS, MOE_EXPERTS_PER_GROUP)
    in_grp = jnp.take_along_axis(exp_logits, grp[:, None, None], axis=1)[:, 0]
    top_val, top_idx = lax.top_k(in_grp, MOE_TOP_K)
    gate = grp_prob * jax.nn.softmax(top_val, axis=-1)
    expert = (grp[:, None] * MOE_EXPERTS_PER_GROUP + top_idx).astype(jnp.int32)

    n_assign = n_tok * MOE_TOP_K
    e_flat = expert.reshape(n_assign)
    t_flat = jnp.repeat(jnp.arange(n_tok, dtype=jnp.int32), MOE_TOP_K)
    order = jnp.argsort(e_flat)
    e_s, t_s, w_s = e_flat[order], t_flat[order], gate.reshape(n_assign)[order]
    counts = jnp.zeros((MOE_EXPERTS,), jnp.int32).at[e_s].add(1)
    starts = jnp.cumsum(counts) - counts
    padded = (counts + MOE_BLOCK - 1) // MOE_BLOCK * MOE_BLOCK
    pad_end = jnp.cumsum(padded)
    pad_start = pad_end - padded
    dest = pad_start[e_s] + jnp.arange(n_assign, dtype=jnp.int32) - starts[e_s]
    n_blocks = (n_assign + MOE_EXPERTS * (MOE_BLOCK - 1) + MOE_BLOCK - 1) // MOE_BLOCK
    n_slots = n_blocks * MOE_BLOCK
    slot_tok = jnp.full((n_slots,), n_tok, jnp.int32).at[dest].set(t_s)
    slot_w = jnp.zeros((n_slots,), h.dtype).at[dest].set(w_s.astype(h.dtype))
    blk_exp = jnp.minimum(jnp.searchsorted(pad_end, jnp.arange(n_blocks, dtype=jnp.int32) * MOE_BLOCK, side='right'),
                          MOE_EXPERTS - 1)
    h_pad = jnp.concatenate([h, jnp.zeros((1, d), h.dtype)], axis=0)

    def step(acc, xs):
        tok, wgt, e = xs
        xb = h_pad[tok]
        yb = (jax.nn.silu(xb @ w1[e]) * (xb @ w3[e])) @ w2[e]
        return acc.at[tok].add(yb * wgt[:, None]), None

    acc, _ = lax.scan(step, jnp.zeros((n_tok + 1, d), h.dtype),
                      (slot_tok.reshape(n_blocks, MOE_BLOCK), slot_w.reshape(n_blocks, MOE_BLOCK), blk_exp))
    return acc[:n_tok]


def setup_inputs(seed: int = 0) -> dict:
    key = jax.random.key(seed)
    keys = iter(jax.random.split(key, 32))
    f32 = jnp.float32
    D = D_MODEL

    def nrm(shape, scale):
        return jax.random.normal(next(keys), shape, f32) * scale

    return {
        'x': nrm((BATCH, SEQ, D), 1.0),
        'c': nrm((BATCH, D), 1.0),
        'ctx': nrm((BATCH, CTX_LEN, D), 1.0),
        'c_ctx': nrm((D,), 1.0),
        'w_ada': nrm((DEPTH, D, 6 * D), 0.5 * D ** -0.5),
        'b_ada': nrm((DEPTH, 6 * D), 0.02),
        'norm1_g': 1.0 + nrm((DEPTH, D), 0.05),
        'norm2_g': 1.0 + nrm((DEPTH, D), 0.05),
        'w_in': nrm((DEPTH, D, N_IN), D ** -0.5),
        'gla_wa2': nrm((DEPTH, 2, GLA_LOW_RANK, GLA_K), GLA_LOW_RANK ** -0.5),
        'gla_ba': nrm((DEPTH, 2, GLA_K), 0.1),
        'gla_norm_g': 1.0 + nrm((DEPTH, GLA_V), 0.05),
        'attn_sink': nrm((DEPTH, ATT_Q_HEADS), 0.5),
        'ret_norm_g': 1.0 + nrm((DEPTH, RET_V), 0.05),
        'w_br_gla': nrm((DEPTH, GLA_V, D), GLA_V ** -0.5),
        'w_br_attn': nrm((DEPTH, ATT_Q_HEADS * ATT_HEAD_DIM, D), (ATT_Q_HEADS * ATT_HEAD_DIM) ** -0.5),
        'w_br_ret': nrm((DEPTH, RET_V, D), RET_V ** -0.5),
        'w_out': nrm((DEPTH, D, D), D ** -0.5),
        'moe_w_grp': nrm((DEPTH, D, MOE_GROUPS), D ** -0.5),
        'moe_b_grp': nrm((DEPTH, MOE_GROUPS), 0.01),
        'moe_w_exp': nrm((DEPTH, D, MOE_EXPERTS), D ** -0.5),
        'moe_b_exp': nrm((DEPTH, MOE_EXPERTS), 0.01),
        'moe_w1': nrm((DEPTH, MOE_EXPERTS, D, MOE_HIDDEN), D ** -0.5),
        'moe_w3': nrm((DEPTH, MOE_EXPERTS, D, MOE_HIDDEN), D ** -0.5),
        'moe_w2': nrm((DEPTH, MOE_EXPERTS, MOE_HIDDEN, D), MOE_HIDDEN ** -0.5),
        'final_g': 1.0 + nrm((D,), 0.05),
    }


def reference(x, c, ctx, c_ctx, w_ada, b_ada, norm1_g, norm2_g, w_in, gla_wa2, gla_ba, gla_norm_g, attn_sink,
              ret_norm_g, w_br_gla, w_br_attn, w_br_ret, w_out, moe_w_grp, moe_b_grp, moe_w_exp, moe_b_exp,
              moe_w1, moe_w3, moe_w2, final_g):
    b_, l_, d = x.shape
    n_ctx = ctx.shape[1]
    ROWS = l_ // GRID_W
    rows = jnp.broadcast_to(jnp.arange(ROWS)[:, None], (ROWS, GRID_W)).reshape(l_)
    cols = jnp.broadcast_to(jnp.arange(GRID_W)[None, :], (ROWS, GRID_W)).reshape(l_)
    ret_pos = jnp.arange(n_ctx + l_)
    ret_log_decay = jnp.log(1.0 - jnp.exp2(-5.0 - jnp.arange(RET_HEADS, dtype=jnp.float32))).reshape(1, 1, RET_HEADS, 1)
    silu_c = jax.nn.silu(c)
    silu_cc = jax.nn.silu(c_ctx)

    for layer in range(DEPTH):
        last = layer == DEPTH - 1
        mod = silu_c @ w_ada[layer] + b_ada[layer]
        mod_c = silu_cc @ w_ada[layer] + b_ada[layer]
        sh1, sc1, g1, sh2, sc2, g2 = jnp.split(mod[:, None, :], 6, axis=-1)
        sh1c, sc1c, g1c, sh2c, sc2c, g2c = jnp.split(mod_c, 6, axis=-1)

        h = jnp.concatenate([rms_norm(ctx, norm1_g[layer]) * (1.0 + sc1c) + sh1c,
                             rms_norm(x, norm1_g[layer]) * (1.0 + sc1) + sh1], axis=1)
        mix = token_mixers(h, n_ctx, rows, cols, ret_pos, ret_log_decay, w_in[layer], gla_wa2[layer], gla_ba[layer],
                           gla_norm_g[layer], attn_sink[layer], ret_norm_g[layer], w_br_gla[layer], w_br_attn[layer],
                           w_br_ret[layer], w_out[layer], last)
        x = x + g1 * mix[:, -l_:]
        if not last:
            ctx = ctx + g1c * mix[:, :n_ctx]

        h2 = rms_norm(x, norm2_g[layer]) * (1.0 + sc2) + sh2
        if not last:
            h2 = jnp.concatenate([rms_norm(ctx, norm2_g[layer]) * (1.0 + sc2c) + sh2c, h2], axis=1)
        f = hier_moe(h2.reshape(-1, d), moe_w_grp[layer], moe_b_grp[layer], moe_w_exp[layer], moe_b_exp[layer],
                     moe_w1[layer], moe_w3[layer], moe_w2[layer]).reshape(h2.shape)
        x = x + g2 * f[:, -l_:]
        if not last:
            ctx = ctx + g2c * f[:, :n_ctx]

    return rms_norm(x, final_g)
```

```cpp
#include <hip/hip_runtime.h>
#include <stdint.h>
#include <stdio.h>

#ifndef MK_MULTI
#define MK_MULTI 1
#endif
#ifndef NAIVE_SCAN
#define NAIVE_SCAN 1
#endif
#ifndef NAIVE_ATTN
#define NAIVE_ATTN 1
#endif

#define LAS __attribute__((address_space(3)))
#ifndef PSEL
#define PSEL -1
#endif
#ifndef PMASK
#define PMASK 0xFFFFFFFFu
#endif
#define PSEL_OK(t) ((PSEL < 0 || PSEL == (t)) && ((PMASK >> (t)) & 1u))
typedef unsigned short bf16_t;
typedef short bf16x8 __attribute__((ext_vector_type(8)));
typedef float f32x4 __attribute__((ext_vector_type(4)));
typedef float f32x2 __attribute__((ext_vector_type(2)));
typedef unsigned u32x4 __attribute__((ext_vector_type(4)));
typedef unsigned u32x2 __attribute__((ext_vector_type(2)));

constexpr int D = 1024, NBATCH = 8, LSEQ = 8192, NCTX = 256, TB = 8448, TALL = 67584;
constexpr int NGRP = 2, BG = 4, TG = 33792;
constexpr int NIN = 10784, NE = 32;
constexpr int NSLOT = 2 * TALL;
constexpr int WIN_ROWS = 11008;
constexpr int CH = 64, NCH = TB / CH;
constexpr float LOG2E = 1.4426950408889634f;

constexpr size_t al(size_t x) { return (x + 4095) & ~(size_t)4095; }
constexpr size_t OFF_BAR   = 0;
constexpr size_t OFF_CNT   = 16384;
constexpr size_t ZERO_BYTES = 32768;
constexpr size_t OFF_MOD   = ZERO_BYTES;
constexpr size_t OFF_MODP  = OFF_MOD   + al((size_t)2 * 9 * 6144 * 4);
constexpr size_t OFF_ATAB  = OFF_MODP  + al((size_t)16 * 2 * 9 * 6144 * 4);
constexpr size_t OFF_RTAB  = OFF_ATAB  + al((size_t)128 * 32 * 8);
constexpr size_t OFF_WR    = OFF_RTAB  + al((size_t)TB * 64 * 8);
constexpr size_t OFF_CTXS  = OFF_WR    + al((size_t)2 * 1024 * 36 * 4);
constexpr size_t OFF_WINT  = OFF_CTXS  + al((size_t)8 * 256 * 1024 * 4);
constexpr size_t OFF_WBRT  = OFF_WINT  + al((size_t)2 * WIN_ROWS * 1024 * 2);
constexpr size_t OFF_WO3T  = OFF_WBRT  + al((size_t)2 * 3 * 1024 * 1024 * 2);
constexpr size_t OFF_EXPID = OFF_WO3T  + al((size_t)2 * 1024 * 3072 * 2);
constexpr size_t OFF_GATEW = OFF_EXPID + al((size_t)TALL * 2 * 4);
constexpr size_t OFF_RANK  = OFF_GATEW + al((size_t)TALL * 2 * 4);
constexpr size_t OFF_TOKSL = OFF_RANK  + al((size_t)TALL * 2 * 4);
constexpr size_t OFF_SLOTW = OFF_TOKSL + al((size_t)TALL * 2 * 4);
constexpr size_t OFF_STATS = OFF_SLOTW + al((size_t)(NSLOT + 256) * 4);
constexpr size_t OFF_H     = OFF_STATS + al((size_t)2 * TG * 4 * 8);
constexpr size_t OFF_REG   = OFF_H     + al((size_t)TALL * 1024 * 2);
constexpr size_t SZ_T1K = (size_t)TG * 1024 * 2;
constexpr size_t R_GQK  = 0;
constexpr size_t R_GIN  = R_GQK + SZ_T1K;
constexpr size_t R_GDEC = R_GIN + 2 * SZ_T1K;
constexpr size_t R_GVT  = R_GDEC + al((size_t)2 * BG * NCH * 512 * 4);
constexpr size_t R_GLR  = R_GVT + SZ_T1K;
constexpr size_t R_AK   = R_GLR + al((size_t)TG * 32 * 4);
constexpr size_t R_AVT  = R_AK + SZ_T1K / 4;
constexpr size_t R_RQK  = R_AVT + SZ_T1K / 4;
constexpr size_t R_RVT  = R_RQK + SZ_T1K;
constexpr size_t R_OGF  = R_RVT + SZ_T1K;
constexpr size_t R_AQ   = R_OGF + SZ_T1K;
constexpr size_t R_ORF  = R_AQ + SZ_T1K;
constexpr size_t R_OGB  = R_ORF + SZ_T1K;
constexpr size_t R_ORB  = R_OGB + SZ_T1K;
constexpr size_t R_MIX_END = R_ORB + SZ_T1K;
constexpr size_t M_W13T = 0;
constexpr size_t M_W2T  = M_W13T + (size_t)32 * 2048 * 1024 * 2;
constexpr size_t M_XG   = M_W2T + (size_t)32 * 1024 * 1024 * 2;
constexpr size_t M_HMID = M_XG + al((size_t)(NSLOT + 256) * 1024 * 2);
constexpr size_t M_END  = M_HMID + al((size_t)(NSLOT + 256) * 1024 * 2);
constexpr size_t REG_BYTES = R_MIX_END > M_END ? R_MIX_END : M_END;
constexpr size_t WS_NEED = OFF_REG + REG_BYTES;

constexpr int LDS_BYTES = 155648;

struct Params {
    const float* in[26];
    float* out;
    unsigned char* ws;
    int ph0, ph1;
};

__device__ __forceinline__ bf16_t f2bf(float f) { unsigned u = __float_as_uint(f); u += 0x7FFFu + ((u >> 16) & 1u); return (bf16_t)(u >> 16); }
__device__ __forceinline__ float bf2f(unsigned b) { return __uint_as_float(b << 16); }
__device__ __forceinline__ float bflo(unsigned w) { return __uint_as_float(w << 16); }
__device__ __forceinline__ float bfhi(unsigned w) { return __uint_as_float(w & 0xFFFF0000u); }
__device__ __forceinline__ unsigned cvt_pk_bf16(float lo, float hi) { unsigned r; asm volatile("v_cvt_pk_bf16_f32 %0, %1, %2" : "=v"(r) : "v"(lo), "v"(hi)); return r; }
__device__ __forceinline__ float wave_sum(float v) {
#pragma unroll
    for (int o = 32; o; o >>= 1) v += __shfl_xor(v, o);
    return v;
}
__device__ __forceinline__ float wave_max(float v) {
#pragma unroll
    for (int o = 32; o; o >>= 1) v = fmaxf(v, __shfl_xor(v, o));
    return v;
}
__device__ __forceinline__ int tid_fresh() { int t = threadIdx.x; asm volatile("" : "+v"(t)); return t; }
__device__ __forceinline__ int bid_fresh() { int t = blockIdx.x; asm volatile("" : "+s"(t)); return t; }
__device__ __forceinline__ float silu_f(float x) { return x / (1.0f + __expf(-x)); }
__device__ __forceinline__ float sigmoid_f(float x) { return 1.0f / (1.0f + __expf(-x)); }

#define XB_TMO      128
#define XB_XCNT(j)  (256  + 64 * (j))
#define XB_XSUB(j)  (1280 + 64 * (j))
#define XB_XGEN(j)  (2304 + 64 * (j))
#define XB_TOP      3328
#define XB_TOPGEN   3392
#define XCD_BAR_WORDS 3456
#define XB_SPIN_CAP (1u << 18)

__device__ __forceinline__ unsigned xb_ld(unsigned* p)              { return __hip_atomic_load(p, __ATOMIC_RELAXED, __HIP_MEMORY_SCOPE_AGENT); }
__device__ __forceinline__ unsigned xb_add(unsigned* p, unsigned v) { return __hip_atomic_fetch_add(p, v, __ATOMIC_RELAXED, __HIP_MEMORY_SCOPE_AGENT); }
__device__ __forceinline__ unsigned xb_xcc_id() { return (unsigned)__builtin_amdgcn_s_getreg((3 << 11) | 20) & 0xFu; }
#define XB_SPIN(cond, bar) do { unsigned _sp = 0; while (cond) { __builtin_amdgcn_s_sleep(1); \
    if ((++_sp & 255u) == 0u) { if (xb_ld(&(bar)[XB_TMO])) break; if (_sp > XB_SPIN_CAP) { atomicAdd(&(bar)[XB_TMO], 1u); break; } } } } while (0)

struct XcdBarrier { unsigned* bar; unsigned x; volatile LAS unsigned* st; };

__device__ __forceinline__ XcdBarrier xcd_barrier_post(unsigned* bar, volatile LAS unsigned* st) {
    XcdBarrier b; b.bar = bar; b.x = xb_xcc_id(); b.st = st;
    if (threadIdx.x == 0) (void)xb_add(&bar[XB_XCNT(b.x)], 1u);
    return b;
}
__device__ __forceinline__ void xcd_barrier_complete(unsigned* bar, unsigned x, unsigned& nloc, unsigned& nx) {
    const unsigned G = gridDim.x * gridDim.y * gridDim.z;
    unsigned sum, cnt, mine, sp = 0u;
    for (;;) {
        sum = 0u; cnt = 0u; mine = 0u;
#pragma unroll
        for (unsigned j = 0; j < 16; ++j) { const unsigned c = xb_ld(&bar[XB_XCNT(j)]); sum += c; cnt += (c > 0u) ? 1u : 0u; mine = (j == x) ? c : mine; }
        if (sum == G) break;
        __builtin_amdgcn_s_sleep(1);
        if ((++sp & 255u) == 0u) { if (xb_ld(&bar[XB_TMO])) break; if (sp > XB_SPIN_CAP) { atomicAdd(&bar[XB_TMO], 1u); break; } }
    }
    nloc = mine > 0u ? mine : 1u; nx = cnt > 0u ? cnt : 1u;
}
__device__ __forceinline__ void xcd_barrier(const XcdBarrier& b) {
    asm volatile("s_waitcnt vmcnt(0)" ::: "memory");
    __syncthreads();
    if (threadIdx.x == 0) {
        unsigned* bar = b.bar;
        __builtin_amdgcn_s_waitcnt(0);
        unsigned nloc = b.st[0], nx = b.st[1];
        if (nloc == 0u) { xcd_barrier_complete(bar, b.x, nloc, nx); b.st[0] = nloc; b.st[1] = nx; }
        const unsigned old = xb_add(&bar[XB_XSUB(b.x)], 1u);
        const unsigned gen = old / nloc;
        if (old + 1u == (gen + 1u) * nloc) {
            __builtin_amdgcn_fence(__ATOMIC_RELEASE, "agent");
            asm volatile("s_waitcnt vmcnt(0)" ::: "memory");
            const unsigned og = xb_add(&bar[XB_TOP], 1u);
            const unsigned tg = og / nx;
            if (og + 1u == (tg + 1u) * nx) xb_add(&bar[XB_TOPGEN], 1u);
            else XB_SPIN(xb_ld(&bar[XB_TOPGEN]) == tg, bar);
            __builtin_amdgcn_fence(__ATOMIC_ACQUIRE, "agent");
            xb_add(&bar[XB_XGEN(b.x)], 1u);
            asm volatile("s_waitcnt vmcnt(0)" ::: "memory");
        } else {
            XB_SPIN(xb_ld(&bar[XB_XGEN(b.x)]) == gen, bar);
            __builtin_amdgcn_fence(__ATOMIC_ACQUIRE, "agent");
            asm volatile("s_waitcnt vmcnt(0)" ::: "memory");
        }
    }
    __syncthreads();
}

__device__ __forceinline__ size_t lat_off(int b, int t) { return ((size_t)b * LSEQ + (t - NCTX)) * D; }
__device__ __forceinline__ size_t ctx_off(int b, int t) { return ((size_t)b * NCTX + t) * D; }

namespace g8 {
constexpr int BM = 256, BK = 64, HALF = 128, HTB = HALF * BK * 2, STAGE_BYTES = 8 * HTB, NXCD = 8, WGM = 8;
__device__ __forceinline__ int lds_byte(int r, int c) { const int st = (r >> 4) * 2 + (c >> 5), rr = r & 15, cc = c & 31, ob = rr * 64 + cc * 2; return st * 1024 + (ob ^ (((ob >> 9) & 1) << 5)); }
__device__ __forceinline__ void stage_rc(int b, int& R, int& C) { const int st = b / 1024, sb = b % 1024, swz = sb ^ (((sb >> 9) & 1) << 5); R = (st >> 1) * 16 + swz / 64; C = (st & 1) * 32 + (swz % 64) / 2; }
__device__ __forceinline__ int perm32(int rho) { const int n = rho >> 4, i = rho & 15; return 8 * (i >> 2) + 4 * n + (i & 3); }

struct GUnit { const char* a; const char* b; int pm, pn, x0, x1; };

__device__ __forceinline__ bool static_tile(int i, int G, int c, int nM, int nN, int& pm, int& pn) {
    const int nwg = nM * nN; const long L = (long)i * G + c; if (L >= nwg) return false;
    int wgid = (int)L; { const int q = nwg / NXCD, r = nwg % NXCD, xcd = wgid % NXCD, off = wgid / NXCD; wgid = (xcd < r ? xcd * (q + 1) : r * (q + 1) + (xcd - r) * q) + off; }
    const int nig = WGM * nN, gid = wgid / nig, fm = gid * WGM, gsz = (nM - fm) < WGM ? (nM - fm) : WGM;
    pm = fm + ((wgid % nig) % gsz); pn = (wgid % nig) / gsz; return true;
}

template <class Epi, class Sched>
__device__ __forceinline__ void gemm_phase(LAS unsigned char* lds, const Sched& S, const Epi& E) {
    const int tid = tid_fresh(), wid = __builtin_amdgcn_readfirstlane(tid >> 6), lane = tid & 63, wr = wid >> 2, wc = wid & 3, fr = lane & 15, fq = lane >> 4;
    const int K = S.K, nt = K / BK;
    const int lda = S.lda;
    unsigned voffA[2], voffB[2];
#pragma unroll
    for (int i = 0; i < 2; ++i) { int R, C; stage_rc(tid * 16 + i * 8192, R, C); const int Rb = Epi::PERM ? ((R & ~31) + perm32(R & 31)) : R;
        voffA[i] = (unsigned)(R * lda + C) * 2u; voffB[i] = (unsigned)(Rb * K + C) * 2u; }
    const size_t kstep = (size_t)(BK * 2);
    const size_t hstepA = (size_t)HALF * lda * 2, hstepB = (size_t)HALF * K * 2;
    const unsigned ldsw = (unsigned)wid * 1024u;
    const int aoff = lds_byte(wr * 64 + fr, fq * 8), boff = lds_byte(wc * 32 + fr, fq * 8);
#define G8_SA(b, h) (((b) * 2 + (h)) * HTB)
#define G8_SB(b, h) ((4 + (b) * 2 + (h)) * HTB)
#define G8_STAGE(bufoff, gbase, voff) do { _Pragma("unroll") for (int _i = 0; _i < 2; ++_i) \
        __builtin_amdgcn_global_load_lds((const unsigned*)((const char*)(gbase) + (voff)[_i]), (LAS unsigned*)(lds + (bufoff) + ldsw + _i * 8192), 16, 0, 0); } while (0)
#define G8_LDA(dst, b, h) do { _Pragma("unroll") for (int m = 0; m < 4; ++m) _Pragma("unroll") for (int k = 0; k < 2; ++k) dst[m][k] = *(const LAS bf16x8*)(lds + G8_SA(b, h) + aoff + m * 2048 + k * 1024); } while (0)
#define G8_LDB(dst, b, h) do { _Pragma("unroll") for (int n = 0; n < 2; ++n) _Pragma("unroll") for (int k = 0; k < 2; ++k) dst[n][k] = *(const LAS bf16x8*)(lds + G8_SB(b, h) + boff + n * 2048 + k * 1024); } while (0)
#define G8_MMA(ai, bj, At, Bt) do { __builtin_amdgcn_s_setprio(1); _Pragma("unroll") for (int m = 0; m < 4; ++m) _Pragma("unroll") for (int n = 0; n < 2; ++n) _Pragma("unroll") for (int k = 0; k < 2; ++k) \
        acc[ai][bj][m][n] = __builtin_amdgcn_mfma_f32_16x16x32_bf16(Bt[n][k], At[m][k], acc[ai][bj][m][n], 0, 0, 0); __builtin_amdgcn_s_setprio(0); } while (0)
#define G8_WAIT_V(n) asm volatile("s_waitcnt vmcnt(" #n ")" ::: "memory")
#define G8_WAIT_L(n) asm volatile("s_waitcnt lgkmcnt(" #n ")" ::: "memory")
#define G8_BAR __builtin_amdgcn_s_barrier()
#define G8_SCHED __builtin_amdgcn_sched_barrier(0)
    GUnit cur, nxt; int ui = 0;
    if (!S.next(0, cur)) return;
    f32x4 acc[2][2][4][2];
#pragma unroll
    for (int a = 0; a < 2; ++a)
#pragma unroll
        for (int b = 0; b < 2; ++b)
#pragma unroll
            for (int m = 0; m < 4; ++m)
#pragma unroll
                for (int n = 0; n < 2; ++n) acc[a][b][m][n] = (f32x4){0.f, 0.f, 0.f, 0.f};
    bf16x8 At[4][2], B0[2][2], B1[2][2];
    const char* cA = cur.a; const char* cB = cur.b;
    G8_STAGE(G8_SB(0, 0), cB, voffB); G8_STAGE(G8_SA(0, 0), cA, voffA); G8_STAGE(G8_SB(0, 1), cB + hstepB, voffB); G8_STAGE(G8_SA(0, 1), cA + hstepA, voffA);
    if (wr == 1) G8_BAR;
    G8_WAIT_V(4); G8_BAR;
    G8_STAGE(G8_SB(1, 0), cB + kstep, voffB); G8_STAGE(G8_SA(1, 0), cA + kstep, voffA); G8_STAGE(G8_SB(1, 1), cB + hstepB + kstep, voffB);
    G8_WAIT_V(6); G8_BAR;
    for (;;) {
        const bool has_next = S.next(ui + 1, nxt);
        const char* nA = has_next ? nxt.a : cA; const char* nB = has_next ? nxt.b : cB;
        for (int t = 0; t < nt; t += 2) {
            const bool last = (t == nt - 2);
            const char* a1 = cA + (size_t)(t + 1) * kstep;
            const char* a2 = last ? nA : cA + (size_t)(t + 2) * kstep; const char* b2 = last ? nB : cB + (size_t)(t + 2) * kstep;
            const char* a3 = a2 + kstep; const char* b3 = b2 + kstep;
            G8_LDB(B0, 0, 0); G8_SCHED; G8_LDA(At, 0, 0); G8_STAGE(G8_SA(1, 1), a1 + hstepA, voffA);
            G8_WAIT_L(8); G8_BAR; G8_WAIT_L(0); G8_MMA(0, 0, At, B0); G8_BAR; G8_SCHED;
            G8_LDB(B1, 0, 1); G8_STAGE(G8_SB(0, 0), b2, voffB);
            G8_BAR; G8_WAIT_L(0); G8_MMA(0, 1, At, B1); G8_BAR;
            G8_LDA(At, 0, 1); G8_STAGE(G8_SA(0, 0), a2, voffA);
            G8_BAR; G8_WAIT_L(0); G8_MMA(1, 0, At, B0); G8_BAR; G8_SCHED;
            G8_STAGE(G8_SB(0, 1), b2 + hstepB, voffB);
            G8_WAIT_V(6); G8_BAR; G8_MMA(1, 1, At, B1); G8_BAR;
            G8_LDB(B0, 1, 0); G8_SCHED; G8_LDA(At, 1, 0); G8_STAGE(G8_SA(0, 1), a2 + hstepA, voffA);
            G8_WAIT_L(8); G8_BAR; G8_WAIT_L(0); G8_MMA(0, 0, At, B0); G8_BAR; G8_SCHED;
            G8_LDB(B1, 1, 1); G8_STAGE(G8_SB(1, 0), b3, voffB);
            G8_BAR; G8_WAIT_L(0); G8_MMA(0, 1, At, B1); G8_BAR;
            G8_LDA(At, 1, 1); G8_STAGE(G8_SA(1, 0), a3, voffA);
            G8_BAR; G8_WAIT_L(0); G8_MMA(1, 0, At, B0); G8_BAR; G8_SCHED;
            G8_STAGE(G8_SB(1, 1), b3 + hstepB, voffB);
            G8_WAIT_V(6); G8_BAR; G8_MMA(1, 1, At, B1); G8_BAR;
        }
        E(acc, cur, wr, wc, fr, fq);
        if (!has_next) break;
#pragma unroll
        for (int a = 0; a < 2; ++a)
#pragma unroll
            for (int b = 0; b < 2; ++b)
#pragma unroll
                for (int m = 0; m < 4; ++m)
#pragma unroll
                    for (int n = 0; n < 2; ++n) acc[a][b][m][n] = (f32x4){0.f, 0.f, 0.f, 0.f};
        cur = nxt; cA = nA; cB = nB; ++ui;
    }
    G8_WAIT_V(0);
    if (wr == 0) G8_BAR;
    G8_BAR;
#undef G8_SA
#undef G8_SB
#undef G8_STAGE
#undef G8_LDA
#undef G8_LDB
#undef G8_MMA
#undef G8_WAIT_V
#undef G8_WAIT_L
#undef G8_BAR
#undef G8_SCHED
}
template <class Epi, class Sched>
__device__ __forceinline__ void gemm_call(LAS unsigned char* lds, Sched S, Epi E) { gemm_phase(lds, S, E); }
}
using g8::GUnit;

struct SchedDense {
    const bf16_t* A; const bf16_t* B; size_t strideA, strideB; int lda, K, nM, nN, nNb;
    __device__ __forceinline__ bool next(int i, GUnit& u) const {
        int pm, pn; if (!g8::static_tile(i, gridDim.x, blockIdx.x, nM, nN, pm, pn)) return false;
        const int br = pn / nNb, pl = pn - br * nNb;
        u.pm = pm; u.pn = pn; u.x0 = br; u.x1 = pl;
        u.a = (const char*)(A + (size_t)br * strideA + (size_t)pm * 256 * lda);
        u.b = (const char*)(B + (size_t)br * strideB + (size_t)pl * 256 * K);
        return true;
    }
};
struct SchedMoe {
    const bf16_t* A; const bf16_t* B; int lda, K, npn, brows;
    const LAS int* tab;
    __device__ __forceinline__ bool next(int i, GUnit& u) const {
        const int L = i * (int)gridDim.x + (int)blockIdx.x;
        const int ntile = tab[96];
        if (L >= ntile * npn) return false;
        const int tg = L / npn, pn = L - tg * npn;
        int e = 0;
#pragma unroll 1
        for (int j = 1; j < 32; ++j) e = (tab[64 + j] <= tg) ? j : e;
        const int mt = tg - tab[64 + e];
        const int slot0 = tab[32 + e] + 256 * mt;
        u.pm = slot0; u.pn = pn; u.x0 = e; u.x1 = tab[e] - 256 * mt;
        u.a = (const char*)(A + (size_t)slot0 * lda);
        u.b = (const char*)(B + ((size_t)e * brows + (size_t)pn * 256) * K);
        return true;
    }
};

struct EpiQKV {
    static constexpr bool PERM = false;
    unsigned char* reg; int g;
    const f32x2* atab; const f32x2* rtab;
    __device__ __forceinline__ void operator()(const f32x4 (&acc)[2][2][4][2], const GUnit& u, int wr, int wc, int fr, int fq) const {
        const int pn = u.pn;
        const int rg0 = u.pm * 256;
        const int bl = rg0 / TB, t0 = rg0 - bl * TB;
        bf16_t* GQK = (bf16_t*)(reg + R_GQK); bf16_t* GVT = (bf16_t*)(reg + R_GVT); float* GLR = (float*)(reg + R_GLR);
        bf16_t* AQ = (bf16_t*)(reg + R_AQ); bf16_t* AK = (bf16_t*)(reg + R_AK); bf16_t* AVT = (bf16_t*)(reg + R_AVT);
        bf16_t* RQK = (bf16_t*)(reg + R_RQK); bf16_t* RVT = (bf16_t*)(reg + R_RVT);
        if (pn < 4) {
            const float sc = pn < 2 ? 0.08838834764831845f : 1.0f;
#pragma unroll
            for (int ai = 0; ai < 2; ++ai)
#pragma unroll
                for (int m = 0; m < 4; ++m) { const int r = rg0 + ai * 128 + wr * 64 + m * 16 + fr; bf16_t* rowp = GQK + (size_t)r * 1024 + pn * 256 + wc * 32 + 4 * fq;
#pragma unroll
                    for (int bj = 0; bj < 2; ++bj)
#pragma unroll
                        for (int n = 0; n < 2; ++n) { const f32x4 v = acc[ai][bj][m][n] * sc; u32x2 w; w.x = cvt_pk_bf16(v[0], v[1]); w.y = cvt_pk_bf16(v[2], v[3]); *(u32x2*)(rowp + bj * 128 + n * 16) = w; } }
        } else if (pn < 8 || pn == 13 || (pn >= 18 && pn < 22)) {
            bf16_t* VT; int dim0, nd;
            if (pn < 8) { VT = GVT; dim0 = (pn - 4) * 256; nd = 1024; } else if (pn == 13) { VT = AVT; dim0 = 0; nd = 256; } else { VT = RVT; dim0 = (pn - 18) * 256; nd = 1024; }
#pragma unroll
            for (int ai = 0; ai < 2; ++ai)
#pragma unroll
                for (int m = 0; m < 4; ++m) { const int t = t0 + ai * 128 + wr * 64 + m * 16 + fr;
#pragma unroll
                    for (int bj = 0; bj < 2; ++bj)
#pragma unroll
                        for (int n = 0; n < 2; ++n) { const int dim = dim0 + bj * 128 + wc * 32 + n * 16 + 4 * fq; bf16_t* p = VT + ((size_t)bl * nd + dim) * TB + t;
#pragma unroll
                            for (int j = 0; j < 4; ++j) p[(size_t)j * TB] = f2bf(acc[ai][bj][m][n][j]); } }
        } else if (pn == 22) {
            if (wc == 0) {
#pragma unroll
                for (int ai = 0; ai < 2; ++ai)
#pragma unroll
                    for (int m = 0; m < 4; ++m) { const int r = rg0 + ai * 128 + wr * 64 + m * 16 + fr;
#pragma unroll
                        for (int n = 0; n < 2; ++n) *(f32x4*)(GLR + (size_t)r * 32 + n * 16 + 4 * fq) = acc[ai][0][m][n]; }
            }
        } else {
            const bool isatt = pn <= 12;
            bf16_t* O; int ld, colbase; float sc;
            if (pn < 12)       { O = AQ;  ld = 1024; colbase = (pn - 8) * 256;  sc = 0.08838834764831845f * LOG2E; }
            else if (pn == 12) { O = AK;  ld = 256;  colbase = 0;               sc = 1.0f; }
            else if (pn < 16)  { O = RQK; ld = 1024; colbase = (pn - 14) * 256; sc = 1.0f; }
            else               { O = RQK; ld = 1024; colbase = 512 + (pn - 16) * 256; sc = 0.08838834764831845f; }
            const int hb = isatt ? ((wc & 1) * 16 + (wc >> 1) * 64) : 16 * wc;
            const int pstep = isatt ? 32 : 64;
            const int fi = isatt ? ((wc & 1) * 16 + 4 * fq) : (16 * wc + 4 * fq);
#pragma unroll
            for (int ai = 0; ai < 2; ++ai)
#pragma unroll
                for (int m = 0; m < 4; ++m) {
                    const int rl = ai * 128 + wr * 64 + m * 16 + fr; const int t = t0 + rl; const int r = rg0 + rl;
                    f32x2 cs[4];
                    if (isatt) { const int lt = t - NCTX; const int pos = (t < NCTX) ? 0 : ((wc < 2) ? (lt >> 6) : (lt & 63));
                        const f32x4* tp = (const f32x4*)(atab + pos * 32 + fi); const f32x4 a = tp[0], b = tp[1]; cs[0] = (f32x2){a[0], a[1]}; cs[1] = (f32x2){a[2], a[3]}; cs[2] = (f32x2){b[0], b[1]}; cs[3] = (f32x2){b[2], b[3]}; }
                    else { const f32x4* tp = (const f32x4*)(rtab + (size_t)t * 64 + fi); const f32x4 a = tp[0], b = tp[1]; cs[0] = (f32x2){a[0], a[1]}; cs[1] = (f32x2){a[2], a[3]}; cs[2] = (f32x2){b[0], b[1]}; cs[3] = (f32x2){b[2], b[3]}; }
#pragma unroll
                    for (int bj = 0; bj < 2; ++bj) {
                        const f32x4 x1 = acc[ai][bj][m][0], x2 = acc[ai][bj][m][1];
                        float o1[4], o2[4];
#pragma unroll
                        for (int j = 0; j < 4; ++j) { o1[j] = (x1[j] * cs[j].x - x2[j] * cs[j].y) * sc; o2[j] = (x2[j] * cs[j].x + x1[j] * cs[j].y) * sc; }
                        bf16_t* p = O + (size_t)r * ld + colbase + bj * 128 + hb + 4 * fq;
                        u32x2 w1, w2; w1.x = cvt_pk_bf16(o1[0], o1[1]); w1.y = cvt_pk_bf16(o1[2], o1[3]); w2.x = cvt_pk_bf16(o2[0], o2[1]); w2.y = cvt_pk_bf16(o2[2], o2[3]);
                        *(u32x2*)p = w1; *(u32x2*)(p + pstep) = w2;
                    }
                }
        }
    }
};

struct EpiGateR {
    static constexpr bool PERM = true;
    unsigned char* reg; const f32x2* stats; const float* gng; const float* rng;
    __device__ __forceinline__ void operator()(const f32x4 (&acc)[2][2][4][2], const GUnit& u, int wr, int wc, int fr, int fq) const {
        const int mix = u.pn >> 2, head = u.pn & 3;
        bf16_t* O = (bf16_t*)(reg + (mix ? R_ORF : R_OGF));
        const float* gn = (mix ? rng : gng) + head * 256;
        const f32x2* st = stats + (size_t)mix * TG * 4;
#pragma unroll
        for (int bj = 0; bj < 2; ++bj) {
            const int c0 = bj * 128 + wc * 32 + 8 * fq;
            const f32x4 ga = *(const f32x4*)(gn + c0), gb = *(const f32x4*)(gn + c0 + 4);
#pragma unroll
            for (int ai = 0; ai < 2; ++ai)
#pragma unroll
                for (int m = 0; m < 4; ++m) {
                    const int r = u.pm * 256 + ai * 128 + wr * 64 + m * 16 + fr;
                    const f32x2 s = st[(size_t)r * 4 + head];
                    bf16_t* p = O + (size_t)r * 1024 + head * 256 + c0;
                    const u32x4 ov = *(const u32x4*)p;
                    const f32x4 a0 = acc[ai][bj][m][0], a1 = acc[ai][bj][m][1];
                    float y[8];
                    y[0] = (bflo(ov.x) - s.x) * s.y * ga[0] * silu_f(a0[0]); y[1] = (bfhi(ov.x) - s.x) * s.y * ga[1] * silu_f(a0[1]);
                    y[2] = (bflo(ov.y) - s.x) * s.y * ga[2] * silu_f(a0[2]); y[3] = (bfhi(ov.y) - s.x) * s.y * ga[3] * silu_f(a0[3]);
                    y[4] = (bflo(ov.z) - s.x) * s.y * gb[0] * silu_f(a1[0]); y[5] = (bfhi(ov.z) - s.x) * s.y * gb[1] * silu_f(a1[1]);
                    y[6] = (bflo(ov.w) - s.x) * s.y * gb[2] * silu_f(a1[2]); y[7] = (bfhi(ov.w) - s.x) * s.y * gb[3] * silu_f(a1[3]);
                    u32x4 w; w.x = cvt_pk_bf16(y[0], y[1]); w.y = cvt_pk_bf16(y[2], y[3]); w.z = cvt_pk_bf16(y[4], y[5]); w.w = cvt_pk_bf16(y[6], y[7]);
                    *(u32x4*)p = w;
                }
        }
    }
};

struct EpiBf16 {
    static constexpr bool PERM = true;
    bf16_t* O; int ld;
    __device__ __forceinline__ void operator()(const f32x4 (&acc)[2][2][4][2], const GUnit& u, int wr, int wc, int fr, int fq) const {
#pragma unroll
        for (int ai = 0; ai < 2; ++ai)
#pragma unroll
            for (int m = 0; m < 4; ++m) { bf16_t* rowp = O + (size_t)(u.pm * 256 + ai * 128 + wr * 64 + m * 16 + fr) * ld + u.pn * 256 + wc * 32 + 8 * fq;
#pragma unroll
                for (int bj = 0; bj < 2; ++bj) { const f32x4 v0 = acc[ai][bj][m][0], v1 = acc[ai][bj][m][1]; u32x4 w; w.x = cvt_pk_bf16(v0[0], v0[1]); w.y = cvt_pk_bf16(v0[2], v0[3]); w.z = cvt_pk_bf16(v1[0], v1[1]); w.w = cvt_pk_bf16(v1[2], v1[3]);
                    *(u32x4*)(rowp + bj * 128) = w; } }
    }
};
struct EpiGZ {
    static constexpr bool PERM = true;
    bf16_t* Z;
    __device__ __forceinline__ void operator()(const f32x4 (&acc)[2][2][4][2], const GUnit& u, int wr, int wc, int fr, int fq) const {
#pragma unroll
        for (int ai = 0; ai < 2; ++ai)
#pragma unroll
            for (int m = 0; m < 4; ++m) { bf16_t* rowp = Z + (size_t)(u.pm * 256 + ai * 128 + wr * 64 + m * 16 + fr) * 3072 + u.pn * 256 + wc * 32 + 8 * fq;
#pragma unroll
                for (int bj = 0; bj < 2; ++bj) { const f32x4 v0 = acc[ai][bj][m][0], v1 = acc[ai][bj][m][1]; const u32x4 z = *(const u32x4*)(rowp + bj * 128); u32x4 w;
                    w.x = cvt_pk_bf16(sigmoid_f(v0[0]) * bflo(z.x), sigmoid_f(v0[1]) * bfhi(z.x)); w.y = cvt_pk_bf16(sigmoid_f(v0[2]) * bflo(z.y), sigmoid_f(v0[3]) * bfhi(z.y));
                    w.z = cvt_pk_bf16(sigmoid_f(v1[0]) * bflo(z.z), sigmoid_f(v1[1]) * bfhi(z.z)); w.w = cvt_pk_bf16(sigmoid_f(v1[2]) * bflo(z.w), sigmoid_f(v1[3]) * bfhi(z.w));
                    *(u32x4*)(rowp + bj * 128) = w; } }
    }
};
struct EpiOut {
    static constexpr bool PERM = false;
    const float* xin_lat; const float* xin_ctx; float* xout_lat; float* xout_ctx; const float* mod; int g;
    __device__ __forceinline__ void operator()(const f32x4 (&acc)[2][2][4][2], const GUnit& u, int wr, int wc, int fr, int fq) const {
        const int rg0 = u.pm * 256; const int bl = rg0 / TB, t0 = rg0 - bl * TB; const int b = g * BG + bl;
        const bool isctx = t0 < NCTX;
        const float* g1 = mod + (size_t)(isctx ? 8 : b) * 6144 + 2048 + u.pn * 256 + wc * 32 + 4 * fq;
        f32x4 gv[2][2];
#pragma unroll
        for (int bj = 0; bj < 2; ++bj)
#pragma unroll
            for (int n = 0; n < 2; ++n) gv[bj][n] = *(const f32x4*)(g1 + bj * 128 + n * 16);
#pragma unroll
        for (int ai = 0; ai < 2; ++ai)
#pragma unroll
            for (int m = 0; m < 4; ++m) { const int t = t0 + ai * 128 + wr * 64 + m * 16 + fr;
                const size_t off = (isctx ? ctx_off(b, t) : lat_off(b, t)) + u.pn * 256 + wc * 32 + 4 * fq;
                const float* ip = (isctx ? xin_ctx : xin_lat) + off; float* op = (isctx ? xout_ctx : xout_lat) + off;
#pragma unroll
                for (int bj = 0; bj < 2; ++bj)
#pragma unroll
                    for (int n = 0; n < 2; ++n) { const f32x4 xi = *(const f32x4*)(ip + bj * 128 + n * 16); *(f32x4*)(op + bj * 128 + n * 16) = xi + gv[bj][n] * acc[ai][bj][m][n]; } }
    }
};
struct EpiMoe1 {
    static constexpr bool PERM = true;
    bf16_t* Hm;
    __device__ __forceinline__ void operator()(const f32x4 (&acc)[2][2][4][2], const GUnit& u, int wr, int wc, int fr, int fq) const {
#pragma unroll
        for (int ai = 0; ai < 2; ++ai)
#pragma unroll
            for (int m = 0; m < 4; ++m) { const int rl = ai * 128 + wr * 64 + m * 16 + fr;
                if (rl < u.x1) { bf16_t* p = Hm + (size_t)(u.pm + rl) * 1024 + u.pn * 128 + wc * 32 + 8 * fq;
                    const f32x4 a0 = acc[ai][0][m][0], a1 = acc[ai][0][m][1], b0 = acc[ai][1][m][0], b1 = acc[ai][1][m][1]; u32x4 w;
                    w.x = cvt_pk_bf16(silu_f(a0[0]) * b0[0], silu_f(a0[1]) * b0[1]); w.y = cvt_pk_bf16(silu_f(a0[2]) * b0[2], silu_f(a0[3]) * b0[3]);
                    w.z = cvt_pk_bf16(silu_f(a1[0]) * b1[0], silu_f(a1[1]) * b1[1]); w.w = cvt_pk_bf16(silu_f(a1[2]) * b1[2], silu_f(a1[3]) * b1[3]);
                    *(u32x4*)p = w; } }
    }
};
struct EpiMoe2 {
    static constexpr bool PERM = true;
    bf16_t* Y; const float* slotw;
    __device__ __forceinline__ void operator()(const f32x4 (&acc)[2][2][4][2], const GUnit& u, int wr, int wc, int fr, int fq) const {
#pragma unroll
        for (int ai = 0; ai < 2; ++ai)
#pragma unroll
            for (int m = 0; m < 4; ++m) { const int rl = ai * 128 + wr * 64 + m * 16 + fr;
                if (rl < u.x1) { const float w8 = slotw[u.pm + rl]; bf16_t* rowp = Y + (size_t)(u.pm + rl) * 1024 + u.pn * 256 + wc * 32 + 8 * fq;
#pragma unroll
                    for (int bj = 0; bj < 2; ++bj) { const f32x4 v0 = acc[ai][bj][m][0] * w8, v1 = acc[ai][bj][m][1] * w8; u32x4 w; w.x = cvt_pk_bf16(v0[0], v0[1]); w.y = cvt_pk_bf16(v0[2], v0[3]); w.z = cvt_pk_bf16(v1[0], v1[1]); w.w = cvt_pk_bf16(v1[2], v1[3]);
                        *(u32x4*)(rowp + bj * 128) = w; } } }
    }
};

template <class F>
__device__ __forceinline__ void conv_tile(LAS float* tile, F f, int n0, int k0src, size_t ldsrc, bf16_t* dst, size_t dst_ld, int k0dst) {
    const int tid = tid_fresh(), nl = tid & 63, kb = tid >> 6;
    const float* colp = f(n0 + nl);
#pragma unroll
    for (int i = 0; i < 8; ++i) { const int kl = kb + 8 * i; tile[kl * 65 + nl] = colp ? colp[(size_t)(k0src + kl) * ldsrc] : 0.f; }
    __syncthreads();
    const int n2 = tid >> 3, k8 = (tid & 7) * 8;
    u32x4 w;
    w.x = cvt_pk_bf16(tile[(k8 + 0) * 65 + n2], tile[(k8 + 1) * 65 + n2]); w.y = cvt_pk_bf16(tile[(k8 + 2) * 65 + n2], tile[(k8 + 3) * 65 + n2]);
    w.z = cvt_pk_bf16(tile[(k8 + 4) * 65 + n2], tile[(k8 + 5) * 65 + n2]); w.w = cvt_pk_bf16(tile[(k8 + 6) * 65 + n2], tile[(k8 + 7) * 65 + n2]);
    *(u32x4*)(dst + (size_t)(n0 + n2) * dst_ld + k0dst + k8) = w;
    __syncthreads();
}
__device__ __forceinline__ int win_col(int np) {
    if (np < 5888) {
        const int tile = np >> 8, p = np & 255, hh = p >> 7, pp = p & 127, wc = pp >> 5, n = (pp >> 4) & 1, q = pp & 15;
        const int fatt = (wc & 1) * 16 + (wc >> 1) * 64 + q + 32 * n, fret = 16 * wc + q + 64 * n;
        if (tile < 8) return np;
        if (tile < 12) return 3104 + (2 * (tile - 8) + hh) * 128 + fatt;
        if (tile == 12) return 4128 + hh * 128 + fatt;
        if (tile == 13) return 4384 + p;
        if (tile < 16) return 4640 + (2 * (tile - 14) + hh) * 128 + fret;
        if (tile < 18) return 5152 + (2 * (tile - 16) + hh) * 128 + fret;
        if (tile < 22) return 5664 + (np - 18 * 256);
        return p < 32 ? 3072 + p : -1;
    }
    if (np < 7936) { const int m = np - 5888; return m < 1024 ? 2048 + m : 6688 + (m - 1024); }
    return 7712 + (np - 7936);
}
struct FWin { const float* w; __device__ __forceinline__ const float* operator()(int np) const { const int c = win_col(np); return c < 0 ? nullptr : w + c; } };
struct FPlain { const float* w; __device__ __forceinline__ const float* operator()(int n) const { return w + n; } };
struct FW13 { const float* w1; const float* w3; __device__ __forceinline__ const float* operator()(int np) const { const int tile = np >> 8, r = np & 255; return r < 128 ? w1 + tile * 128 + r : w3 + tile * 128 + (r - 128); } };

constexpr int PRO_MOD = 384, PRO_TAB = 8 + 1056, PRO_WR = 144, PRO_WIN = 2 * 172 * 16, PRO_WBR = 2 * 3 * 16 * 16, PRO_WO3 = 2 * 16 * 48;
constexpr int PRO_UNITS = PRO_MOD + PRO_TAB + PRO_WR + PRO_WIN + PRO_WBR + PRO_WO3;

__device__ __forceinline__ void prologue1(const Params& p, LAS unsigned char* lds) {
    unsigned char* ws = p.ws; const int tid = tid_fresh();
    LAS float* tile = (LAS float*)lds;
    for (int u = blockIdx.x; u < PRO_UNITS; u += gridDim.x) {
        int idx = u;
        if (idx < PRO_MOD) {
            const int l = idx / 192, rem = idx % 192, cb = rem / 16, ks = rem % 16, k0 = ks * 64;
            LAS float* sv = tile;
            for (int e = tid; e < 9 * 64; e += 512) { const int r = e >> 6, kk = e & 63; const float cv = (r < 8) ? p.in[1][r * 1024 + k0 + kk] : p.in[3][k0 + kk]; sv[e] = cv / (1.0f + expf(-cv)); }
            __syncthreads();
            const int n = cb * 512 + tid; const float* w = p.in[4] + ((size_t)l * 1024 + k0) * 6144 + n;
            float a[9];
#pragma unroll
            for (int r = 0; r < 9; ++r) a[r] = 0.f;
            for (int kk = 0; kk < 64; ++kk) { const float wv = w[(size_t)kk * 6144];
#pragma unroll
                for (int r = 0; r < 9; ++r) a[r] += sv[r * 64 + kk] * wv; }
            float* mp = (float*)(ws + OFF_MODP);
#pragma unroll
            for (int r = 0; r < 9; ++r) mp[((size_t)(ks * 2 + l) * 9 + r) * 6144 + n] = a[r];
            __syncthreads();
            continue;
        }
        idx -= PRO_MOD;
        if (idx < PRO_TAB) {
            const int e = idx * 512 + tid;
            if (e < 4096) { const int pos = e >> 5, i = e & 31; const float inv = powf(10000.0f, -(float)i / 32.0f); const float ang = (float)pos * inv; float s, c; sincosf(ang, &s, &c); ((f32x2*)(ws + OFF_ATAB))[e] = (f32x2){c, s}; }
            else { const int e2 = e - 4096; if (e2 < TB * 64) { const int pos = e2 >> 6, i = e2 & 63; const float inv = powf(10000.0f, -(float)i / 64.0f); const float ang = (float)pos * inv; float s, c; sincosf(ang, &s, &c); ((f32x2*)(ws + OFF_RTAB))[e2] = (f32x2){c, s}; } }
            continue;
        }
        idx -= PRO_TAB;
        if (idx < PRO_WR) {
            const int e = idx * 512 + tid; const int o = e % 36, lk = e / 36;
            ((float*)(ws + OFF_WR))[e] = o < 4 ? p.in[18][(size_t)lk * 4 + o] : p.in[20][(size_t)lk * 32 + (o - 4)];
            continue;
        }
        idx -= PRO_WR;
        if (idx < PRO_WIN) {
            const int l = idx / (172 * 16), rem = idx % (172 * 16), nt = rem / 16, kt = rem % 16;
            FWin f{p.in[8] + (size_t)l * 1024 * NIN};
            conv_tile(tile, f, nt * 64, kt * 64, NIN, (bf16_t*)(ws + OFF_WINT) + (size_t)l * WIN_ROWS * 1024, 1024, kt * 64);
            continue;
        }
        idx -= PRO_WIN;
        if (idx < PRO_WBR) {
            const int lb = idx / 256, rem = idx % 256, nt = rem / 16, kt = rem % 16; const int l = lb / 3, br = lb % 3;
            FPlain f{p.in[14 + br] + (size_t)l * 1024 * 1024};
            conv_tile(tile, f, nt * 64, kt * 64, 1024, (bf16_t*)(ws + OFF_WBRT) + (size_t)lb * 1024 * 1024, 1024, kt * 64);
            continue;
        }
        idx -= PRO_WBR;
        {
            const int l = idx / (16 * 48), rem = idx % (16 * 48), nt = rem / 48, kt = rem % 48;
            FPlain f{p.in[17] + (size_t)l * 1024 * 1024};
            conv_tile(tile, f, nt * 64, (kt % 16) * 64, 1024, (bf16_t*)(ws + OFF_WO3T) + (size_t)l * 1024 * 3072, 3072, kt * 64);
        }
    }
}
__device__ __forceinline__ void prologue2(const Params& p) {
    const float* mp = (const float*)(p.ws + OFF_MODP); float* mo = (float*)(p.ws + OFF_MOD);
    for (int e = blockIdx.x * 512 + tid_fresh(); e < 2 * 9 * 6144; e += gridDim.x * 512) {
        const int l = e / (9 * 6144), n = e % 6144;
        float s = p.in[5][l * 6144 + n];
#pragma unroll
        for (int ks = 0; ks < 16; ++ks) s += mp[(size_t)ks * 2 * 9 * 6144 + e];
        mo[e] = s;
    }
}
__device__ __forceinline__ void moe_convert(const Params& p, int layer, LAS unsigned char* lds) {
    LAS float* tile = (LAS float*)lds;
    bf16_t* W13T = (bf16_t*)(p.ws + OFF_REG + M_W13T); bf16_t* W2T = (bf16_t*)(p.ws + OFF_REG + M_W2T);
    for (int u = blockIdx.x; u < 32 * 32 * 16 + 32 * 16 * 16; u += gridDim.x) {
        if (u < 32 * 32 * 16) { const int e = u / 512, rem = u % 512, nt = rem / 16, kt = rem % 16;
            const size_t eo = ((size_t)layer * 32 + e) * 1024 * 1024;
            FW13 f{p.in[22] + eo, p.in[23] + eo};
            conv_tile(tile, f, nt * 64, kt * 64, 1024, W13T + (size_t)e * 2048 * 1024, 1024, kt * 64);
        } else { const int v = u - 32 * 32 * 16; const int e = v / 256, rem = v % 256, nt = rem / 16, kt = rem % 16;
            FPlain f{p.in[24] + ((size_t)layer * 32 + e) * 1024 * 1024};
            conv_tile(tile, f, nt * 64, kt * 64, 1024, W2T + (size_t)e * 1024 * 1024, 1024, kt * 64);
        }
    }
}

template <int MODE>
__device__ __forceinline__ void norm_phase(const Params& p, int layer) {
    unsigned char* ws = p.ws; const int tid_ = tid_fresh(); const int lane = tid_ & 63, wid = tid_ >> 6;
    const float* MOD = (const float*)(ws + OFF_MOD); float* CTXS = (float*)(ws + OFF_CTXS); bf16_t* H = (bf16_t*)(ws + OFF_H);
    const int* TOKSL = (const int*)(ws + OFF_TOKSL); const bf16_t* YS = (const bf16_t*)(ws + OFF_REG + M_XG);
    for (int R = blockIdx.x * 8 + wid; R < TALL; R += gridDim.x * 8) {
        const int b = R / TB, t = R - b * TB; const bool isctx = t < NCTX; const int r9 = isctx ? 8 : b;
        if ((MODE == 3 || (MODE == 2 && layer == 1)) && isctx) continue;
        const float* src; float* dstx;
        if (MODE == 0) { src = isctx ? p.in[2] + ctx_off(b, t) : p.in[0] + lat_off(b, t); dstx = nullptr; }
        else { dstx = isctx ? CTXS + ctx_off(b, t) : p.out + lat_off(b, t); src = dstx; }
        f32x4 x[4];
#pragma unroll
        for (int i = 0; i < 4; ++i) x[i] = *(const f32x4*)(src + 256 * i + 4 * lane);
        if (MODE == 1 || MODE == 3) {
            const int pl = (MODE == 1) ? layer - 1 : 1;
            const float* g2 = MOD + ((size_t)pl * 9 + r9) * 6144 + 5120;
            const int sa = TOKSL[R * 2], sb = TOKSL[R * 2 + 1];
#pragma unroll
            for (int i = 0; i < 4; ++i) { const int c = 256 * i + 4 * lane; const u32x2 ya = *(const u32x2*)(YS + (size_t)sa * 1024 + c), yb = *(const u32x2*)(YS + (size_t)sb * 1024 + c); const f32x4 gv = *(const f32x4*)(g2 + c);
                x[i][0] += gv[0] * (bflo(ya.x) + bflo(yb.x)); x[i][1] += gv[1] * (bfhi(ya.x) + bfhi(yb.x)); x[i][2] += gv[2] * (bflo(ya.y) + bflo(yb.y)); x[i][3] += gv[3] * (bfhi(ya.y) + bfhi(yb.y)); }
            if (MODE == 1) {
#pragma unroll
                for (int i = 0; i < 4; ++i) *(f32x4*)(dstx + 256 * i + 4 * lane) = x[i];
            }
        }
        float ss = 0.f;
#pragma unroll
        for (int i = 0; i < 4; ++i) ss += x[i][0] * x[i][0] + x[i][1] * x[i][1] + x[i][2] * x[i][2] + x[i][3] * x[i][3];
        ss = wave_sum(ss);
        const float rstd = rsqrtf(ss * (1.0f / 1024.0f) + 1e-6f);
        if (MODE == 3) {
#pragma unroll
            for (int i = 0; i < 4; ++i) { const int c = 256 * i + 4 * lane; const f32x4 g = *(const f32x4*)(p.in[25] + c); *(f32x4*)(p.out + lat_off(b, t) + c) = x[i] * rstd * g; }
            continue;
        }
        const float* gain = (MODE == 2 ? p.in[7] : p.in[6]) + layer * 1024;
        const float* mrow = MOD + ((size_t)layer * 9 + r9) * 6144 + (MODE == 2 ? 3072 : 0);
        f32x4 h[4];
#pragma unroll
        for (int i = 0; i < 4; ++i) { const int c = 256 * i + 4 * lane; const f32x4 g = *(const f32x4*)(gain + c), sh = *(const f32x4*)(mrow + c), sc = *(const f32x4*)(mrow + 1024 + c);
            h[i] = (x[i] * rstd * g) * (sc + 1.0f) + sh;
            u32x2 w; w.x = cvt_pk_bf16(h[i][0], h[i][1]); w.y = cvt_pk_bf16(h[i][2], h[i][3]); *(u32x2*)(H + (size_t)R * 1024 + c) = w; }
        if (MODE == 2) {
            const float* WR = (const float*)(ws + OFF_WR) + (size_t)layer * 1024 * 36;
            float a[36];
#pragma unroll
            for (int o = 0; o < 36; ++o) a[o] = 0.f;
#pragma unroll
            for (int i = 0; i < 4; ++i)
#pragma unroll
                for (int jj = 0; jj < 4; ++jj) { const float hv = h[i][jj]; const f32x4* wrow = (const f32x4*)(WR + (size_t)(256 * i + 4 * lane + jj) * 36);
#pragma unroll
                    for (int o4 = 0; o4 < 9; ++o4) { const f32x4 w = wrow[o4]; a[4 * o4] += hv * w[0]; a[4 * o4 + 1] += hv * w[1]; a[4 * o4 + 2] += hv * w[2]; a[4 * o4 + 3] += hv * w[3]; } }
#pragma unroll
            for (int o = 0; o < 36; ++o) a[o] = wave_sum(a[o]);
            if (lane == 0) {
                const float* bg = p.in[19] + layer * 4; const float* be = p.in[21] + layer * 32;
                float gl[4];
#pragma unroll
                for (int j = 0; j < 4; ++j) gl[j] = a[j] + bg[j];
                int grp = 0; float gm = gl[0];
#pragma unroll
                for (int j = 1; j < 4; ++j) if (gl[j] > gm) { gm = gl[j]; grp = j; }
                float den = 0.f;
#pragma unroll
                for (int j = 0; j < 4; ++j) den += expf(gl[j] - gm);
                const float gp = 1.0f / den;
                float v1 = -3.0e38f, v2 = -3.0e38f; int i1 = 0, i2 = 0;
#pragma unroll
                for (int j = 0; j < 8; ++j) {
                    const float lv = (grp == 0 ? a[4 + j] : grp == 1 ? a[12 + j] : grp == 2 ? a[20 + j] : a[28 + j]) + be[grp * 8 + j];
                    if (lv > v1) { v2 = v1; i2 = i1; v1 = lv; i1 = j; } else if (lv > v2) { v2 = lv; i2 = j; }
                }
                const float e2 = expf(v2 - v1); const float w1 = gp / (1.0f + e2), w2 = gp * e2 / (1.0f + e2);
                const int ex1 = grp * 8 + i1, ex2 = grp * 8 + i2;
                unsigned* cnt = (unsigned*)(ws + OFF_CNT) + layer * 32;
                const unsigned r1 = atomicAdd(cnt + ex1, 1u), r2 = atomicAdd(cnt + ex2, 1u);
                int* EX = (int*)(ws + OFF_EXPID); float* GW = (float*)(ws + OFF_GATEW); int* RK = (int*)(ws + OFF_RANK);
                EX[R * 2] = ex1; EX[R * 2 + 1] = ex2; GW[R * 2] = w1; GW[R * 2 + 1] = w2; RK[R * 2] = (int)r1; RK[R * 2 + 1] = (int)r2;
            }
        }
    }
}

__device__ __forceinline__ void moe_table(const Params& p, int layer, LAS int* tab) {
    if (tid_fresh() == 0) {
        const unsigned* cnt = (const unsigned*)(p.ws + OFF_CNT) + layer * 32; int s = 0, tl = 0;
        for (int e = 0; e < 32; ++e) { const int c = (int)__hip_atomic_load(cnt + e, __ATOMIC_RELAXED, __HIP_MEMORY_SCOPE_AGENT); tab[e] = c; tab[32 + e] = s; tab[64 + e] = tl; s += c; tl += (c + 255) >> 8; }
        tab[96] = tl;
    }
    __syncthreads();
}
__device__ __forceinline__ void dispatch_phase(const Params& p, int layer, LAS int* tab) {
    unsigned char* ws = p.ws; const int tid_ = tid_fresh(); const int lane = tid_ & 63, wid = tid_ >> 6;
    moe_table(p, layer, tab);
    const int* EX = (const int*)(ws + OFF_EXPID); const float* GW = (const float*)(ws + OFF_GATEW); const int* RK = (const int*)(ws + OFF_RANK);
    int* TOKSL = (int*)(ws + OFF_TOKSL); float* SLOTW = (float*)(ws + OFF_SLOTW);
    const bf16_t* H = (const bf16_t*)(ws + OFF_H); bf16_t* XG = (bf16_t*)(ws + OFF_REG + M_XG);
    for (int R = blockIdx.x * 8 + wid; R < TALL; R += gridDim.x * 8) {
        const int t = R % TB; if (layer == 1 && t < NCTX) continue;
        const u32x4 h0 = *(const u32x4*)(H + (size_t)R * 1024 + lane * 8), h1 = *(const u32x4*)(H + (size_t)R * 1024 + 512 + lane * 8);
#pragma unroll
        for (int k = 0; k < 2; ++k) {
            const int e = EX[R * 2 + k]; const int slot = tab[32 + e] + RK[R * 2 + k];
            if (lane == 0) { TOKSL[R * 2 + k] = slot; SLOTW[slot] = GW[R * 2 + k]; }
            *(u32x4*)(XG + (size_t)slot * 1024 + lane * 8) = h0; *(u32x4*)(XG + (size_t)slot * 1024 + 512 + lane * 8) = h1;
        }
    }
}

__device__ __forceinline__ void gate_phase(const Params& p, int layer, int g, LAS unsigned char* lds) {
    unsigned char* reg = p.ws + OFF_REG; const int tid = tid_fresh();
    const bf16_t* GQK = (const bf16_t*)(reg + R_GQK); bf16_t* GIN = (bf16_t*)(reg + R_GIN); float* GDEC = (float*)(reg + R_GDEC); const float* GLR = (const float*)(reg + R_GLR);
    LAS float* lr = (LAS float*)lds;
    const float* wa = p.in[9] + (size_t)layer * 2 * 16 * 512; const float* ba = p.in[10] + layer * 2 * 512;
    float wf[16], wb[16];
#pragma unroll
    for (int r = 0; r < 16; ++r) { wf[r] = wa[r * 512 + tid]; wb[r] = wa[(16 + r) * 512 + tid]; }
    const float baf = ba[tid], bab = ba[512 + tid];
    for (int u = blockIdx.x; u < BG * NCH; u += gridDim.x) {
        const int bl = u / NCH, ch = u - bl * NCH; const int r0 = bl * TB + ch * CH;
        __syncthreads();
        for (int e = tid; e < 64 * 32; e += 512) lr[e] = GLR[(size_t)r0 * 32 + e];
        __syncthreads();
        float cum = 0.f;
        for (int j = 0; j < CH; ++j) {
            float z = baf;
#pragma unroll
            for (int r = 0; r < 16; ++r) z += lr[j * 32 + r] * wf[r];
            const float la = -(fmaxf(-z, 0.f) + log1pf(expf(-fabsf(z)))) * (1.0f / 16.0f);
            cum += la; const float e = expf(cum);
            const size_t ro = (size_t)(r0 + j) * 1024;
            GIN[ro + tid] = f2bf(bf2f(GQK[ro + tid]) * e); GIN[ro + 512 + tid] = f2bf(bf2f(GQK[ro + 512 + tid]) / e);
        }
        GDEC[((size_t)(0 * BG + bl) * NCH + ch) * 512 + tid] = expf(cum);
        cum = 0.f;
        for (int j = CH - 1; j >= 0; --j) {
            float z = bab;
#pragma unroll
            for (int r = 0; r < 16; ++r) z += lr[j * 32 + 16 + r] * wb[r];
            const float la = -(fmaxf(-z, 0.f) + log1pf(expf(-fabsf(z)))) * (1.0f / 16.0f);
            cum += la; const float e = expf(cum);
            const size_t ro = (size_t)(r0 + j) * 1024;
            GIN[(size_t)TG * 1024 + ro + tid] = f2bf(bf2f(GQK[ro + tid]) * e); GIN[(size_t)TG * 1024 + ro + 512 + tid] = f2bf(bf2f(GQK[ro + 512 + tid]) / e);
        }
        GDEC[((size_t)(1 * BG + bl) * NCH + ch) * 512 + tid] = expf(cum);
    }
}
__device__ __forceinline__ void stats_phase(const Params& p, int g) {
    unsigned char* reg = p.ws + OFF_REG; const int tid_ = tid_fresh(); const int lane = tid_ & 63, wid = tid_ >> 6;
    f32x2* ST = (f32x2*)(p.ws + OFF_STATS);
    for (int R = blockIdx.x * 8 + wid; R < TG; R += gridDim.x * 8) {
#pragma unroll
        for (int mix = 0; mix < 2; ++mix) {
            bf16_t* of = (bf16_t*)(reg + (mix ? R_ORF : R_OGF)) + (size_t)R * 1024; const bf16_t* ob = (const bf16_t*)(reg + (mix ? R_ORB : R_OGB)) + (size_t)R * 1024;
#pragma unroll
            for (int i = 0; i < 4; ++i) {
                const int c = 256 * i + 4 * lane; const u32x2 a = *(const u32x2*)(of + c), b2 = *(const u32x2*)(ob + c);
                const float o0 = bflo(a.x) + bflo(b2.x), o1 = bfhi(a.x) + bfhi(b2.x), o2 = bflo(a.y) + bflo(b2.y), o3 = bfhi(a.y) + bfhi(b2.y);
                const float mean = wave_sum(o0 + o1 + o2 + o3) * (1.0f / 256.0f);
                const float d0 = o0 - mean, d1 = o1 - mean, d2 = o2 - mean, d3 = o3 - mean;
                const float var = wave_sum(d0 * d0 + d1 * d1 + d2 * d2 + d3 * d3) * (1.0f / 256.0f);
                u32x2 w; w.x = cvt_pk_bf16(o0, o1); w.y = cvt_pk_bf16(o2, o3); *(u32x2*)(of + c) = w;
                if (lane == 0) ST[((size_t)mix * TG + R) * 4 + i] = (f32x2){mean, rsqrtf(var + 1e-6f)};
            }
        }
    }
}

#if NAIVE_SCAN
__device__ __forceinline__ void scan_naive(const Params& p, int layer, int g, LAS unsigned char* lds) {
    unsigned char* reg = p.ws + OFF_REG; const int tid = tid_fresh(), sub = tid >> 8, e = tid & 255;
    LAS float* sh = (LAS float*)lds + sub * 512;
    for (int u = blockIdx.x; u < 32; u += gridDim.x) {
        const int chain = u * 2 + sub; const int dir = chain & 1, h = (chain >> 1) & 3, bl = (chain >> 3) & 3, mix = chain >> 5;
        const bf16_t* QK = (const bf16_t*)(reg + (mix ? R_RQK : R_GQK)); const bf16_t* VT = (const bf16_t*)(reg + (mix ? R_RVT : R_GVT));
        bf16_t* O = (bf16_t*)(reg + (mix ? (dir ? R_ORB : R_ORF) : (dir ? R_OGB : R_OGF)));
        const float* GLR = (const float*)(reg + R_GLR);
        float wa[16]; float bav = 0.f;
        if (e < 128) {
#pragma unroll
            for (int r = 0; r < 16; ++r) wa[r] = p.in[9][(((size_t)layer * 2 + dir) * 16 + r) * 512 + h * 128 + e];
            bav = p.in[10][((size_t)layer * 2 + dir) * 512 + h * 128 + e];
        }
        const float gam = 1.0f - exp2f(-5.0f - (float)h);
        float S[128];
#pragma unroll
        for (int d = 0; d < 128; ++d) S[d] = 0.f;
        const bf16_t* vrow = VT + ((size_t)bl * 1024 + h * 256 + e) * TB;
        for (int s = 0; s < TB; ++s) {
            const int t = dir == 0 ? s : (s < NCTX ? NCTX - 1 - s : TB - 1 - (s - NCTX));
            const size_t ro = (size_t)(bl * TB + t);
            __syncthreads();
            if (e < 128) {
                sh[e] = bf2f(QK[ro * 1024 + h * 128 + e]); sh[128 + e] = bf2f(QK[ro * 1024 + 512 + h * 128 + e]);
                float a;
                if (mix == 0) { float z = bav;
#pragma unroll
                    for (int r = 0; r < 16; ++r) z += GLR[ro * 32 + dir * 16 + r] * wa[r];
                    a = expf(-(fmaxf(-z, 0.f) + log1pf(expf(-fabsf(z)))) * (1.0f / 16.0f)); }
                else a = gam;
                sh[256 + e] = a;
            }
            __syncthreads();
            const float v = bf2f(vrow[t]);
            float o = 0.f;
            if (dir == 0) {
#pragma unroll
                for (int d = 0; d < 128; ++d) { S[d] = sh[256 + d] * S[d] + sh[128 + d] * v; o += sh[d] * S[d]; }
            } else {
#pragma unroll
                for (int d = 0; d < 128; ++d) { const float sd = sh[256 + d] * S[d]; o += sh[d] * sd; S[d] = sd + sh[128 + d] * v; }
            }
            O[ro * 1024 + h * 256 + e] = f2bf(o);
        }
    }
}
#endif

#if NAIVE_ATTN
__device__ __forceinline__ void attn_naive(const Params& p, int layer, int g, LAS unsigned char* lds) {
    unsigned char* reg = p.ws + OFF_REG; const int tid_ = tid_fresh(); const int lane = tid_ & 63, wid = tid_ >> 6;
    bf16_t* AQ = (bf16_t*)(reg + R_AQ); const bf16_t* AK = (const bf16_t*)(reg + R_AK); const bf16_t* AVT = (const bf16_t*)(reg + R_AVT);
    LAS float* qs = (LAS float*)lds + wid * 1024; LAS float* ps = qs + 128;
    for (int u = blockIdx.x; u < TG / 64; u += gridDim.x) {
#pragma unroll 1
        for (int pr = wid; pr < 512; pr += 8) {
            const int R = u * 64 + (pr >> 3), hq = pr & 7, hkv = hq >> 2; const int bl = R / TB, t = R - bl * TB;
            { const unsigned w = *(const unsigned*)(AQ + (size_t)R * 1024 + hq * 128 + 2 * lane); qs[2 * lane] = bflo(w); qs[2 * lane + 1] = bfhi(w); }
            const bool lat = t >= NCTX; const int i = t - NCTX;
            const int jlo = lat ? (i - 128 < 0 ? 0 : i - 128) : 0, jhi = lat ? (i + 128 > LSEQ - 1 ? LSEQ - 1 : i + 128) : -1;
            const float sink2 = p.in[12][layer * 8 + hq] * LOG2E;
            float mx = sink2;
#pragma unroll 1
            for (int rd = 0; rd < 9; ++rd) {
                int key; bool valid;
                if (rd < 4) { key = rd * 64 + lane; valid = true; } else { const int j = jlo + (rd - 4) * 64 + lane; key = NCTX + j; valid = j <= jhi; }
                float s = -3.0e38f;
                if (valid) { const bf16_t* kr = AK + (size_t)(bl * TB + key) * 256 + hkv * 128; s = 0.f;
#pragma unroll 4
                    for (int d8 = 0; d8 < 16; ++d8) { const u32x4 kv = *(const u32x4*)(kr + d8 * 8); const LAS float* q = qs + d8 * 8;
                        s += q[0] * bflo(kv.x) + q[1] * bfhi(kv.x) + q[2] * bflo(kv.y) + q[3] * bfhi(kv.y) + q[4] * bflo(kv.z) + q[5] * bfhi(kv.z) + q[6] * bflo(kv.w) + q[7] * bfhi(kv.w); } }
                ps[rd * 64 + lane] = s; mx = fmaxf(mx, s);
            }
            mx = wave_max(mx);
            float sum = 0.f;
#pragma unroll 1
            for (int rd = 0; rd < 9; ++rd) { const float sv = ps[rd * 64 + lane]; const float pv = sv > -1.0e38f ? exp2f(sv - mx) : 0.f; ps[rd * 64 + lane] = pv; sum += pv; }
            sum = wave_sum(sum) + exp2f(sink2 - mx);
            const float inv = 1.0f / sum;
            float o0 = 0.f, o1 = 0.f;
            const bf16_t* v0 = AVT + ((size_t)bl * 256 + hkv * 128 + 2 * lane) * TB; const bf16_t* v1 = v0 + TB;
#pragma unroll 4
            for (int k = 0; k < NCTX; ++k) { const float pv = ps[k]; o0 += pv * bf2f(v0[k]); o1 += pv * bf2f(v1[k]); }
#pragma unroll 4
            for (int j = jlo; j <= jhi; ++j) { const float pv = ps[256 + (j - jlo)]; o0 += pv * bf2f(v0[NCTX + j]); o1 += pv * bf2f(v1[NCTX + j]); }
            *(unsigned*)(AQ + (size_t)R * 1024 + hq * 128 + 2 * lane) = cvt_pk_bf16(o0 * inv, o1 * inv);
        }
    }
}
#endif

__global__ void __launch_bounds__(512, 2) mega(Params p) {
    extern __shared__ __attribute__((aligned(16))) unsigned char smem_raw[];
    LAS unsigned char* lds = (LAS unsigned char*)smem_raw;
    LAS unsigned* xbw = (LAS unsigned*)(lds + 131072);
    LAS int* tab = (LAS int*)(lds + 131072 + 256);
    if (threadIdx.x == 0) { xbw[0] = 0u; xbw[1] = 0u; xbw[2] = 0u; xbw[3] = 0u; }
    __syncthreads();
    unsigned char* ws = p.ws;
    XcdBarrier bar = xcd_barrier_post((unsigned*)(ws + OFF_BAR), (volatile LAS unsigned*)xbw);
    int ph = 0;
#define PH_ON (ph >= p.ph0 && ph < p.ph1)
#define PH_END do { if (ph >= p.ph0 && ph + 1 < p.ph1) xcd_barrier(bar); ++ph; } while (0)
    if (PH_ON && PSEL_OK(0)) prologue1(p, lds);
    PH_END;
    if (PH_ON && PSEL_OK(1)) prologue2(p);
    PH_END;
    for (int layer = 0; layer < 2; ++layer) {
        if (PH_ON && PSEL_OK(2)) { if (layer == 0) norm_phase<0>(p, 0); else norm_phase<1>(p, 1); }
        PH_END;
        for (int g = 0; g < NGRP; ++g) {
            unsigned char* reg = ws + OFF_REG;
            const bf16_t* Hg = (const bf16_t*)(ws + OFF_H) + (size_t)g * TG * 1024;
            const bf16_t* WIN = (const bf16_t*)(ws + OFF_WINT) + (size_t)layer * WIN_ROWS * 1024;
            if (PH_ON && PSEL_OK(3)) {
                SchedDense S{}; S.A = Hg; S.B = WIN; S.lda = 1024; S.K = 1024; S.nM = TG / 256; S.nN = 23; S.nNb = 23;
                EpiQKV E{reg, g, (const f32x2*)(ws + OFF_ATAB), (const f32x2*)(ws + OFF_RTAB)};
                g8::gemm_call(lds, S, E);
            }
            PH_END;
            if (PH_ON && PSEL_OK(4)) gate_phase(p, layer, g, lds);
            PH_END;
            if (PH_ON && PSEL_OK(5)) {
#if NAIVE_SCAN
                scan_naive(p, layer, g, lds);
#endif
            }
            PH_END;
            if (PH_ON && PSEL_OK(6)) {
#if NAIVE_ATTN
                attn_naive(p, layer, g, lds);
#endif
            }
            PH_END;
            if (PH_ON && PSEL_OK(7)) stats_phase(p, g);
            PH_END;
            if (PH_ON && PSEL_OK(8)) {
                SchedDense S{}; S.A = Hg; S.B = WIN + (size_t)5888 * 1024; S.lda = 1024; S.K = 1024; S.nM = TG / 256; S.nN = 8; S.nNb = 8;
                EpiGateR E{reg, (const f32x2*)(ws + OFF_STATS), p.in[11] + layer * 1024, p.in[13] + layer * 1024};
                g8::gemm_call(lds, S, E);
            }
            PH_END;
            if (PH_ON && PSEL_OK(9)) {
                SchedDense S{}; S.A = (const bf16_t*)(reg + R_OGF); S.strideA = (size_t)TG * 1024;
                const bf16_t* WB = (const bf16_t*)(ws + OFF_WBRT) + (size_t)layer * 3 * 1024 * 1024;
                S.B = WB; S.strideB = (size_t)1024 * 1024; S.lda = 1024; S.K = 1024; S.nM = TG / 256; S.nN = 12; S.nNb = 4;
                EpiBf16 E{(bf16_t*)(reg + R_GQK), 3072};
                g8::gemm_call(lds, S, E);
            }
            PH_END;
            if (PH_ON && PSEL_OK(10)) {
                SchedDense S{}; S.A = Hg; S.B = WIN + (size_t)7936 * 1024; S.lda = 1024; S.K = 1024; S.nM = TG / 256; S.nN = 12; S.nNb = 12;
                EpiGZ E{(bf16_t*)(reg + R_GQK)};
                g8::gemm_call(lds, S, E);
            }
            PH_END;
            if (PH_ON && PSEL_OK(11)) {
                SchedDense S{}; S.A = (const bf16_t*)(reg + R_GQK); const bf16_t* WO = (const bf16_t*)(ws + OFF_WO3T) + (size_t)layer * 1024 * 3072;
                S.B = WO; S.lda = 3072; S.K = 3072; S.nM = TG / 256; S.nN = 4; S.nNb = 4;
                EpiOut E{layer == 0 ? p.in[0] : p.out, layer == 0 ? p.in[2] : (const float*)(ws + OFF_CTXS), p.out, (float*)(ws + OFF_CTXS), (const float*)(ws + OFF_MOD) + (size_t)layer * 9 * 6144, g};
                g8::gemm_call(lds, S, E);
            }
            PH_END;
        }
        if (PH_ON && PSEL_OK(12)) moe_convert(p, layer, lds);
        PH_END;
        if (PH_ON && PSEL_OK(13)) norm_phase<2>(p, layer);
        PH_END;
        if (PH_ON && PSEL_OK(14)) dispatch_phase(p, layer, tab);
        PH_END;
        if (PH_ON && PSEL_OK(15)) {
            moe_table(p, layer, tab);
            SchedMoe S{(const bf16_t*)(ws + OFF_REG + M_XG), (const bf16_t*)(ws + OFF_REG + M_W13T), 1024, 1024, 8, 2048, tab};
            EpiMoe1 E{(bf16_t*)(ws + OFF_REG + M_HMID)};
            g8::gemm_call(lds, S, E);
        }
        PH_END;
        if (PH_ON && PSEL_OK(16)) {
            moe_table(p, layer, tab);
            SchedMoe S{(const bf16_t*)(ws + OFF_REG + M_HMID), (const bf16_t*)(ws + OFF_REG + M_W2T), 1024, 1024, 4, 1024, tab};
            EpiMoe2 E{(bf16_t*)(ws + OFF_REG + M_XG), (const float*)(ws + OFF_SLOTW)};
            g8::gemm_call(lds, S, E);
        }
        PH_END;
    }
    if (PH_ON && PSEL_OK(17)) norm_phase<3>(p, 1);
    PH_END;
}
constexpr int N_PHASES = 2 + 2 * (1 + NGRP * 9 + 5) + 1;

extern "C" void kernel_launch(void* const* d_in, const int* in_sizes, int n_in, void* d_out, int out_size, void* d_ws, size_t ws_size, hipStream_t stream) {
    static int grid = 0;
    if (!grid) {
        int dev = 0, cus = 0, per_cu = 0;
        hipGetDevice(&dev);
        hipDeviceGetAttribute(&cus, hipDeviceAttributeMultiprocessorCount, dev);
        hipFuncSetAttribute((const void*)mega, hipFuncAttributeMaxDynamicSharedMemorySize, LDS_BYTES);
        hipOccupancyMaxActiveBlocksPerMultiprocessor(&per_cu, mega, 512, LDS_BYTES);
        grid = per_cu >= 1 ? cus : 0;
    }
    if (!grid || ws_size < WS_NEED || n_in < 26) { fprintf(stderr, "kernel_launch: cannot run (grid %d, ws %zu need %zu)\n", grid, ws_size, (size_t)WS_NEED); return; }
    hipMemsetAsync(d_ws, 0, ZERO_BYTES, stream);
    Params p{};
    for (int i = 0; i < 26; ++i) p.in[i] = (const float*)d_in[i];
    p.out = (float*)d_out; p.ws = (unsigned char*)d_ws;
#if MK_MULTI
    for (int ph = 0; ph < N_PHASES; ++ph) { p.ph0 = ph; p.ph1 = ph + 1; hipLaunchKernelGGL(mega, dim3(grid), dim3(512), LDS_BYTES, stream, p); }
#else
    p.ph0 = 0; p.ph1 = N_PHASES;
    hipLaunchKernelGGL(mega, dim3(grid), dim3(512), LDS_BYTES, stream, p);
#endif
}
```

```cpp
#include <hip/hip_runtime.h>
#include <stdint.h>
#include <stdio.h>

#ifndef MK_MULTI
#define MK_MULTI 0
#endif
#ifndef NAIVE_SCAN
#define NAIVE_SCAN 1
#endif
#ifndef SCAN_MASK
#define SCAN_MASK 15
#endif
#ifndef SCAN_E1
#define SCAN_E1 0
#endif
#ifndef E2_SEL
#define E2_SEL (layer == 1 && g == 0 && mix == 1 && ch == 126 && (u & 7) == 2)
#endif
#ifndef LDS_POISON
#define LDS_POISON 0
#endif
#ifndef SCAN_DELAY
#define SCAN_DELAY 0
#endif
#ifndef E2_KEY
#define E2_KEY (fminf(60000.0f, 100.0f * fmaxf(fmaxf(fabsf(c[0] - r0_), fabsf(c[1] - r1_)), fmaxf(fabsf(c[2] - r2_), fabsf(c[3] - r3_)))))
#endif
#ifndef REP_MASK
#define REP_MASK 0u
#define REP_N 3
#endif
#ifndef BAR_PROBE
#define BAR_PROBE 0
#endif
#ifndef NAIVE_ATTN
#define NAIVE_ATTN 0
#endif

#define LAS __attribute__((address_space(3)))
#ifndef PSEL
#define PSEL -1
#endif
#ifndef PMASK
#define PMASK 0xFFFFFFFFu
#endif
#define PSEL_OK(t) ((PSEL < 0 || PSEL == (t)) && ((PMASK >> (t)) & 1u))
typedef unsigned short bf16_t;
typedef short bf16x8 __attribute__((ext_vector_type(8)));
typedef float f32x4 __attribute__((ext_vector_type(4)));
typedef float f32x2 __attribute__((ext_vector_type(2)));
typedef unsigned u32x4 __attribute__((ext_vector_type(4)));
typedef unsigned u32x2 __attribute__((ext_vector_type(2)));

constexpr int D = 1024, NBATCH = 8, LSEQ = 8192, NCTX = 256, TB = 8448, TALL = 67584;
constexpr int NGRP = 2, BG = 4, TG = 33792;
constexpr int NIN = 10784, NE = 32;
constexpr int NSLOT = 2 * TALL;
constexpr int WIN_ROWS = 11008;
constexpr int CH = 64, NCH = TB / CH;
constexpr float LOG2E = 1.4426950408889634f;

constexpr size_t al(size_t x) { return (x + 4095) & ~(size_t)4095; }
constexpr size_t OFF_BAR   = 0;
constexpr size_t OFF_CNT   = 16384;
constexpr size_t ZERO_BYTES = 32768;
constexpr size_t OFF_MOD   = ZERO_BYTES;
constexpr size_t OFF_MODP  = OFF_MOD   + al((size_t)2 * 9 * 6144 * 4);
constexpr size_t OFF_ATAB  = OFF_MODP  + al((size_t)16 * 2 * 9 * 6144 * 4);
constexpr size_t OFF_RTAB  = OFF_ATAB  + al((size_t)128 * 32 * 8);
constexpr size_t OFF_WR    = OFF_RTAB  + al((size_t)TB * 64 * 8);
constexpr size_t OFF_CTXS  = OFF_WR    + al((size_t)2 * 2 * 48 * 1024 * 2);
constexpr size_t OFF_WINT  = OFF_CTXS  + al((size_t)8 * 256 * 1024 * 4);
constexpr size_t OFF_WBRT  = OFF_WINT  + al((size_t)2 * WIN_ROWS * 1024 * 2);
constexpr size_t OFF_WO3T  = OFF_WBRT  + al((size_t)2 * 3 * 1024 * 1024 * 2);
constexpr size_t OFF_WO1T  = OFF_WO3T  + al((size_t)2 * 1024 * 3072 * 2);
constexpr size_t OFF_EXPID = OFF_WO1T  + al((size_t)2 * 1024 * 1024 * 2);
constexpr size_t OFF_GATEW = OFF_EXPID + al((size_t)TALL * 2 * 4);
constexpr size_t OFF_RANK  = OFF_GATEW + al((size_t)TALL * 2 * 4);
constexpr size_t OFF_TOKSL = OFF_RANK  + al((size_t)TALL * 2 * 4);
constexpr size_t OFF_SLOTW = OFF_TOKSL + al((size_t)TALL * 2 * 4);
constexpr size_t OFF_SLOTTOK = OFF_SLOTW + al((size_t)(NSLOT + 256) * 4);
constexpr size_t OFF_STATS = OFF_SLOTTOK + al((size_t)(NSLOT + 256) * 4);
constexpr size_t OFF_H     = OFF_STATS + al((size_t)2 * TG * 4 * 8);
constexpr size_t OFF_REG   = OFF_H     + al((size_t)TALL * 1024 * 2);
constexpr size_t SZ_T1K = (size_t)TG * 1024 * 2;
constexpr size_t R_GQK  = 0;
constexpr size_t R_GIN  = R_GQK + SZ_T1K;
constexpr size_t R_GDEC = R_GIN + 2 * SZ_T1K;
constexpr size_t R_GVT  = R_GDEC + al((size_t)2 * BG * NCH * 512 * 4);
constexpr size_t R_GLR  = R_GVT + SZ_T1K;
constexpr size_t R_AK   = R_GLR + al((size_t)TG * 32 * 4);
constexpr size_t R_AVT  = R_AK + SZ_T1K / 4;
constexpr size_t R_RQK  = R_AVT + SZ_T1K / 4;
constexpr size_t R_RVT  = R_RQK + SZ_T1K;
constexpr size_t R_OGF  = R_RVT + SZ_T1K;
constexpr size_t R_AQ   = R_OGF + SZ_T1K;
constexpr size_t R_ORF  = R_AQ + SZ_T1K;
constexpr size_t R_OGB  = R_ORF + SZ_T1K;
constexpr size_t R_ORB  = R_OGB + SZ_T1K;
constexpr size_t R_ZG0  = R_ORB + SZ_T1K;
constexpr size_t R_MIX_END = R_ZG0 + 3 * SZ_T1K;
constexpr size_t M_W13T = 0;
constexpr size_t M_W2T  = M_W13T + (size_t)32 * 2048 * 1024 * 2;
constexpr size_t M_XG   = M_W2T + (size_t)32 * 1024 * 1024 * 2;
constexpr size_t M_HMID = M_XG + al((size_t)(NSLOT + 256) * 1024 * 2);
constexpr size_t M_END  = M_HMID + al((size_t)(NSLOT + 256) * 1024 * 2);
constexpr size_t REG_BYTES = R_MIX_END > M_END ? R_MIX_END : M_END;
constexpr size_t WS_NEED = OFF_REG + REG_BYTES;

constexpr int LDS_BYTES = 155648;

struct Params {
    const float* in[26];
    float* out;
    unsigned char* ws;
    int ph0, ph1;
};
typedef const __attribute__((address_space(4))) Params KPS;
typedef KPS& KP;

__device__ __forceinline__ bf16_t f2bf(float f) { unsigned u = __float_as_uint(f); u += 0x7FFFu + ((u >> 16) & 1u); return (bf16_t)(u >> 16); }
__device__ __forceinline__ float bf2f(unsigned b) { return __uint_as_float(b << 16); }
__device__ __forceinline__ float bflo(unsigned w) { return __uint_as_float(w << 16); }
__device__ __forceinline__ float bfhi(unsigned w) { return __uint_as_float(w & 0xFFFF0000u); }
typedef __bf16 bf16x2_t __attribute__((ext_vector_type(2)));
__device__ __forceinline__ unsigned cvt_pk_bf16(float lo, float hi) { const f32x2 v = (f32x2){lo, hi}; const bf16x2_t b = __builtin_convertvector(v, bf16x2_t); return __builtin_bit_cast(unsigned, b); }
__device__ __forceinline__ float sx(float v, int m, int lane) { return __int_as_float(__builtin_amdgcn_ds_bpermute((lane ^ m) << 2, __float_as_int(v))); }
__device__ __forceinline__ float wave_sum(float v, int lane) {
#pragma unroll
    for (int o = 32; o; o >>= 1) v += sx(v, o, lane);
    return v;
}
__device__ __forceinline__ float wave_max(float v, int lane) {
#pragma unroll
    for (int o = 32; o; o >>= 1) v = fmaxf(v, sx(v, o, lane));
    return v;
}
__device__ __forceinline__ int tid_fresh() { int t = threadIdx.x; asm volatile("" : "+v"(t)); return t; }
__device__ __forceinline__ int bid_fresh() { int t = blockIdx.x; asm volatile("" : "+s"(t)); return t; }
__device__ __forceinline__ float sigmoid_f(float x) { return __builtin_amdgcn_rcpf(1.0f + __builtin_amdgcn_exp2f(x * -LOG2E)); }
__device__ __forceinline__ float silu_f(float x) { return x * sigmoid_f(x); }

#define XB_TMO      128
#define XB_XCNT(j)  (256  + 64 * (j))
#define XB_XSUB(j)  (1280 + 64 * (j))
#define XB_XGEN(j)  (2304 + 64 * (j))
#define XB_TOP      3328
#define XB_TOPGEN   3392
#define XCD_BAR_WORDS 3456
#define XB_SPIN_CAP (1u << 18)

__device__ __forceinline__ unsigned xb_ld(unsigned* p)              { return __hip_atomic_load(p, __ATOMIC_RELAXED, __HIP_MEMORY_SCOPE_AGENT); }
__device__ __forceinline__ unsigned xb_add(unsigned* p, unsigned v) { return __hip_atomic_fetch_add(p, v, __ATOMIC_RELAXED, __HIP_MEMORY_SCOPE_AGENT); }
__device__ __forceinline__ unsigned xb_xcc_id() { return (unsigned)__builtin_amdgcn_s_getreg((3 << 11) | 20) & 0xFu; }
#define XB_SPIN(cond, bar) do { unsigned _sp = 0; while (cond) { __builtin_amdgcn_s_sleep(1); \
    if ((++_sp & 255u) == 0u) { if (xb_ld(&(bar)[XB_TMO])) break; if (_sp > XB_SPIN_CAP) { atomicAdd(&(bar)[XB_TMO], 1u); break; } } } } while (0)

struct XcdBarrier { unsigned* bar; unsigned x; volatile LAS unsigned* st; };

__device__ __forceinline__ XcdBarrier xcd_barrier_post(unsigned* bar, volatile LAS unsigned* st) {
    XcdBarrier b; b.bar = bar; b.x = xb_xcc_id(); b.st = st;
    if (threadIdx.x == 0) (void)xb_add(&bar[XB_XCNT(b.x)], 1u);
    return b;
}
__device__ __forceinline__ void xcd_barrier_complete(unsigned* bar, unsigned x, unsigned& nloc, unsigned& nx) {
    const unsigned G = gridDim.x * gridDim.y * gridDim.z;
    unsigned sum, cnt, mine, sp = 0u;
    for (;;) {
        sum = 0u; cnt = 0u; mine = 0u;
#pragma unroll
        for (unsigned j = 0; j < 16; ++j) { const unsigned c = xb_ld(&bar[XB_XCNT(j)]); sum += c; cnt += (c > 0u) ? 1u : 0u; mine = (j == x) ? c : mine; }
        if (sum == G) break;
        __builtin_amdgcn_s_sleep(1);
        if ((++sp & 255u) == 0u) { if (xb_ld(&bar[XB_TMO])) break; if (sp > XB_SPIN_CAP) { atomicAdd(&bar[XB_TMO], 1u); break; } }
    }
    nloc = mine > 0u ? mine : 1u; nx = cnt > 0u ? cnt : 1u;
}
__device__ __forceinline__ void xcd_barrier(const XcdBarrier& b) {
    asm volatile("s_waitcnt vmcnt(0)" ::: "memory");
    __syncthreads();
    if (threadIdx.x == 0) {
        unsigned* bar = b.bar;
        __builtin_amdgcn_s_waitcnt(0);
        unsigned nloc = b.st[0], nx = b.st[1];
        if (nloc == 0u) { xcd_barrier_complete(bar, b.x, nloc, nx); b.st[0] = nloc; b.st[1] = nx; }
        const unsigned old = xb_add(&bar[XB_XSUB(b.x)], 1u);
        const unsigned gen = old / nloc;
        if (old + 1u == (gen + 1u) * nloc) {
            __builtin_amdgcn_fence(__ATOMIC_RELEASE, "agent");
            asm volatile("s_waitcnt vmcnt(0)" ::: "memory");
            const unsigned og = xb_add(&bar[XB_TOP], 1u);
            const unsigned tg = og / nx;
            if (og + 1u == (tg + 1u) * nx) xb_add(&bar[XB_TOPGEN], 1u);
            else XB_SPIN(xb_ld(&bar[XB_TOPGEN]) == tg, bar);
            __builtin_amdgcn_fence(__ATOMIC_ACQUIRE, "agent");
            xb_add(&bar[XB_XGEN(b.x)], 1u);
            asm volatile("s_waitcnt vmcnt(0)" ::: "memory");
        } else {
            XB_SPIN(xb_ld(&bar[XB_XGEN(b.x)]) == gen, bar);
            __builtin_amdgcn_fence(__ATOMIC_ACQUIRE, "agent");
            asm volatile("s_waitcnt vmcnt(0)" ::: "memory");
        }
    }
    __syncthreads();
}

__device__ __forceinline__ size_t lat_off(int b, int t) { return ((size_t)b * LSEQ + (t - NCTX)) * D; }
__device__ __forceinline__ size_t ctx_off(int b, int t) { return ((size_t)b * NCTX + t) * D; }

namespace g8 {
constexpr int BM = 256, BK = 64, HALF = 128, HTB = HALF * BK * 2, STAGE_BYTES = 8 * HTB, NXCD = 8, WGM = 8;
__device__ __forceinline__ int lds_byte(int r, int c) { const int st = (r >> 4) * 2 + (c >> 5), rr = r & 15, cc = c & 31, ob = rr * 64 + cc * 2; return st * 1024 + (ob ^ (((ob >> 9) & 1) << 5)); }
__device__ __forceinline__ void stage_rc(int b, int& R, int& C) { const int st = b / 1024, sb = b % 1024, swz = sb ^ (((sb >> 9) & 1) << 5); R = (st >> 1) * 16 + swz / 64; C = (st & 1) * 32 + (swz % 64) / 2; }
__device__ __forceinline__ int perm32(int rho) { const int n = rho >> 4, i = rho & 15; return 8 * (i >> 2) + 4 * n + (i & 3); }

struct GUnit { const char* a; const char* b; int pm, pn, x0, x1, xi; };

__device__ __forceinline__ bool static_tile(int i, int G, int c, int nM, int nN, int& pm, int& pn) {
    const int nwg = nM * nN; const long L = (long)i * G + c; if (L >= nwg) return false;
    int wgid = (int)L; { const int q = nwg / NXCD, r = nwg % NXCD, xcd = wgid % NXCD, off = wgid / NXCD; wgid = (xcd < r ? xcd * (q + 1) : r * (q + 1) + (xcd - r) * q) + off; }
    const int nig = WGM * nN, gid = wgid / nig, fm = gid * WGM, gsz = (nM - fm) < WGM ? (nM - fm) : WGM;
    pm = fm + ((wgid % nig) % gsz); pn = (wgid % nig) / gsz; return true;
}

template <class Epi, class Sched>
__device__ __forceinline__ void gemm_phase(LAS unsigned char* lds, const Sched& S, const Epi& E) {
    const int tid = tid_fresh(), wid = __builtin_amdgcn_readfirstlane(tid >> 6), lane = tid & 63, wr = wid >> 2, wc = wid & 3, fr = lane & 15, fq = lane >> 4;
    const int K = S.K, nt = K / BK;
    const int lda = S.lda;
    unsigned voffA[2], voffB[2]; int Rr[2], Cc[2];
#pragma unroll
    for (int i = 0; i < 2; ++i) { int R, C; stage_rc(tid * 16 + i * 8192, R, C); const int Rb = Epi::PERM ? ((R & ~31) + perm32(R & 31)) : R; Rr[i] = R; Cc[i] = C;
        voffA[i] = (unsigned)(R * lda + C) * 2u; voffB[i] = (unsigned)(Rb * K + C) * 2u; }
    unsigned vAc[2][2], vAn[2][2];
    const size_t kstep = (size_t)(BK * 2);
    const size_t hstepA = (size_t)HALF * lda * 2, hstepB = (size_t)HALF * K * 2;
    const unsigned ldsw = (unsigned)wid * 1024u;
    const int aoff = lds_byte(wr * 64 + fr, fq * 8), boff = lds_byte(wc * 32 + fr, fq * 8);
#define G8_SA(b, h) (((b) * 2 + (h)) * HTB)
#define G8_SB(b, h) ((4 + (b) * 2 + (h)) * HTB)
#define G8_STAGE(bufoff, gbase, voff) do { _Pragma("unroll") for (int _i = 0; _i < 2; ++_i) \
        __builtin_amdgcn_global_load_lds((const unsigned*)((const char*)(gbase) + (voff)[_i]), (LAS unsigned*)(lds + (bufoff) + ldsw + _i * 8192), 16, 0, 0); } while (0)
#define G8_STAGE_A(bufoff, basep, h, usenext) do { if constexpr (Sched::GATHER) { unsigned _v[2]; _v[0] = (usenext) ? vAn[h][0] : vAc[h][0]; _v[1] = (usenext) ? vAn[h][1] : vAc[h][1]; G8_STAGE(bufoff, basep, _v); } \
        else { G8_STAGE(bufoff, (basep) + (h) * hstepA, voffA); } } while (0)
#define G8_LDA(dst, b, h) do { _Pragma("unroll") for (int m = 0; m < 4; ++m) _Pragma("unroll") for (int k = 0; k < 2; ++k) dst[m][k] = *(const LAS bf16x8*)(lds + G8_SA(b, h) + aoff + m * 2048 + k * 1024); } while (0)
#define G8_LDB(dst, b, h) do { _Pragma("unroll") for (int n = 0; n < 2; ++n) _Pragma("unroll") for (int k = 0; k < 2; ++k) dst[n][k] = *(const LAS bf16x8*)(lds + G8_SB(b, h) + boff + n * 2048 + k * 1024); } while (0)
#define G8_MMA(ai, bj, At, Bt) do { __builtin_amdgcn_s_setprio(1); _Pragma("unroll") for (int m = 0; m < 4; ++m) _Pragma("unroll") for (int n = 0; n < 2; ++n) _Pragma("unroll") for (int k = 0; k < 2; ++k) \
        acc[ai][bj][m][n] = __builtin_amdgcn_mfma_f32_16x16x32_bf16(Bt[n][k], At[m][k], acc[ai][bj][m][n], 0, 0, 0); __builtin_amdgcn_s_setprio(0); } while (0)
#define G8_WAIT_V(n) asm volatile("s_waitcnt vmcnt(" #n ")" ::: "memory")
#define G8_WAIT_L(n) asm volatile("s_waitcnt lgkmcnt(" #n ")" ::: "memory")
#define G8_BAR __builtin_amdgcn_s_barrier()
#define G8_SCHED __builtin_amdgcn_sched_barrier(0)
    GUnit cur, nxt; int ui = 0;
    if (!S.next(0, cur)) return;
    f32x4 acc[2][2][4][2];
#pragma unroll
    for (int a = 0; a < 2; ++a)
#pragma unroll
        for (int b = 0; b < 2; ++b)
#pragma unroll
            for (int m = 0; m < 4; ++m)
#pragma unroll
                for (int n = 0; n < 2; ++n) acc[a][b][m][n] = (f32x4){0.f, 0.f, 0.f, 0.f};
    bf16x8 At[4][2], B0[2][2], B1[2][2];
    const char* cA = cur.a; const char* cB = cur.b;
    if constexpr (Sched::GATHER) { S.aoff(cur, Rr, Cc, vAc); asm volatile("s_waitcnt lgkmcnt(0)" ::: "memory"); }
    G8_STAGE(G8_SB(0, 0), cB, voffB); G8_STAGE_A(G8_SA(0, 0), cA, 0, false); G8_STAGE(G8_SB(0, 1), cB + hstepB, voffB); G8_STAGE_A(G8_SA(0, 1), cA, 1, false);
    if (wr == 1) G8_BAR;
    G8_WAIT_V(4); G8_BAR;
    G8_STAGE(G8_SB(1, 0), cB + kstep, voffB); G8_STAGE_A(G8_SA(1, 0), cA + kstep, 0, false); G8_STAGE(G8_SB(1, 1), cB + hstepB + kstep, voffB);
    G8_WAIT_V(6); G8_BAR;
    for (;;) {
        const bool has_next = S.next(ui + 1, nxt);
        const char* nA = has_next ? nxt.a : cA; const char* nB = has_next ? nxt.b : cB;
        if constexpr (Sched::GATHER) {
            if (has_next) S.aoff(nxt, Rr, Cc, vAn); else { vAn[0][0] = vAc[0][0]; vAn[0][1] = vAc[0][1]; vAn[1][0] = vAc[1][0]; vAn[1][1] = vAc[1][1]; }
            asm volatile("s_waitcnt lgkmcnt(0)" : "+v"(vAn[0][0]), "+v"(vAn[0][1]), "+v"(vAn[1][0]), "+v"(vAn[1][1]) :: "memory");
        }
        for (int t = 0; t < nt; t += 2) {
            const bool last = (t == nt - 2);
            const char* a1 = cA + (size_t)(t + 1) * kstep;
            const char* a2 = last ? nA : cA + (size_t)(t + 2) * kstep; const char* b2 = last ? nB : cB + (size_t)(t + 2) * kstep;
            const char* a3 = a2 + kstep; const char* b3 = b2 + kstep;
            G8_LDB(B0, 0, 0); G8_SCHED; G8_LDA(At, 0, 0); G8_STAGE_A(G8_SA(1, 1), a1, 1, false);
            G8_WAIT_L(8); G8_BAR; G8_WAIT_L(0); G8_MMA(0, 0, At, B0); G8_BAR; G8_SCHED;
            G8_LDB(B1, 0, 1); G8_STAGE(G8_SB(0, 0), b2, voffB);
            G8_BAR; G8_WAIT_L(0); G8_MMA(0, 1, At, B1); G8_BAR;
            G8_LDA(At, 0, 1); G8_STAGE_A(G8_SA(0, 0), a2, 0, last);
            G8_BAR; G8_WAIT_L(0); G8_MMA(1, 0, At, B0); G8_BAR; G8_SCHED;
            G8_STAGE(G8_SB(0, 1), b2 + hstepB, voffB);
            G8_WAIT_V(6); G8_BAR; G8_MMA(1, 1, At, B1); G8_BAR;
            G8_LDB(B0, 1, 0); G8_SCHED; G8_LDA(At, 1, 0); G8_STAGE_A(G8_SA(0, 1), a2, 1, last);
            G8_WAIT_L(8); G8_BAR; G8_WAIT_L(0); G8_MMA(0, 0, At, B0); G8_BAR; G8_SCHED;
            G8_LDB(B1, 1, 1); G8_STAGE(G8_SB(1, 0), b3, voffB);
            G8_BAR; G8_WAIT_L(0); G8_MMA(0, 1, At, B1); G8_BAR;
            G8_LDA(At, 1, 1); G8_STAGE_A(G8_SA(1, 0), a3, 0, last);
            G8_BAR; G8_WAIT_L(0); G8_MMA(1, 0, At, B0); G8_BAR; G8_SCHED;
            G8_STAGE(G8_SB(1, 1), b3 + hstepB, voffB);
            G8_WAIT_V(6); G8_BAR; G8_MMA(1, 1, At, B1); G8_BAR;
        }
        E(acc, cur, wr, wc, fr, fq);
        if (!has_next) break;
#pragma unroll
        for (int a = 0; a < 2; ++a)
#pragma unroll
            for (int b = 0; b < 2; ++b)
#pragma unroll
                for (int m = 0; m < 4; ++m)
#pragma unroll
                    for (int n = 0; n < 2; ++n) acc[a][b][m][n] = (f32x4){0.f, 0.f, 0.f, 0.f};
        cur = nxt; cA = nA; cB = nB; ++ui;
        if constexpr (Sched::GATHER) { vAc[0][0] = vAn[0][0]; vAc[0][1] = vAn[0][1]; vAc[1][0] = vAn[1][0]; vAc[1][1] = vAn[1][1]; }
    }
    G8_WAIT_V(0);
    if (wr == 0) G8_BAR;
    G8_BAR;
#undef G8_SA
#undef G8_SB
#undef G8_STAGE
#undef G8_STAGE_A
#undef G8_LDA
#undef G8_LDB
#undef G8_MMA
#undef G8_WAIT_V
#undef G8_WAIT_L
#undef G8_BAR
#undef G8_SCHED
}
template <class Epi, class Sched>
__device__ __forceinline__ void gemm_call(LAS unsigned char* lds, Sched S, Epi E) { gemm_phase(lds, S, E); }
}
using g8::GUnit;

__device__ __forceinline__ int skipctx_pm(int pmc) { return (pmc >> 5) * 33 + 1 + (pmc & 31); }
struct SchedDense {       static constexpr bool GATHER = false;
    const bf16_t* A; const bf16_t* B; size_t strideA, strideB; int lda, K, nM, nN, nNb; bool skipctx; bool qkvswap;
    __device__ __forceinline__ bool next(int i, GUnit& u) const {
        int pm, pn; if (!g8::static_tile(i, gridDim.x, blockIdx.x, nM, nN, pm, pn)) return false;
        if (skipctx) pm = skipctx_pm(pm);
        const int br = pn / nNb, pl = pn - br * nNb;
        u.pm = pm; u.pn = pn; u.x0 = br; u.x1 = pl;
        u.a = (const char*)(A + (size_t)br * strideA + (size_t)pm * 256 * lda);
        u.b = (const char*)(B + (size_t)br * strideB + (size_t)pl * 256 * K);
        { const bool vt_ = qkvswap && ((0x3C20F0u >> pn) & 1u); const unsigned long long x_ = ((unsigned long long)u.a ^ (unsigned long long)u.b) & (vt_ ? ~0ull : 0ull); u.a = (const char*)((unsigned long long)u.a ^ x_); u.b = (const char*)((unsigned long long)u.b ^ x_); }
        return true;
    }
};
struct SchedZG {
    static constexpr bool GATHER = false;
    const bf16_t* Y; const bf16_t* WB; const bf16_t* Hm; const bf16_t* WG; int nM; bool skipctx; bool ctxonly;
    static constexpr int lda = 1024, K = 1024;
    __device__ __forceinline__ bool next(int i, GUnit& u) const {
        int pm, pn; if (!g8::static_tile(i >> 1, gridDim.x, blockIdx.x, nM, 12, pm, pn)) return false;
        if (skipctx) pm = skipctx_pm(pm);
        if (ctxonly) pm = pm * 33;
        const int sub = i & 1, br = pn >> 2, pl = pn & 3;
        u.pm = pm; u.pn = pn; u.x0 = sub; u.x1 = 0;
        if (sub == 0) { u.a = (const char*)(Y + (size_t)br * TG * 1024 + (size_t)pm * 256 * 1024); u.b = (const char*)(WB + (size_t)br * 1024 * 1024 + (size_t)pl * 256 * 1024); }
        else { u.a = (const char*)(Hm + (size_t)pm * 256 * 1024); u.b = (const char*)(WG + (size_t)pn * 256 * 1024); }
        return true;
    }
};
struct SchedZGc {
    static constexpr bool GATHER = false;
    const bf16_t* Y; const bf16_t* WB; const bf16_t* Hm; const bf16_t* WG; int nM; bool skipctx;
    static constexpr int lda = 1024, K = 1024;
    __device__ __forceinline__ bool next(int i, GUnit& u) const {
        const int q = i / 6, st = i - q * 6;
        int pm, pc; if (!g8::static_tile(q, gridDim.x, blockIdx.x, nM, 4, pm, pc)) return false;
        if (skipctx) pm = skipctx_pm(pm);
        const int sub = st & 1, br = st >> 1, pn = br * 4 + pc;
        u.pm = pm; u.pn = pn; u.x0 = sub; u.x1 = br;
        if (sub == 0) { u.a = (const char*)(Y + (size_t)br * TG * 1024 + (size_t)pm * 256 * 1024); u.b = (const char*)(WB + (size_t)br * 1024 * 1024 + (size_t)pc * 256 * 1024); }
        else { u.a = (const char*)(Hm + (size_t)pm * 256 * 1024); u.b = (const char*)(WG + (size_t)pn * 256 * 1024); }
        return true;
    }
};
struct SchedOut2 {
    static constexpr bool GATHER = false;
    const bf16_t* Z0; const bf16_t* Z1; const bf16_t* B; bool skipctx; int K; bool ctxonly; bool skew;
    static constexpr int lda = 3072;
    __device__ __forceinline__ bool next(int i, GUnit& u) const {
        int pm, pn;
        if (skew && gridDim.x == 256) {
            int L; const int b = (int)blockIdx.x;
            if (b < 32) { if (i >= 2) return false; L = b + 32 * i; } else { L = 64 + i * 224 + (b - 32); if (L >= 1024) return false; }
            g8::static_tile(0, 1, L, 256, 4, pm, pn);
        } else if (!g8::static_tile(i, gridDim.x, blockIdx.x, ctxonly ? 8 : (skipctx ? 256 : 2 * (TG / 256)), 4, pm, pn)) return false;
        if (skipctx) pm = skipctx_pm(pm);
        if (ctxonly) pm = pm * 33;
        u.pm = pm; u.pn = pn; u.x0 = 0; u.x1 = 0;
        const bf16_t* z1adj = Z1 - (size_t)(TG / 256) * 256 * 3072; const long long d = (pm < TG / 256) ? (long long)(Z0 - z1adj) : 0ll;
        u.a = (const char*)(z1adj + d + (size_t)pm * 256 * 3072);
        u.b = (const char*)(B + (size_t)pn * 256 * K);
        return true;
    }
};
struct SchedMoe {
    static constexpr bool GATHER = false;
    const bf16_t* A; const bf16_t* B; int lda, K, npn, brows;
    const LAS int* tab;
    __device__ __forceinline__ bool next(int i, GUnit& u) const {
        const int L = i * (int)gridDim.x + (int)blockIdx.x;
        const int ntile = tab[96];
        if (L >= ntile * npn) return false;
        const int tg = L / npn, pn = L - tg * npn;
        int e = 0;
#pragma unroll 1
        for (int j = 1; j < 32; ++j) e = (tab[64 + j] <= tg) ? j : e;
        const int mt = tg - tab[64 + e];
        const int slot0 = tab[32 + e] + 256 * mt;
        u.pm = slot0; u.pn = pn; u.x0 = e; u.x1 = tab[e] - 256 * mt;
        u.a = (const char*)(A + (size_t)slot0 * lda);
        u.b = (const char*)(B + ((size_t)e * brows + (size_t)pn * 256) * K);
        return true;
    }
};

struct SchedMoeG {
    static constexpr bool GATHER = true;
    const bf16_t* Hm; const bf16_t* B; const LAS int* tab; const LAS int* tok;
    static constexpr int lda = 1024, K = 1024;
    __device__ __forceinline__ bool next(int i, GUnit& u) const {
        const int L = i * (int)gridDim.x + (int)blockIdx.x;
        const int ntile = tab[96];
        if (L >= ntile * 8) return false;
        const int tg = L >> 3, pn = L & 7;
        int e = 0;
#pragma unroll 1
        for (int j = 1; j < 32; ++j) e = (tab[64 + j] <= tg) ? j : e;
        const int mt = tg - tab[64 + e];
        const int slot0 = tab[32 + e] + 256 * mt;
        u.pm = slot0; u.pn = pn; u.x0 = e; u.x1 = tab[e] - 256 * mt; u.xi = i;
        u.a = (const char*)Hm;
        u.b = (const char*)(B + ((size_t)e * 2048 + (size_t)pn * 256) * 1024);
        return true;
    }
    __device__ __forceinline__ void aoff(const GUnit& u, const int (&R)[2], const int (&C)[2], unsigned (&vo)[2][2]) const {
        const LAS int* tk = tok + u.xi * 256;
#pragma unroll
        for (int h = 0; h < 2; ++h)
#pragma unroll
            for (int q = 0; q < 2; ++q) vo[h][q] = (unsigned)(tk[h * 128 + R[q]] * 1024 + C[q]) * 2u;
    }
};

struct EpiQKV {
    static constexpr bool PERM = true;
    unsigned char* reg; int g;
    const f32x2* atab; const f32x2* rtab; bool dry;
    __device__ __forceinline__ void operator()(const f32x4 (&acc)[2][2][4][2], const GUnit& u, int wr, int wc, int fr, int fq) const {
        const int pn = u.pn;
        if (dry) { if (acc[0][0][0][0][0] == 1234.5678f) reg[0] = 1; return; }
        const int rg0 = u.pm * 256;
        const int bl = rg0 / TB, t0 = rg0 - bl * TB;
        bf16_t* GQK = (bf16_t*)(reg + R_GQK); bf16_t* GVT = (bf16_t*)(reg + R_GVT); float* GLR = (float*)(reg + R_GLR);
        bf16_t* AQ = (bf16_t*)(reg + R_AQ); bf16_t* AK = (bf16_t*)(reg + R_AK); bf16_t* AVT = (bf16_t*)(reg + R_AVT);
        bf16_t* RQK = (bf16_t*)(reg + R_RQK); bf16_t* RVT = (bf16_t*)(reg + R_RVT);
        if (pn < 4) {
            const float sc = pn < 2 ? 0.08838834764831845f : 1.0f;
#pragma unroll
            for (int ai = 0; ai < 2; ++ai)
#pragma unroll
                for (int m = 0; m < 4; ++m) { const int r = rg0 + ai * 128 + wr * 64 + m * 16 + fr; bf16_t* rowp = GQK + (size_t)r * 1024 + pn * 256 + wc * 32 + 8 * fq;
#pragma unroll
                    for (int bj = 0; bj < 2; ++bj) { const f32x4 v0 = acc[ai][bj][m][0] * sc, v1 = acc[ai][bj][m][1] * sc; u32x4 w; w.x = cvt_pk_bf16(v0[0], v0[1]); w.y = cvt_pk_bf16(v0[2], v0[3]); w.z = cvt_pk_bf16(v1[0], v1[1]); w.w = cvt_pk_bf16(v1[2], v1[3]);
                        *(u32x4*)(rowp + bj * 128) = w; } }
        } else if ((0x3C20F0u >> pn) & 1u) {
            bf16_t* VT; int dim0, nd;
            if (pn < 8) { VT = GVT; dim0 = (pn - 4) * 256; nd = 1024; } else if (pn == 13) { VT = AVT; dim0 = 0; nd = 256; } else { VT = RVT; dim0 = (pn - 18) * 256; nd = 1024; }
#pragma unroll
            for (int ai = 0; ai < 2; ++ai)
#pragma unroll
                for (int m = 0; m < 4; ++m) { const int dimr = ai * 128 + wr * 64 + m * 16 + fr; bf16_t* rowp = VT + ((size_t)bl * nd + dim0 + dimr) * TB + t0 + wc * 32 + 8 * fq;
#pragma unroll
                    for (int bj = 0; bj < 2; ++bj) { const f32x4 v0 = acc[ai][bj][m][0], v1 = acc[ai][bj][m][1]; u32x4 w; w.x = cvt_pk_bf16(v0[0], v0[1]); w.y = cvt_pk_bf16(v0[2], v0[3]); w.z = cvt_pk_bf16(v1[0], v1[1]); w.w = cvt_pk_bf16(v1[2], v1[3]);
                        *(u32x4*)(rowp + bj * 128) = w; } }
        } else if (pn == 22) {
            if (wc == 0) {
#pragma unroll
                for (int ai = 0; ai < 2; ++ai)
#pragma unroll
                    for (int m = 0; m < 4; ++m) { const int r = rg0 + ai * 128 + wr * 64 + m * 16 + fr;
#pragma unroll
                        for (int n = 0; n < 2; ++n) *(f32x4*)(GLR + (size_t)r * 32 + 8 * fq + 4 * n) = acc[ai][0][m][n]; }
            }
        } else {
            const bool isatt = pn <= 12;
            bf16_t* O; int ld, colbase; float sc;
            if (pn < 12)       { O = AQ;  ld = 1024; colbase = (pn - 8) * 256;  sc = 0.08838834764831845f * LOG2E; }
            else if (pn == 12) { O = AK;  ld = 256;  colbase = 0;               sc = 1.0f; }
            else if (pn < 16)  { O = RQK; ld = 1024; colbase = (pn - 14) * 256; sc = 1.0f; }
            else               { O = RQK; ld = 1024; colbase = 512 + (pn - 16) * 256; sc = 0.08838834764831845f; }
            const int hb = isatt ? ((wc & 1) * 16 + (wc >> 1) * 64) : 16 * wc;
            const int pstep = isatt ? 32 : 64;
            const int fi = isatt ? ((wc & 1) * 16 + 4 * fq) : (16 * wc + 4 * fq);
#pragma unroll
            for (int ai = 0; ai < 2; ++ai) {
                f32x4 tb[4][2];
#pragma unroll
                for (int m = 0; m < 4; ++m) { const int t = t0 + ai * 128 + wr * 64 + m * 16 + fr;
                    const f32x4* tp;
                    if (isatt) { const int lt = t - NCTX; const int pos = (t < NCTX) ? 0 : ((wc < 2) ? (lt >> 6) : (lt & 63)); tp = (const f32x4*)(atab + pos * 32 + fi); }
                    else tp = (const f32x4*)(rtab + (size_t)t * 64 + fi);
                    tb[m][0] = tp[0]; tb[m][1] = tp[1]; }
#pragma unroll
                for (int m = 0; m < 4; ++m) {
                    const int rl = ai * 128 + wr * 64 + m * 16 + fr; const int r = rg0 + rl;
                    f32x2 cs[4]; { const f32x4 a = tb[m][0], b = tb[m][1]; cs[0] = (f32x2){a[0], a[1]}; cs[1] = (f32x2){a[2], a[3]}; cs[2] = (f32x2){b[0], b[1]}; cs[3] = (f32x2){b[2], b[3]}; }
#pragma unroll
                    for (int bj = 0; bj < 2; ++bj) {
                        const f32x4 x1 = acc[ai][bj][m][0], x2 = acc[ai][bj][m][1];
                        float o1[4], o2[4];
#pragma unroll
                        for (int j = 0; j < 4; ++j) { o1[j] = (x1[j] * cs[j].x - x2[j] * cs[j].y) * sc; o2[j] = (x2[j] * cs[j].x + x1[j] * cs[j].y) * sc; }
                        bf16_t* p = O + (size_t)r * ld + colbase + bj * 128 + hb + 4 * fq;
                        u32x2 w1, w2; w1.x = cvt_pk_bf16(o1[0], o1[1]); w1.y = cvt_pk_bf16(o1[2], o1[3]); w2.x = cvt_pk_bf16(o2[0], o2[1]); w2.y = cvt_pk_bf16(o2[2], o2[3]);
                        *(u32x2*)p = w1; *(u32x2*)(p + pstep) = w2;
                    }
                }
            }
        }
    }
};

struct EpiGateR {
    static constexpr bool PERM = true;
    unsigned char* reg; const f32x2* stats; const float* gng; const float* rng; bool dry;
    __device__ __forceinline__ void operator()(const f32x4 (&acc)[2][2][4][2], const GUnit& u, int wr, int wc, int fr, int fq) const {
        const int mix = u.pn >> 2, head = u.pn & 3;
        bf16_t* O = (bf16_t*)(reg + (mix ? R_ORF : R_OGF));
        const float* gn = (mix ? rng : gng) + head * 256;
        const f32x2* st = stats + (size_t)mix * TG * 4;
        f32x4 ga[2], gb[2];
#pragma unroll
        for (int bj = 0; bj < 2; ++bj) { const int c0 = bj * 128 + wc * 32 + 8 * fq; ga[bj] = *(const f32x4*)(gn + c0); gb[bj] = *(const f32x4*)(gn + c0 + 4); }
#pragma unroll
        for (int ai = 0; ai < 2; ++ai) {
            u32x4 ov[4][2]; f32x2 sv[4];
#pragma unroll
            for (int m = 0; m < 4; ++m) { const int r = u.pm * 256 + ai * 128 + wr * 64 + m * 16 + fr; sv[m] = st[(size_t)r * 4 + head];
#pragma unroll
                for (int bj = 0; bj < 2; ++bj) ov[m][bj] = *(const u32x4*)(O + (size_t)r * 1024 + head * 256 + bj * 128 + wc * 32 + 8 * fq); }
#pragma unroll
            for (int m = 0; m < 4; ++m) { const int r = u.pm * 256 + ai * 128 + wr * 64 + m * 16 + fr; const float mu = sv[m].x, rs = sv[m].y;
#pragma unroll
                for (int bj = 0; bj < 2; ++bj) {
                    const u32x4 o4 = ov[m][bj]; const f32x4 a0 = acc[ai][bj][m][0], a1 = acc[ai][bj][m][1]; const f32x4 g0 = ga[bj], g1 = gb[bj];
                    float y[8];
                    y[0] = (bflo(o4.x) - mu) * rs * g0[0] * silu_f(a0[0]); y[1] = (bfhi(o4.x) - mu) * rs * g0[1] * silu_f(a0[1]);
                    y[2] = (bflo(o4.y) - mu) * rs * g0[2] * silu_f(a0[2]); y[3] = (bfhi(o4.y) - mu) * rs * g0[3] * silu_f(a0[3]);
                    y[4] = (bflo(o4.z) - mu) * rs * g1[0] * silu_f(a1[0]); y[5] = (bfhi(o4.z) - mu) * rs * g1[1] * silu_f(a1[1]);
                    y[6] = (bflo(o4.w) - mu) * rs * g1[2] * silu_f(a1[2]); y[7] = (bfhi(o4.w) - mu) * rs * g1[3] * silu_f(a1[3]);
                    u32x4 w; w.x = cvt_pk_bf16(y[0], y[1]); w.y = cvt_pk_bf16(y[2], y[3]); w.z = cvt_pk_bf16(y[4], y[5]); w.w = cvt_pk_bf16(y[6], y[7]);
                    if (!dry) *(u32x4*)(O + (size_t)r * 1024 + head * 256 + bj * 128 + wc * 32 + 8 * fq) = w;
                } }
        }
    }
};

struct EpiBf16 {
    static constexpr bool PERM = true;
    bf16_t* O; int ld;
    __device__ __forceinline__ void operator()(const f32x4 (&acc)[2][2][4][2], const GUnit& u, int wr, int wc, int fr, int fq) const {
#pragma unroll
        for (int ai = 0; ai < 2; ++ai)
#pragma unroll
            for (int m = 0; m < 4; ++m) { bf16_t* rowp = O + (size_t)(u.pm * 256 + ai * 128 + wr * 64 + m * 16 + fr) * ld + u.pn * 256 + wc * 32 + 8 * fq;
#pragma unroll
                for (int bj = 0; bj < 2; ++bj) { const f32x4 v0 = acc[ai][bj][m][0], v1 = acc[ai][bj][m][1]; u32x4 w; w.x = cvt_pk_bf16(v0[0], v0[1]); w.y = cvt_pk_bf16(v0[2], v0[3]); w.z = cvt_pk_bf16(v1[0], v1[1]); w.w = cvt_pk_bf16(v1[2], v1[3]);
                    *(u32x4*)(rowp + bj * 128) = w; } }
    }
};
struct EpiGZ {
    static constexpr bool PERM = true;
    bf16_t* Z; bool dry;
    __device__ __forceinline__ void operator()(const f32x4 (&acc)[2][2][4][2], const GUnit& u, int wr, int wc, int fr, int fq) const {
#pragma unroll
        for (int ai = 0; ai < 2; ++ai) {
            u32x4 zv[4][2];
#pragma unroll
            for (int m = 0; m < 4; ++m)
#pragma unroll
                for (int bj = 0; bj < 2; ++bj) zv[m][bj] = *(const u32x4*)(Z + (size_t)(u.pm * 256 + ai * 128 + wr * 64 + m * 16 + fr) * 3072 + u.pn * 256 + wc * 32 + 8 * fq + bj * 128);
#pragma unroll
            for (int m = 0; m < 4; ++m) { bf16_t* rowp = Z + (size_t)(u.pm * 256 + ai * 128 + wr * 64 + m * 16 + fr) * 3072 + u.pn * 256 + wc * 32 + 8 * fq;
#pragma unroll
                for (int bj = 0; bj < 2; ++bj) { const f32x4 v0 = acc[ai][bj][m][0], v1 = acc[ai][bj][m][1]; const u32x4 z = zv[m][bj]; u32x4 w;
                    w.x = cvt_pk_bf16(sigmoid_f(v0[0]) * bflo(z.x), sigmoid_f(v0[1]) * bfhi(z.x)); w.y = cvt_pk_bf16(sigmoid_f(v0[2]) * bflo(z.y), sigmoid_f(v0[3]) * bfhi(z.y));
                    w.z = cvt_pk_bf16(sigmoid_f(v1[0]) * bflo(z.z), sigmoid_f(v1[1]) * bfhi(z.z)); w.w = cvt_pk_bf16(sigmoid_f(v1[2]) * bflo(z.w), sigmoid_f(v1[3]) * bfhi(z.w));
                    if (!dry) *(u32x4*)(rowp + bj * 128) = w; } }
        }
    }
};
struct EpiZG {
    static constexpr bool PERM = true;
    bf16_t* Z; bool dry;
    __device__ __forceinline__ void operator()(const f32x4 (&acc)[2][2][4][2], const GUnit& u, int wr, int wc, int fr, int fq) const {
        if (dry) { if (acc[0][0][0][0][0] == 1234.5678f) Z[0] = 1; return; }
        if (u.x0 == 0) { EpiBf16 e{Z, 3072}; e(acc, u, wr, wc, fr, fq); } else { EpiGZ e{Z, false}; e(acc, u, wr, wc, fr, fq); }
    }
};
struct EpiZGc {
    static constexpr bool PERM = true;
    bf16_t* Z;
    __device__ __forceinline__ void operator()(const f32x4 (&acc)[2][2][4][2], const GUnit& u, int wr, int wc, int fr, int fq) const {
        if (u.x0 == 0) { EpiBf16 e{Z, 3072}; e(acc, u, wr, wc, fr, fq); return; }
        const int br = u.x1, pc = u.pn - br * 4;
#pragma unroll
        for (int ai = 0; ai < 2; ++ai) {
            u32x4 zv[4][2], mv[4][2];
#pragma unroll
            for (int m = 0; m < 4; ++m)
#pragma unroll
                for (int bj = 0; bj < 2; ++bj) { const bf16_t* rp = Z + (size_t)(u.pm * 256 + ai * 128 + wr * 64 + m * 16 + fr) * 3072 + wc * 32 + 8 * fq + bj * 128;
                    zv[m][bj] = *(const u32x4*)(rp + u.pn * 256); mv[m][bj] = (br > 0) ? *(const u32x4*)(rp + pc * 256) : (u32x4){0u, 0u, 0u, 0u}; }
#pragma unroll
            for (int m = 0; m < 4; ++m) { bf16_t* rowp = Z + (size_t)(u.pm * 256 + ai * 128 + wr * 64 + m * 16 + fr) * 3072 + pc * 256 + wc * 32 + 8 * fq;
#pragma unroll
                for (int bj = 0; bj < 2; ++bj) { const f32x4 v0 = acc[ai][bj][m][0], v1 = acc[ai][bj][m][1]; const u32x4 z = zv[m][bj], mm = mv[m][bj]; u32x4 w;
                    w.x = cvt_pk_bf16(bflo(mm.x) + sigmoid_f(v0[0]) * bflo(z.x), bfhi(mm.x) + sigmoid_f(v0[1]) * bfhi(z.x)); w.y = cvt_pk_bf16(bflo(mm.y) + sigmoid_f(v0[2]) * bflo(z.y), bfhi(mm.y) + sigmoid_f(v0[3]) * bfhi(z.y));
                    w.z = cvt_pk_bf16(bflo(mm.z) + sigmoid_f(v1[0]) * bflo(z.z), bfhi(mm.z) + sigmoid_f(v1[1]) * bfhi(z.z)); w.w = cvt_pk_bf16(bflo(mm.w) + sigmoid_f(v1[2]) * bflo(z.w), bfhi(mm.w) + sigmoid_f(v1[3]) * bfhi(z.w));
                    *(u32x4*)(rowp + bj * 128) = w; } }
        }
    }
};
struct EpiOut {
    static constexpr bool PERM = false;
    const float* xin_lat; const float* xin_ctx; float* xout_lat; float* xout_ctx; const float* mod; int g; bool dry;
    __device__ __forceinline__ void operator()(const f32x4 (&acc)[2][2][4][2], const GUnit& u, int wr, int wc, int fr, int fq) const {
        const int rg0 = u.pm * 256; const int bl = rg0 / TB, t0 = rg0 - bl * TB; const int b = g * BG + bl;
        const bool isctx = t0 < NCTX;
        const float* g1 = mod + (size_t)(isctx ? 8 : b) * 6144 + 2048 + u.pn * 256 + wc * 32 + 4 * fq;
        f32x4 gv[2][2];
#pragma unroll
        for (int bj = 0; bj < 2; ++bj)
#pragma unroll
            for (int n = 0; n < 2; ++n) gv[bj][n] = *(const f32x4*)(g1 + bj * 128 + n * 16);
#pragma unroll
        for (int ai = 0; ai < 2; ++ai) {
            f32x4 xv[4][2][2];
#pragma unroll
            for (int m = 0; m < 4; ++m) { const int t = t0 + ai * 128 + wr * 64 + m * 16 + fr;
                const float* ip = (isctx ? xin_ctx : xin_lat) + (isctx ? ctx_off(b, t) : lat_off(b, t)) + u.pn * 256 + wc * 32 + 4 * fq;
#pragma unroll
                for (int bj = 0; bj < 2; ++bj)
#pragma unroll
                    for (int n = 0; n < 2; ++n) xv[m][bj][n] = *(const f32x4*)(ip + bj * 128 + n * 16); }
#pragma unroll
            for (int m = 0; m < 4; ++m) { const int t = t0 + ai * 128 + wr * 64 + m * 16 + fr;
                float* op = (isctx ? xout_ctx : xout_lat) + (isctx ? ctx_off(b, t) : lat_off(b, t)) + u.pn * 256 + wc * 32 + 4 * fq;
#pragma unroll
                for (int bj = 0; bj < 2; ++bj)
#pragma unroll
                    for (int n = 0; n < 2; ++n) { if (!dry) *(f32x4*)(op + bj * 128 + n * 16) = xv[m][bj][n] + gv[bj][n] * acc[ai][bj][m][n]; } }
        }
    }
};
struct EpiMoe1 {
    static constexpr bool PERM = true;
    bf16_t* Hm;
    __device__ __forceinline__ void operator()(const f32x4 (&acc)[2][2][4][2], const GUnit& u, int wr, int wc, int fr, int fq) const {
#pragma unroll
        for (int ai = 0; ai < 2; ++ai)
#pragma unroll
            for (int m = 0; m < 4; ++m) { const int rl = ai * 128 + wr * 64 + m * 16 + fr;
                if (rl < u.x1) { bf16_t* p = Hm + (size_t)(u.pm + rl) * 1024 + u.pn * 128 + wc * 32 + 8 * fq;
                    const f32x4 a0 = acc[ai][0][m][0], a1 = acc[ai][0][m][1], b0 = acc[ai][1][m][0], b1 = acc[ai][1][m][1]; u32x4 w;
                    w.x = cvt_pk_bf16(silu_f(a0[0]) * b0[0], silu_f(a0[1]) * b0[1]); w.y = cvt_pk_bf16(silu_f(a0[2]) * b0[2], silu_f(a0[3]) * b0[3]);
                    w.z = cvt_pk_bf16(silu_f(a1[0]) * b1[0], silu_f(a1[1]) * b1[1]); w.w = cvt_pk_bf16(silu_f(a1[2]) * b1[2], silu_f(a1[3]) * b1[3]);
                    *(u32x4*)p = w; } }
    }
};
struct EpiMoe2 {
    static constexpr bool PERM = true;
    bf16_t* Y; const float* slotw;
    __device__ __forceinline__ void operator()(const f32x4 (&acc)[2][2][4][2], const GUnit& u, int wr, int wc, int fr, int fq) const {
        float sw[2][4];
#pragma unroll
        for (int ai = 0; ai < 2; ++ai)
#pragma unroll
            for (int m = 0; m < 4; ++m) sw[ai][m] = slotw[u.pm + ai * 128 + wr * 64 + m * 16 + fr];
#pragma unroll
        for (int ai = 0; ai < 2; ++ai)
#pragma unroll
            for (int m = 0; m < 4; ++m) { const int rl = ai * 128 + wr * 64 + m * 16 + fr;
                if (rl < u.x1) { const float w8 = sw[ai][m]; bf16_t* rowp = Y + (size_t)(u.pm + rl) * 1024 + u.pn * 256 + wc * 32 + 8 * fq;
#pragma unroll
                    for (int bj = 0; bj < 2; ++bj) { const f32x4 v0 = acc[ai][bj][m][0] * w8, v1 = acc[ai][bj][m][1] * w8; u32x4 w; w.x = cvt_pk_bf16(v0[0], v0[1]); w.y = cvt_pk_bf16(v0[2], v0[3]); w.z = cvt_pk_bf16(v1[0], v1[1]); w.w = cvt_pk_bf16(v1[2], v1[3]);
                        *(u32x4*)(rowp + bj * 128) = w; } } }
    }
};

template <class F>
__device__ __forceinline__ void conv_tile(LAS float* tile, F f, int n0, int k0src, size_t ldsrc, bf16_t* dst, size_t dst_ld, int k0dst) {
    const int tid = tid_fresh(), c4 = tid & 31, kb = tid >> 5;
    const float* colp = f(n0 + 4 * c4);
#pragma unroll
    for (int i = 0; i < 4; ++i) { const int kl = kb + 16 * i; const f32x4 v = colp ? *(const f32x4*)(colp + (size_t)(k0src + kl) * ldsrc) : (f32x4){0.f, 0.f, 0.f, 0.f}; *(LAS f32x4*)(tile + kl * 132 + 4 * c4) = v; }
    __syncthreads();
    const int n2 = tid >> 2, k16 = (tid & 3) * 16;
    u32x4 w0, w1;
    w0.x = cvt_pk_bf16(tile[(k16 + 0) * 132 + n2], tile[(k16 + 1) * 132 + n2]); w0.y = cvt_pk_bf16(tile[(k16 + 2) * 132 + n2], tile[(k16 + 3) * 132 + n2]);
    w0.z = cvt_pk_bf16(tile[(k16 + 4) * 132 + n2], tile[(k16 + 5) * 132 + n2]); w0.w = cvt_pk_bf16(tile[(k16 + 6) * 132 + n2], tile[(k16 + 7) * 132 + n2]);
    w1.x = cvt_pk_bf16(tile[(k16 + 8) * 132 + n2], tile[(k16 + 9) * 132 + n2]); w1.y = cvt_pk_bf16(tile[(k16 + 10) * 132 + n2], tile[(k16 + 11) * 132 + n2]);
    w1.z = cvt_pk_bf16(tile[(k16 + 12) * 132 + n2], tile[(k16 + 13) * 132 + n2]); w1.w = cvt_pk_bf16(tile[(k16 + 14) * 132 + n2], tile[(k16 + 15) * 132 + n2]);
    bf16_t* dp = dst + (size_t)(n0 + n2) * dst_ld + k0dst + k16;
    *(u32x4*)dp = w0; *(u32x4*)(dp + 8) = w1;
    __syncthreads();
}
__device__ __forceinline__ int win_col(int np) {
    if (np < 5888) {
        const int tile = np >> 8, p = np & 255, hh = p >> 7, pp = p & 127, wc = pp >> 5, n = (pp >> 2) & 1, q = 4 * ((pp >> 3) & 3) + (pp & 3);
        const int fatt = (wc & 1) * 16 + (wc >> 1) * 64 + q + 32 * n, fret = 16 * wc + q + 64 * n;
        if (tile < 8) return np;
        if (tile < 12) return 3104 + (2 * (tile - 8) + hh) * 128 + fatt;
        if (tile == 12) return 4128 + hh * 128 + fatt;
        if (tile == 13) return 4384 + p;
        if (tile < 16) return 4640 + (2 * (tile - 14) + hh) * 128 + fret;
        if (tile < 18) return 5152 + (2 * (tile - 16) + hh) * 128 + fret;
        if (tile < 22) return 5664 + (np - 18 * 256);
        return p < 32 ? 3072 + p : -1;
    }
    if (np < 7936) { const int m = np - 5888; return m < 1024 ? 2048 + m : 6688 + (m - 1024); }
    return 7712 + (np - 7936);
}
struct FWin { const float* w; __device__ __forceinline__ const float* operator()(int np) const { const int c = win_col(np); return c < 0 ? nullptr : w + c; } };
struct FPlain { const float* w; __device__ __forceinline__ const float* operator()(int n) const { return w + n; } };
struct FW13 { const float* w1; const float* w3; __device__ __forceinline__ const float* operator()(int np) const { const int tile = np >> 8, r = np & 255; return r < 128 ? w1 + tile * 128 + r : w3 + tile * 128 + (r - 128); } };

constexpr int PRO_MOD = 384, PRO_TAB = 8 + 1056, PRO_WR = 192, PRO_WIN = 2 * 86 * 16, PRO_WBR = 2 * 3 * 8 * 16, PRO_WO3 = 2 * 8 * 48, PRO_WO1 = 2 * 8 * 16;
constexpr int PRO_UNITS = PRO_MOD + PRO_TAB + PRO_WR + PRO_WIN + PRO_WBR + PRO_WO3 + PRO_WO1;

__device__ __forceinline__ void prologue1(KP p, LAS unsigned char* lds) {
    unsigned char* ws = p.ws; const int tid = tid_fresh();
    LAS float* tile = (LAS float*)lds;
    for (int u = blockIdx.x; u < PRO_UNITS; u += gridDim.x) {
        int idx = u;
        if (idx < PRO_MOD) {
            const int l = idx / 192, rem = idx % 192, cb = rem / 16, ks = rem % 16, k0 = ks * 64;
            LAS float* sv = tile;
            for (int e = tid; e < 9 * 64; e += 512) { const int r = e >> 6, kk = e & 63; const float cv = (r < 8) ? p.in[1][r * 1024 + k0 + kk] : p.in[3][k0 + kk]; sv[e] = cv / (1.0f + expf(-cv)); }
            __syncthreads();
            const int n = cb * 512 + tid; const float* w = p.in[4] + ((size_t)l * 1024 + k0) * 6144 + n;
            float a[9];
#pragma unroll
            for (int r = 0; r < 9; ++r) a[r] = 0.f;
            for (int kk = 0; kk < 64; ++kk) { const float wv = w[(size_t)kk * 6144];
#pragma unroll
                for (int r = 0; r < 9; ++r) a[r] += sv[r * 64 + kk] * wv; }
            float* mp = (float*)(ws + OFF_MODP);
#pragma unroll
            for (int r = 0; r < 9; ++r) mp[((size_t)(ks * 2 + l) * 9 + r) * 6144 + n] = a[r];
            __syncthreads();
            continue;
        }
        idx -= PRO_MOD;
        if (idx < PRO_TAB) {
            const int e = idx * 512 + tid;
            if (e < 4096) { const int pos = e >> 5, i = e & 31; const float inv = powf(10000.0f, -(float)i / 32.0f); const float ang = (float)pos * inv; float s, c; sincosf(ang, &s, &c); ((f32x2*)(ws + OFF_ATAB))[e] = (f32x2){c, s}; }
            else { const int e2 = e - 4096; if (e2 < TB * 64) { const int pos = e2 >> 6, i = e2 & 63; const float inv = powf(10000.0f, -(float)i / 64.0f); const float ang = (float)pos * inv; float s, c; sincosf(ang, &s, &c); ((f32x2*)(ws + OFF_RTAB))[e2] = (f32x2){c, s}; } }
            continue;
        }
        idx -= PRO_TAB;
        if (idx < PRO_WR) {
            const int e = idx * 512 + tid; const int k = e & 1023, n = (e >> 10) % 48, l = e / (48 * 1024);
            const float v = n < 4 ? p.in[18][((size_t)l * 1024 + k) * 4 + n] : (n < 36 ? p.in[20][((size_t)l * 1024 + k) * 32 + (n - 4)] : 0.f);
            const bf16_t hi = f2bf(v); const bf16_t lo = f2bf(v - bf2f(hi));
            bf16_t* W = (bf16_t*)(ws + OFF_WR) + (size_t)l * 2 * 48 * 1024;
            W[(size_t)n * 1024 + k] = hi; W[(size_t)(48 + n) * 1024 + k] = lo;
            continue;
        }
        idx -= PRO_WR;
        if (idx < PRO_WIN) {
            const int l = idx / (86 * 16), rem = idx % (86 * 16), nt = rem / 16, kt = rem % 16;
            FWin f{p.in[8] + (size_t)l * 1024 * NIN};
            conv_tile(tile, f, nt * 128, kt * 64, NIN, (bf16_t*)(ws + OFF_WINT) + (size_t)l * WIN_ROWS * 1024, 1024, kt * 64);
            continue;
        }
        idx -= PRO_WIN;
        if (idx < PRO_WBR) {
            const int lb = idx / 128, rem = idx % 128, nt = rem / 16, kt = rem % 16; const int l = lb / 3, br = lb % 3;
            FPlain f{p.in[14 + br] + (size_t)l * 1024 * 1024};
            conv_tile(tile, f, nt * 128, kt * 64, 1024, (bf16_t*)(ws + OFF_WBRT) + (size_t)lb * 1024 * 1024, 1024, kt * 64);
            continue;
        }
        idx -= PRO_WBR;
        if (idx < PRO_WO3) {
            const int l = idx / (8 * 48), rem = idx % (8 * 48), nt = rem / 48, kt = rem % 48;
            FPlain f{p.in[17] + (size_t)l * 1024 * 1024};
            conv_tile(tile, f, nt * 128, (kt % 16) * 64, 1024, (bf16_t*)(ws + OFF_WO3T) + (size_t)l * 1024 * 3072, 3072, kt * 64);
            continue;
        }
        idx -= PRO_WO3;
        {
            const int l = idx / 128, rem = idx % 128, nt = rem / 16, kt = rem % 16;
            FPlain f{p.in[17] + (size_t)l * 1024 * 1024};
            conv_tile(tile, f, nt * 128, kt * 64, 1024, (bf16_t*)(ws + OFF_WO1T) + (size_t)l * 1024 * 1024, 1024, kt * 64);
        }
    }
}
__device__ __forceinline__ void prologue2(KP p) {

    const float* mp = (const float*)(p.ws + OFF_MODP); float* mo = (float*)(p.ws + OFF_MOD);
    for (int e = blockIdx.x * 512 + tid_fresh(); e < 2 * 9 * 6144; e += gridDim.x * 512) {
        const int l = e / (9 * 6144), n = e % 6144;
        float s = p.in[5][l * 6144 + n];
#pragma unroll
        for (int ks = 0; ks < 16; ++ks) s += mp[(size_t)ks * 2 * 9 * 6144 + e];
        mo[e] = s;
    }
}
__device__ __forceinline__ void moe_convert(KP p, int layer, LAS unsigned char* lds) {
    bf16_t* W13T = (bf16_t*)(p.ws + OFF_REG + M_W13T); bf16_t* W2T = (bf16_t*)(p.ws + OFF_REG + M_W2T);
    const int tid = tid_fresh(), n2 = tid >> 2, k16 = (tid & 3) * 16;
    const float* w1 = p.in[22] + (size_t)layer * 32 * 1024 * 1024; const float* w3 = p.in[23] + (size_t)layer * 32 * 1024 * 1024; const float* w2 = p.in[24] + (size_t)layer * 32 * 1024 * 1024;
    constexpr int NT = 32 * 16 * 16 + 32 * 8 * 16;
#pragma unroll 2
    for (int u = blockIdx.x; u < NT; u += gridDim.x) {
        const float* sp; bf16_t* dp;
        if (u < 32 * 16 * 16) { const int e = u >> 8, rem = u & 255, nt = rem >> 4, kt = rem & 15; const int np = nt * 128 + n2, tl = np >> 8, r = np & 255;
            sp = (r < 128 ? w1 + tl * 128 + r : w3 + tl * 128 + (r - 128)) + (size_t)e * 1024 * 1024 + (size_t)(kt * 64 + k16) * 1024;
            dp = W13T + ((size_t)e * 2048 + np) * 1024 + kt * 64 + k16; }
        else { const int v = u - 32 * 16 * 16; const int e = v >> 7, rem = v & 127, nt = rem >> 4, kt = rem & 15;
            sp = w2 + (size_t)e * 1024 * 1024 + (size_t)(kt * 64 + k16) * 1024 + nt * 128 + n2;
            dp = W2T + ((size_t)e * 1024 + nt * 128 + n2) * 1024 + kt * 64 + k16; }
        float v[16];
#pragma unroll
        for (int i = 0; i < 16; ++i) v[i] = sp[(size_t)i * 1024];
        u32x4 w0, w1v;
        w0.x = cvt_pk_bf16(v[0], v[1]); w0.y = cvt_pk_bf16(v[2], v[3]); w0.z = cvt_pk_bf16(v[4], v[5]); w0.w = cvt_pk_bf16(v[6], v[7]);
        w1v.x = cvt_pk_bf16(v[8], v[9]); w1v.y = cvt_pk_bf16(v[10], v[11]); w1v.z = cvt_pk_bf16(v[12], v[13]); w1v.w = cvt_pk_bf16(v[14], v[15]);
        *(u32x4*)dp = w0; *(u32x4*)(dp + 8) = w1v;
    }
}

template <int MODE>
__device__ __forceinline__ void norm_phase(KP p, int layer, bool dry) {
    unsigned char* ws = p.ws; const int tid_ = tid_fresh(); const int lane = tid_ & 63, wid = tid_ >> 6;
    const float* MOD = (const float*)(ws + OFF_MOD); float* CTXS = (float*)(ws + OFF_CTXS); bf16_t* H = (bf16_t*)(ws + OFF_H);
    const int* TOKSL = (const int*)(ws + OFF_TOKSL); const bf16_t* YS = (const bf16_t*)(ws + OFF_REG + M_XG);
    for (int R = blockIdx.x * 8 + wid; R < TALL; R += gridDim.x * 8) {
        const int b = R / TB, t = R - b * TB; const bool isctx = t < NCTX; const int r9 = isctx ? 8 : b;
        if ((MODE == 3 || (MODE == 2 && layer == 1)) && isctx) continue;
        const float* src; float* dstx;
        if (MODE == 0) { src = isctx ? p.in[2] + ctx_off(b, t) : p.in[0] + lat_off(b, t); dstx = nullptr; }
        else { dstx = isctx ? CTXS + ctx_off(b, t) : p.out + lat_off(b, t); src = dstx; }
        f32x4 x[4];
#pragma unroll
        for (int i = 0; i < 4; ++i) x[i] = *(const f32x4*)(src + 256 * i + 4 * lane);
        if (MODE == 1 || MODE == 3) {
            const int pl = (MODE == 1) ? layer - 1 : 1;
            const float* g2 = MOD + ((size_t)pl * 9 + r9) * 6144 + 5120;
            const int sa = TOKSL[R * 2], sb = TOKSL[R * 2 + 1];
#pragma unroll
            for (int i = 0; i < 4; ++i) { const int c = 256 * i + 4 * lane; const u32x2 ya = *(const u32x2*)(YS + (size_t)sa * 1024 + c), yb = *(const u32x2*)(YS + (size_t)sb * 1024 + c); const f32x4 gv = *(const f32x4*)(g2 + c);
                x[i][0] += gv[0] * (bflo(ya.x) + bflo(yb.x)); x[i][1] += gv[1] * (bfhi(ya.x) + bfhi(yb.x)); x[i][2] += gv[2] * (bflo(ya.y) + bflo(yb.y)); x[i][3] += gv[3] * (bfhi(ya.y) + bfhi(yb.y)); }
            if (MODE == 1 && !dry) {
#pragma unroll
                for (int i = 0; i < 4; ++i) *(f32x4*)(dstx + 256 * i + 4 * lane) = x[i];
            }
        }
        float ss = 0.f;
#pragma unroll
        for (int i = 0; i < 4; ++i) ss += x[i][0] * x[i][0] + x[i][1] * x[i][1] + x[i][2] * x[i][2] + x[i][3] * x[i][3];
        ss = wave_sum(ss, lane);
        const float rstd = rsqrtf(ss * (1.0f / 1024.0f) + 1e-6f);
        if (MODE == 3) {
#pragma unroll
            for (int i = 0; i < 4; ++i) { const int c = 256 * i + 4 * lane; const f32x4 g = *(const f32x4*)(p.in[25] + c);
                if (!dry) *(f32x4*)(p.out + lat_off(b, t) + c) = x[i] * rstd * g; }
            continue;
        }
        const float* gain = (MODE == 2 ? p.in[7] : p.in[6]) + layer * 1024;
        const float* mrow = MOD + ((size_t)layer * 9 + r9) * 6144 + (MODE == 2 ? 3072 : 0);
        f32x4 h[4];
#pragma unroll
        for (int i = 0; i < 4; ++i) { const int c = 256 * i + 4 * lane; const f32x4 g = *(const f32x4*)(gain + c), sh = *(const f32x4*)(mrow + c), sc = *(const f32x4*)(mrow + 1024 + c);
            h[i] = (x[i] * rstd * g) * (sc + 1.0f) + sh;
            u32x2 w; w.x = cvt_pk_bf16(h[i][0], h[i][1]); w.y = cvt_pk_bf16(h[i][2], h[i][3]); *(u32x2*)(H + (size_t)R * 1024 + c) = w; }
        if (MODE == 2) {
            const float* WR = (const float*)(ws + OFF_WR) + (size_t)layer * 1024 * 36;
            float a[36];
#pragma unroll
            for (int o = 0; o < 36; ++o) a[o] = 0.f;
#pragma unroll
            for (int i = 0; i < 4; ++i)
#pragma unroll
                for (int jj = 0; jj < 4; ++jj) { const float hv = h[i][jj]; const f32x4* wrow = (const f32x4*)(WR + (size_t)(256 * i + 4 * lane + jj) * 36);
#pragma unroll
                    for (int o4 = 0; o4 < 9; ++o4) { const f32x4 w = wrow[o4]; a[4 * o4] += hv * w[0]; a[4 * o4 + 1] += hv * w[1]; a[4 * o4 + 2] += hv * w[2]; a[4 * o4 + 3] += hv * w[3]; } }
#pragma unroll
            for (int o = 0; o < 36; ++o) a[o] = wave_sum(a[o], lane);
            if (lane == 0) {
                const float* bg = p.in[19] + layer * 4; const float* be = p.in[21] + layer * 32;
                float gl[4];
#pragma unroll
                for (int j = 0; j < 4; ++j) gl[j] = a[j] + bg[j];
                int grp = 0; float gm = gl[0];
#pragma unroll
                for (int j = 1; j < 4; ++j) if (gl[j] > gm) { gm = gl[j]; grp = j; }
                float den = 0.f;
#pragma unroll
                for (int j = 0; j < 4; ++j) den += expf(gl[j] - gm);
                const float gp = 1.0f / den;
                float v1 = -3.0e38f, v2 = -3.0e38f; int i1 = 0, i2 = 0;
#pragma unroll
                for (int j = 0; j < 8; ++j) {
                    const float lv = (grp == 0 ? a[4 + j] : grp == 1 ? a[12 + j] : grp == 2 ? a[20 + j] : a[28 + j]) + be[grp * 8 + j];
                    if (lv > v1) { v2 = v1; i2 = i1; v1 = lv; i1 = j; } else if (lv > v2) { v2 = lv; i2 = j; }
                }
                const float e2 = expf(v2 - v1); const float w1 = gp / (1.0f + e2), w2 = gp * e2 / (1.0f + e2);
                const int ex1 = grp * 8 + i1, ex2 = grp * 8 + i2;
                unsigned* cnt = (unsigned*)(ws + OFF_CNT) + layer * 32;
                const unsigned r1 = atomicAdd(cnt + ex1, 1u), r2 = atomicAdd(cnt + ex2, 1u);
                int* EX = (int*)(ws + OFF_EXPID); float* GW = (float*)(ws + OFF_GATEW); int* RK = (int*)(ws + OFF_RANK);
                EX[R * 2] = ex1; EX[R * 2 + 1] = ex2; GW[R * 2] = w1; GW[R * 2 + 1] = w2; RK[R * 2] = (int)r1; RK[R * 2 + 1] = (int)r2;
            }
        }
    }
}

template <int MODE>
__device__ __forceinline__ void norm_phase2(KP p, int layer, bool dry) {
    unsigned char* ws = p.ws; const int tid_ = tid_fresh(); const int lane = tid_ & 63, wid = tid_ >> 6;
    const float* MOD = (const float*)(ws + OFF_MOD); float* CTXS = (float*)(ws + OFF_CTXS); bf16_t* H = (bf16_t*)(ws + OFF_H);
    const int* TOKSL = (const int*)(ws + OFF_TOKSL); const bf16_t* YS = (const bf16_t*)(ws + OFF_REG + M_XG);
    const int stride = gridDim.x * 8;
    for (int R0 = blockIdx.x * 8 + wid; R0 < TALL; R0 += 2 * stride) {
        int Rr[2], bb[2], tt[2]; bool ok[2], ic[2];
#pragma unroll
        for (int rr = 0; rr < 2; ++rr) { const int R = R0 + rr * stride; ok[rr] = R < TALL; Rr[rr] = ok[rr] ? R : R0; bb[rr] = Rr[rr] / TB; tt[rr] = Rr[rr] - bb[rr] * TB; ic[rr] = tt[rr] < NCTX; if (MODE == 3 && ic[rr]) ok[rr] = false; }
        f32x4 x[2][4]; int sa[2], sb[2];
#pragma unroll
        for (int rr = 0; rr < 2; ++rr) {
            const float* src;
            if (MODE == 0) src = ic[rr] ? p.in[2] + ctx_off(bb[rr], tt[rr]) : p.in[0] + lat_off(bb[rr], tt[rr]);
            else src = ic[rr] ? CTXS + ctx_off(bb[rr], tt[rr]) : p.out + lat_off(bb[rr], tt[rr]);
#pragma unroll
            for (int i = 0; i < 4; ++i) x[rr][i] = *(const f32x4*)(src + 256 * i + 4 * lane);
            if (MODE == 1 || MODE == 3) { sa[rr] = TOKSL[Rr[rr] * 2]; sb[rr] = TOKSL[Rr[rr] * 2 + 1]; }
        }
        u32x2 ya[2][4], yb[2][4];
        if (MODE == 1 || MODE == 3) {
#pragma unroll
            for (int rr = 0; rr < 2; ++rr)
#pragma unroll
                for (int i = 0; i < 4; ++i) { const int c = 256 * i + 4 * lane; ya[rr][i] = *(const u32x2*)(YS + (size_t)sa[rr] * 1024 + c); yb[rr][i] = *(const u32x2*)(YS + (size_t)sb[rr] * 1024 + c); }
        }
#pragma unroll
        for (int rr = 0; rr < 2; ++rr) {
            if (!ok[rr]) continue;
            const int R = Rr[rr], b = bb[rr], t = tt[rr]; const int r9 = ic[rr] ? 8 : b;
            if (MODE == 1 || MODE == 3) {
                const int pl = (MODE == 1) ? layer - 1 : 1;
                const float* g2 = MOD + ((size_t)pl * 9 + r9) * 6144 + 5120;
#pragma unroll
                for (int i = 0; i < 4; ++i) { const int c = 256 * i + 4 * lane; const f32x4 gv = *(const f32x4*)(g2 + c); const u32x2 a = ya[rr][i], b2 = yb[rr][i];
                    x[rr][i][0] += gv[0] * (bflo(a.x) + bflo(b2.x)); x[rr][i][1] += gv[1] * (bfhi(a.x) + bfhi(b2.x)); x[rr][i][2] += gv[2] * (bflo(a.y) + bflo(b2.y)); x[rr][i][3] += gv[3] * (bfhi(a.y) + bfhi(b2.y)); }
                if (MODE == 1 && !dry) { float* dstx = ic[rr] ? CTXS + ctx_off(b, t) : p.out + lat_off(b, t);
#pragma unroll
                    for (int i = 0; i < 4; ++i) *(f32x4*)(dstx + 256 * i + 4 * lane) = x[rr][i]; }
            }
            float ss = 0.f;
#pragma unroll
            for (int i = 0; i < 4; ++i) ss += x[rr][i][0] * x[rr][i][0] + x[rr][i][1] * x[rr][i][1] + x[rr][i][2] * x[rr][i][2] + x[rr][i][3] * x[rr][i][3];
            ss = wave_sum(ss, lane);
            const float rstd = rsqrtf(ss * (1.0f / 1024.0f) + 1e-6f);
            if (MODE == 3) {
#pragma unroll
                for (int i = 0; i < 4; ++i) { const int c = 256 * i + 4 * lane; const f32x4 g = *(const f32x4*)(p.in[25] + c);
                    if (!dry) *(f32x4*)(p.out + lat_off(b, t) + c) = x[rr][i] * rstd * g; }
            } else {
                const float* gain = p.in[6] + layer * 1024;
                const float* mrow = MOD + ((size_t)layer * 9 + r9) * 6144;
#pragma unroll
                for (int i = 0; i < 4; ++i) { const int c = 256 * i + 4 * lane; const f32x4 g = *(const f32x4*)(gain + c), sh = *(const f32x4*)(mrow + c), sc = *(const f32x4*)(mrow + 1024 + c);
                    const f32x4 h = (x[rr][i] * rstd * g) * (sc + 1.0f) + sh;
                    u32x2 w; w.x = cvt_pk_bf16(h[0], h[1]); w.y = cvt_pk_bf16(h[2], h[3]); *(u32x2*)(H + (size_t)R * 1024 + c) = w; }
            }
        }
    }
}

__device__ __forceinline__ void norm2_router(KP p, int layer, LAS unsigned char* lds, bool dry) {
    (void)dry;
    unsigned char* ws = p.ws; const int tid_ = tid_fresh(); const int lane = tid_ & 63, wid = tid_ >> 6, fr = lane & 15, fq = lane >> 4;
    const float* MOD = (const float*)(ws + OFF_MOD); const float* CTXS = (const float*)(ws + OFF_CTXS); bf16_t* H = (bf16_t*)(ws + OFF_H);
    const bf16_t* WH = (const bf16_t*)(ws + OFF_WR) + (size_t)layer * 2 * 48 * 1024; const bf16_t* WL = WH + 48 * 1024;
    LAS float* ssp = (LAS float*)lds;
    LAS float* part = (LAS float*)(lds + 512);
    LAS float* lgf = (LAS float*)(lds + 512 + 8 * 16 * 48 * 4);
    LAS unsigned* lcnt = (LAS unsigned*)(lds + 512 + 8 * 16 * 48 * 4 + 16 * 48 * 4);
    __syncthreads();
    if (tid_ < 64) lcnt[tid_] = 0u;
    __syncthreads();
    const float* gain = p.in[7] + layer * 1024;
    const int cw = 128 * wid + 8 * fq;
    const int ntask = TALL / 16;
    auto xrow = [&](int task) -> const float* { const int R0 = task * 16; const int b = R0 / TB, t = R0 - b * TB; return (t < NCTX ? CTXS + ctx_off(b, t + fr) : p.out + lat_off(b, t + fr)) + cw; };
    auto skip = [&](int task) -> bool { return layer == 1 && ((task * 16) % TB) < NCTX; };
    f32x4 xn[4][2];
    int task = blockIdx.x; while (task < ntask && skip(task)) task += gridDim.x;
    if (task < ntask) { const float* src = xrow(task);
#pragma unroll
        for (int s2 = 0; s2 < 4; ++s2) { xn[s2][0] = *(const f32x4*)(src + 32 * s2); xn[s2][1] = *(const f32x4*)(src + 32 * s2 + 4); } }
    while (task < ntask) {
        const int R0 = task * 16; const int b = R0 / TB, t = R0 - b * TB; const bool isctx = t < NCTX; const int r9 = isctx ? 8 : b;
        f32x4 x[4][2];
#pragma unroll
        for (int s2 = 0; s2 < 4; ++s2) { x[s2][0] = xn[s2][0]; x[s2][1] = xn[s2][1]; }
        int nxt = task + gridDim.x; while (nxt < ntask && skip(nxt)) nxt += gridDim.x;
        if (nxt < ntask) { const float* src = xrow(nxt);
#pragma unroll
            for (int s2 = 0; s2 < 4; ++s2) { xn[s2][0] = *(const f32x4*)(src + 32 * s2); xn[s2][1] = *(const f32x4*)(src + 32 * s2 + 4); } }
        float ss = 0.f;
#pragma unroll
        for (int s2 = 0; s2 < 4; ++s2) { const f32x4 a = x[s2][0], c = x[s2][1]; ss += a[0] * a[0] + a[1] * a[1] + a[2] * a[2] + a[3] * a[3] + c[0] * c[0] + c[1] * c[1] + c[2] * c[2] + c[3] * c[3]; }
        ss += sx(ss, 16, lane); ss += sx(ss, 32, lane);
        if (fq == 0) ssp[wid * 16 + fr] = ss;
        __syncthreads();
        float tot = 0.f;
#pragma unroll
        for (int w2 = 0; w2 < 8; ++w2) tot += ssp[w2 * 16 + fr];
        const float rstd = rsqrtf(tot * (1.0f / 1024.0f) + 1e-6f);
        const float* mrow = MOD + ((size_t)layer * 9 + r9) * 6144 + 3072 + cw;
        const float* grow = gain + cw;
        bf16_t* hrow = H + (size_t)(R0 + fr) * 1024 + cw;
        f32x4 acc[3];
#pragma unroll
        for (int nb = 0; nb < 3; ++nb) acc[nb] = (f32x4){0.f, 0.f, 0.f, 0.f};
#pragma unroll
        for (int s2 = 0; s2 < 4; ++s2) {
            const int c = 32 * s2;
            const f32x4 g0 = *(const f32x4*)(grow + c), g1 = *(const f32x4*)(grow + c + 4);
            const f32x4 sh0 = *(const f32x4*)(mrow + c), sh1 = *(const f32x4*)(mrow + c + 4), sc0 = *(const f32x4*)(mrow + 1024 + c), sc1 = *(const f32x4*)(mrow + 1024 + c + 4);
            const f32x4 h0 = (x[s2][0] * rstd * g0) * (sc0 + 1.0f) + sh0, h1 = (x[s2][1] * rstd * g1) * (sc1 + 1.0f) + sh1;
            u32x4 hw; hw.x = cvt_pk_bf16(h0[0], h0[1]); hw.y = cvt_pk_bf16(h0[2], h0[3]); hw.z = cvt_pk_bf16(h1[0], h1[1]); hw.w = cvt_pk_bf16(h1[2], h1[3]);
            *(u32x4*)(hrow + c) = hw;
            u32x4 lw; lw.x = cvt_pk_bf16(h0[0] - bflo(hw.x), h0[1] - bfhi(hw.x)); lw.y = cvt_pk_bf16(h0[2] - bflo(hw.y), h0[3] - bfhi(hw.y));
            lw.z = cvt_pk_bf16(h1[0] - bflo(hw.z), h1[1] - bfhi(hw.z)); lw.w = cvt_pk_bf16(h1[2] - bflo(hw.w), h1[3] - bfhi(hw.w));
            const bf16x8 ahi = __builtin_bit_cast(bf16x8, hw), alo = __builtin_bit_cast(bf16x8, lw);
#pragma unroll
            for (int nb = 0; nb < 3; ++nb) {
                const bf16x8 bhi = *(const bf16x8*)(WH + (size_t)(16 * nb + fr) * 1024 + cw + c), blo = *(const bf16x8*)(WL + (size_t)(16 * nb + fr) * 1024 + cw + c);
                acc[nb] = __builtin_amdgcn_mfma_f32_16x16x32_bf16(ahi, bhi, acc[nb], 0, 0, 0);
                acc[nb] = __builtin_amdgcn_mfma_f32_16x16x32_bf16(alo, bhi, acc[nb], 0, 0, 0);
                acc[nb] = __builtin_amdgcn_mfma_f32_16x16x32_bf16(ahi, blo, acc[nb], 0, 0, 0);
            }
        }
#pragma unroll
        for (int nb = 0; nb < 3; ++nb)
#pragma unroll
            for (int jj = 0; jj < 4; ++jj) part[(wid * 16 + 4 * fq + jj) * 48 + 16 * nb + fr] = acc[nb][jj];
        __syncthreads();
        for (int e = tid_; e < 16 * 48; e += 512) { float sm = 0.f;
#pragma unroll
            for (int w2 = 0; w2 < 8; ++w2) sm += part[w2 * 16 * 48 + e];
            lgf[e] = sm; }
        __syncthreads();
        if (tid_ < 16) {
            const LAS float* a = lgf + tid_ * 48; const int R = R0 + tid_;
            const float* bg = p.in[19] + layer * 4; const float* be = p.in[21] + layer * 32;
            float gl[4];
#pragma unroll
            for (int j = 0; j < 4; ++j) gl[j] = a[j] + bg[j];
            int grp = 0; float gm = gl[0];
#pragma unroll
            for (int j = 1; j < 4; ++j) if (gl[j] > gm) { gm = gl[j]; grp = j; }
            float den = 0.f;
#pragma unroll
            for (int j = 0; j < 4; ++j) den += expf(gl[j] - gm);
            const float gp = 1.0f / den;
            float v1 = -3.0e38f, v2 = -3.0e38f; int i1 = 0, i2 = 0;
#pragma unroll
            for (int j = 0; j < 8; ++j) { const float lv = a[4 + grp * 8 + j] + be[grp * 8 + j];
                if (lv > v1) { v2 = v1; i2 = i1; v1 = lv; i1 = j; } else if (lv > v2) { v2 = lv; i2 = j; } }
            const float e2 = expf(v2 - v1); const float w1 = gp / (1.0f + e2), w2 = gp * e2 / (1.0f + e2);
            const int ex1 = grp * 8 + i1, ex2 = grp * 8 + i2;
            const unsigned r1 = __hip_atomic_fetch_add(lcnt + ex1, 1u, __ATOMIC_RELAXED, __HIP_MEMORY_SCOPE_WORKGROUP), r2 = __hip_atomic_fetch_add(lcnt + ex2, 1u, __ATOMIC_RELAXED, __HIP_MEMORY_SCOPE_WORKGROUP);
            int* EX = (int*)(ws + OFF_EXPID); float* GW = (float*)(ws + OFF_GATEW); int* RK = (int*)(ws + OFF_RANK);
            EX[R * 2] = ex1; EX[R * 2 + 1] = ex2; GW[R * 2] = w1; GW[R * 2 + 1] = w2; RK[R * 2] = (int)r1; RK[R * 2 + 1] = (int)r2;
        }
        task = nxt;
    }
    __syncthreads();
    if (tid_ < 32) { unsigned* cnt = (unsigned*)(ws + OFF_CNT) + layer * 32; const unsigned c = lcnt[tid_]; lcnt[32 + tid_] = c ? atomicAdd(cnt + tid_, c) : 0u; }
    __syncthreads();
    if (tid_ < 16) {
        int* EX = (int*)(ws + OFF_EXPID); int* RK = (int*)(ws + OFF_RANK);
        for (int tk = blockIdx.x; tk < ntask; tk += gridDim.x) {
            if (skip(tk)) continue;
            const int R = tk * 16 + tid_;
            RK[R * 2] += (int)lcnt[32 + EX[R * 2]]; RK[R * 2 + 1] += (int)lcnt[32 + EX[R * 2 + 1]];
        }
    }
}

__device__ __forceinline__ void moe_table(KP p, int layer, LAS int* tab) {
    if (tid_fresh() == 0) {
        const unsigned* cnt = (const unsigned*)(p.ws + OFF_CNT) + layer * 32; int s = 0, tl = 0;
        for (int e = 0; e < 32; ++e) { const int c = (int)__hip_atomic_load(cnt + e, __ATOMIC_RELAXED, __HIP_MEMORY_SCOPE_AGENT); tab[e] = c; tab[32 + e] = s; tab[64 + e] = tl; s += c; tl += (c + 255) >> 8; }
        tab[96] = tl;
    }
    __syncthreads();
}
__device__ __forceinline__ void dispatch_phase(KP p, int layer, LAS int* tab) {
    unsigned char* ws = p.ws; const int tid_ = tid_fresh();
    moe_table(p, layer, tab);
    const int* EX = (const int*)(ws + OFF_EXPID); const float* GW = (const float*)(ws + OFF_GATEW); const int* RK = (const int*)(ws + OFF_RANK);
    int* TOKSL = (int*)(ws + OFF_TOKSL); float* SLOTW = (float*)(ws + OFF_SLOTW); int* SLOTTOK = (int*)(ws + OFF_SLOTTOK);
    for (int idx = blockIdx.x * 512 + tid_; idx < TALL * 2; idx += gridDim.x * 512) {
        const int R = idx >> 1;
        if (layer == 1 && (R % TB) < NCTX) continue;
        const int slot = tab[32 + EX[idx]] + RK[idx];
        TOKSL[idx] = slot; SLOTW[slot] = GW[idx]; SLOTTOK[slot] = R;
    }
}
__device__ __forceinline__ void moe_tok_table(KP p, const LAS int* tab, LAS int* tok) {
    const int tid_ = tid_fresh(); const int* SLOTTOK = (const int*)(p.ws + OFF_SLOTTOK);
    const int ntile = tab[96];
    for (int i = 0;; ++i) {
        const int L = i * (int)gridDim.x + (int)blockIdx.x;
        if (L >= ntile * 8 || i >= 22) break;
        const int tg = L >> 3; int e = 0;
#pragma unroll 1
        for (int j = 1; j < 32; ++j) e = (tab[64 + j] <= tg) ? j : e;
        const int mt = tg - tab[64 + e]; const int slot0 = tab[32 + e] + 256 * mt, valid = tab[e] - 256 * mt;
        if (tid_ < 256) tok[i * 256 + tid_] = SLOTTOK[slot0 + (tid_ < valid ? tid_ : 0)];
    }
    __syncthreads();
}

__device__ __forceinline__ void gate_phase(KP p, int layer, int g, LAS unsigned char* lds) {
    unsigned char* reg = p.ws + OFF_REG; const int tid = tid_fresh();
    const bf16_t* GQK = (const bf16_t*)(reg + R_GQK); bf16_t* GIN = (bf16_t*)(reg + R_GIN); float* GDEC = (float*)(reg + R_GDEC); const float* GLR = (const float*)(reg + R_GLR);
    LAS float* lr = (LAS float*)lds;
    const float* wa = p.in[9] + (size_t)layer * 2 * 16 * 512; const float* ba = p.in[10] + layer * 2 * 512;
    float w[16]; float bav = 0.f; int dprev = -1;
#pragma unroll
    for (int r = 0; r < 16; ++r) w[r] = 0.f;
    for (int u = blockIdx.x; u < BG * NCH * 2; u += gridDim.x) {
        const int dir = u & 1, rest = u >> 1, bl = rest / NCH, ch = rest - bl * NCH; const int r0 = bl * TB + ch * CH;
        if (dir != dprev) { dprev = dir;
#pragma unroll
            for (int r = 0; r < 16; ++r) w[r] = wa[(dir * 16 + r) * 512 + tid] * LOG2E;
            bav = ba[dir * 512 + tid] * LOG2E; }
        __syncthreads();
        for (int e = tid; e < 64 * 16; e += 512) lr[e] = GLR[(size_t)(r0 + (e >> 4)) * 32 + dir * 16 + (e & 15)];
        __syncthreads();
        bf16_t* GO = GIN + (size_t)dir * TG * 1024;
        float cum = 0.f;
#pragma unroll 1
        for (int hh = 0; hh < 2; ++hh) {
            unsigned short qv[32], kv[32];
#pragma unroll
            for (int s2 = 0; s2 < 32; ++s2) { const int st = hh * 32 + s2; const int j = dir ? CH - 1 - st : st; const size_t ro = (size_t)(r0 + j) * 1024; qv[s2] = GQK[ro + tid]; kv[s2] = GQK[ro + 512 + tid]; }
#pragma unroll
            for (int s2 = 0; s2 < 32; ++s2) {
                const int st = hh * 32 + s2; const int j = dir ? CH - 1 - st : st;
                const LAS f32x4* l4 = (const LAS f32x4*)(lr + j * 16);
                const f32x4 a0 = l4[0], a1 = l4[1], a2 = l4[2], a3 = l4[3];
                float z = bav;
                z += a0[0] * w[0] + a0[1] * w[1] + a0[2] * w[2] + a0[3] * w[3] + a1[0] * w[4] + a1[1] * w[5] + a1[2] * w[6] + a1[3] * w[7]
                   + a2[0] * w[8] + a2[1] * w[9] + a2[2] * w[10] + a2[3] * w[11] + a3[0] * w[12] + a3[1] * w[13] + a3[2] * w[14] + a3[3] * w[15];
                const float la = -(fmaxf(-z, 0.f) + __builtin_amdgcn_logf(1.0f + __builtin_amdgcn_exp2f(-fabsf(z)))) * (1.0f / 16.0f);
                cum += la; const float e = __builtin_amdgcn_exp2f(cum), ei = __builtin_amdgcn_exp2f(-cum);
                const size_t ro = (size_t)(r0 + j) * 1024;
                GO[ro + tid] = f2bf(bf2f(qv[s2]) * e); GO[ro + 512 + tid] = f2bf(bf2f(kv[s2]) * ei);
            }
        }
        GDEC[((size_t)(dir * BG + bl) * NCH + ch) * 512 + tid] = __builtin_amdgcn_exp2f(cum);
    }
}
__device__ __forceinline__ void stats_phase(KP p, int g, bool dry) {
    unsigned char* reg = p.ws + OFF_REG; const int tid_ = tid_fresh(); const int lane = tid_ & 63, wid = tid_ >> 6;
    f32x2* ST = (f32x2*)(p.ws + OFF_STATS);
    const int stride = gridDim.x * 8;
    for (int R0 = blockIdx.x * 8 + wid; R0 < TG; R0 += 2 * stride) {
        const int R1 = R0 + stride; const bool two = R1 < TG; const int R1c = two ? R1 : R0;
        u32x2 av[2][2][4], bv[2][2][4];
#pragma unroll
        for (int rr = 0; rr < 2; ++rr)
#pragma unroll
            for (int mix = 0; mix < 2; ++mix) {
                const bf16_t* of = (const bf16_t*)(reg + (mix ? R_ORF : R_OGF)) + (size_t)(rr ? R1c : R0) * 1024; const bf16_t* ob = (const bf16_t*)(reg + (mix ? R_ORB : R_OGB)) + (size_t)(rr ? R1c : R0) * 1024;
#pragma unroll
                for (int i = 0; i < 4; ++i) { av[rr][mix][i] = *(const u32x2*)(of + 256 * i + 4 * lane); bv[rr][mix][i] = *(const u32x2*)(ob + 256 * i + 4 * lane); }
            }
#pragma unroll
        for (int rr = 0; rr < 2; ++rr) {
            if (rr == 1 && !two) break;
            const int R = rr ? R1 : R0;
#pragma unroll
            for (int mix = 0; mix < 2; ++mix) {
                bf16_t* of = (bf16_t*)(reg + (mix ? R_ORF : R_OGF)) + (size_t)R * 1024;
#pragma unroll
                for (int i = 0; i < 4; ++i) {
                    const int c = 256 * i + 4 * lane; const u32x2 a = av[rr][mix][i], b2 = bv[rr][mix][i];
                    const float o0 = bflo(a.x) + bflo(b2.x), o1 = bfhi(a.x) + bfhi(b2.x), o2 = bflo(a.y) + bflo(b2.y), o3 = bfhi(a.y) + bfhi(b2.y);
                    const float mean = wave_sum(o0 + o1 + o2 + o3, lane) * (1.0f / 256.0f);
                    const float d0 = o0 - mean, d1 = o1 - mean, d2 = o2 - mean, d3 = o3 - mean;
                    const float var = wave_sum(d0 * d0 + d1 * d1 + d2 * d2 + d3 * d3, lane) * (1.0f / 256.0f);
                    u32x2 w; w.x = cvt_pk_bf16(o0, o1); w.y = cvt_pk_bf16(o2, o3); if (!dry) *(u32x2*)(of + c) = w;
                    if (lane == 0) ST[((size_t)mix * TG + R) * 4 + i] = (f32x2){mean, rsqrtf(var + 1e-6f)};
                }
            }
        }
    }
}

#if 1
__device__ __forceinline__ void scan_naive(KP p, int layer, int g, LAS unsigned char* lds) {
    unsigned char* reg = p.ws + OFF_REG; const int tid = tid_fresh(), sub = tid >> 8, e = tid & 255;
    LAS float* sh = (LAS float*)lds + sub * 512;
    for (int u = blockIdx.x; u < 32; u += gridDim.x) {
        const int chain = u * 2 + sub; const int dir = chain & 1, h = (chain >> 1) & 3, bl = (chain >> 3) & 3, mix = chain >> 5;
        if (!SCAN_E1 && ((SCAN_MASK >> (mix * 2 + dir)) & 1)) continue;
        const bf16_t* QK = (const bf16_t*)(reg + (mix ? R_RQK : R_GQK)); const bf16_t* VT = (const bf16_t*)(reg + (mix ? R_RVT : R_GVT));
        bf16_t* O = (bf16_t*)(reg + (mix ? (dir ? R_ORB : R_ORF) : (dir ? R_OGB : R_OGF)));
        const float* GLR = (const float*)(reg + R_GLR);
        float wa[16]; float bav = 0.f;
        if (e < 128) {
#pragma unroll
            for (int r = 0; r < 16; ++r) wa[r] = p.in[9][(((size_t)layer * 2 + dir) * 16 + r) * 512 + h * 128 + e];
            bav = p.in[10][((size_t)layer * 2 + dir) * 512 + h * 128 + e];
        }
        const float gam = 1.0f - exp2f(-5.0f - (float)h);
        float S[128];
#pragma unroll
        for (int d = 0; d < 128; ++d) S[d] = 0.f;
        const bf16_t* vrow = VT + ((size_t)bl * 1024 + h * 256 + e) * TB;
        for (int s = 0; s < TB; ++s) {
            const int t = dir == 0 ? s : (s < NCTX ? NCTX - 1 - s : TB - 1 - (s - NCTX));
            const size_t ro = (size_t)(bl * TB + t);
            __syncthreads();
            if (e < 128) {
                sh[e] = bf2f(QK[ro * 1024 + h * 128 + e]); sh[128 + e] = bf2f(QK[ro * 1024 + 512 + h * 128 + e]);
                float a;
                if (mix == 0) { float z = bav;
#pragma unroll
                    for (int r = 0; r < 16; ++r) z += GLR[ro * 32 + dir * 16 + r] * wa[r];
                    a = expf(-(fmaxf(-z, 0.f) + log1pf(expf(-fabsf(z)))) * (1.0f / 16.0f)); }
                else a = gam;
                sh[256 + e] = a;
            }
            __syncthreads();
            const float v = bf2f(vrow[t]);
            float o = 0.f;
            if (dir == 0) {
#pragma unroll
                for (int d = 0; d < 128; ++d) { S[d] = sh[256 + d] * S[d] + sh[128 + d] * v; o += sh[d] * S[d]; }
            } else {
#pragma unroll
                for (int d = 0; d < 128; ++d) { const float sd = sh[256 + d] * S[d]; o += sh[d] * sd; S[d] = sd + sh[128 + d] * v; }
            }
            O[ro * 1024 + h * 256 + e] = f2bf(o);
        }
    }
}
#endif


#if 1
constexpr int SC_QS = 272, SC_VS = 144;
constexpr int SC_QB = 0, SC_KB = SC_QB + 2 * 64 * SC_QS, SC_VB = SC_KB + 2 * 64 * SC_QS, SC_ST = SC_VB + 2 * 64 * SC_VS,
              SC_DEC = SC_ST + 2 * 64 * SC_QS, SC_SCL = SC_DEC + 2 * 128 * 4, SC_END = SC_SCL + 128 * 4, SC_PB = 132096, SC_OB = SC_PB + 64 * SC_VS;
static_assert(SC_OB + 64 * SC_VS <= LDS_BYTES, "scan LDS tail");
static_assert(SC_END <= 131072, "scan LDS");
__device__ __forceinline__ u32x4 scale8(u32x4 v, float s) {
    u32x4 r; r.x = cvt_pk_bf16(bflo(v.x) * s, bfhi(v.x) * s); r.y = cvt_pk_bf16(bflo(v.y) * s, bfhi(v.y) * s); r.z = cvt_pk_bf16(bflo(v.z) * s, bfhi(v.z) * s); r.w = cvt_pk_bf16(bflo(v.w) * s, bfhi(v.w) * s); return r;
}
__device__ __forceinline__ void scan_mfma(KP p, int layer, int g, LAS unsigned char* lds, bool cmp_mode) {
    unsigned char* reg = p.ws + OFF_REG; const int tid = tid_fresh(), wid = tid >> 6, lane = tid & 63, fr = lane & 15, fq = lane >> 4;
#if SCAN_DELAY
    { const long long t0_ = clock64(); while (clock64() - t0_ < 4000000ll) __builtin_amdgcn_s_sleep(8); }
#endif
    for (int u = blockIdx.x; u < 256; u += gridDim.x) {
        const int dvq = (u >> 3) & 3, chain = (u & 7) + 8 * (u >> 5); const int dir = chain & 1, h = (chain >> 1) & 3, bl = (chain >> 3) & 3, mix = chain >> 5;
        if (!((SCAN_MASK >> (mix * 2 + dir)) & 1)) continue;
        const bf16_t* QI; const bf16_t* KI;
        if (mix == 0) { QI = (const bf16_t*)(reg + R_GIN) + (size_t)dir * TG * 1024; KI = QI + 512; } else { QI = (const bf16_t*)(reg + R_RQK); KI = QI + 512; }
        const bf16_t* VT = (const bf16_t*)(reg + (mix ? R_RVT : R_GVT)) + ((size_t)bl * 1024 + h * 256 + dvq * 64) * TB;
        bf16_t* O = (bf16_t*)(reg + (mix ? (dir ? R_ORB : R_ORF) : (dir ? R_OGB : R_OGF)));
        const float* GDEC = (const float*)(reg + R_GDEC) + ((size_t)(dir * BG + bl) * NCH) * 512 + h * 128;
        const float lam = logf(1.0f - exp2f(-5.0f - (float)h));
        __syncthreads();
        for (int e = tid; e < 2 * 64 * SC_QS / 16; e += 512) *(LAS u32x4*)(lds + SC_ST + e * 16) = (u32x4){0u, 0u, 0u, 0u};
        __syncthreads();
        const bool po = wid < 4; const int wq = wid & 3, t2_ = tid & 255;
        const int jb2 = 2 * (wq & 1), ib2 = 2 * (wq >> 1);
        const int db2 = 2 * wq;
        f32x4 R[8];
#pragma unroll
        for (int x = 0; x < 8; ++x) R[x] = (f32x4){0.f, 0.f, 0.f, 0.f};
        const int qrow0 = t2_ >> 4, qc8 = t2_ & 15;
        const int ve = t2_ >> 3, vj8 = t2_ & 7;
        u32x4 rq[4], rk[4], rv[2]; float rdec = 0.f;
        const float rdecay = expf(64.0f * lam);
        auto chunk_of = [&](int s) { return dir == 0 ? s : (s < 4 ? 3 - s : 131 - (s - 4)); };
        auto gload = [&](int ch) {
            const size_t r0 = (size_t)bl * TB + (size_t)ch * CH;
#pragma unroll
            for (int x = 0; x < 4; ++x) { const size_t ro = (r0 + qrow0 + 16 * x) * 1024 + h * 128 + qc8 * 8; rq[x] = *(const u32x4*)(QI + ro); rk[x] = *(const u32x4*)(KI + ro); }
#pragma unroll
            for (int x = 0; x < 2; ++x) rv[x] = *(const u32x4*)(VT + (size_t)(ve + 32 * x) * TB + ch * CH + vj8 * 8);
            const float gd = GDEC[(size_t)ch * 512 + (t2_ & 127)];
            rdec = mix ? rdecay : gd;
        };
        const float vs0 = mix ? expf(-(dir == 0 ? (float)(vj8 * 8 + 1) : (float)(64 - vj8 * 8)) * lam) : 1.0f;
        const float rr = mix ? expf(dir == 0 ? -lam : lam) : 1.0f; const float vs1 = vs0 * rr, rr2 = rr * rr;
        auto lstore = [&](int buf) {
#pragma unroll
            for (int x = 0; x < 4; ++x) {
                *(LAS u32x4*)(lds + SC_QB + buf * 64 * SC_QS + (qrow0 + 16 * x) * SC_QS + qc8 * 16) = rq[x];
                *(LAS u32x4*)(lds + SC_KB + buf * 64 * SC_QS + (qrow0 + 16 * x) * SC_QS + qc8 * 16) = rk[x]; }
#pragma unroll
            for (int x = 0; x < 2; ++x) { const u32x4 r = rv[x];
                float fa = vs0, fb = vs1; u32x4 v2; v2.x = cvt_pk_bf16(bflo(r.x) * fa, bfhi(r.x) * fb); fa *= rr2; fb *= rr2; v2.y = cvt_pk_bf16(bflo(r.y) * fa, bfhi(r.y) * fb); fa *= rr2; fb *= rr2;
                v2.z = cvt_pk_bf16(bflo(r.z) * fa, bfhi(r.z) * fb); fa *= rr2; fb *= rr2; v2.w = cvt_pk_bf16(bflo(r.w) * fa, bfhi(r.w) * fb);
                *(LAS u32x4*)(lds + SC_VB + buf * 64 * SC_VS + (ve + 32 * x) * SC_VS + vj8 * 16) = v2; }
            if (t2_ < 128) ((LAS float*)(lds + SC_DEC))[buf * 128 + t2_] = rdec;
        };
        if (!po) { gload(chunk_of(0)); lstore(0); gload(chunk_of(1)); }
        __syncthreads();
        float fo[2];
#pragma unroll
        for (int x = 0; x < 2; ++x) { const int i = 16 * (ib2 + x) + fr; fo[x] = mix ? expf((dir == 0 ? (float)(i + 1) : (float)(64 - i)) * lam) : 1.0f; }
        auto ostore = [&](int chp, int ob) {
            const size_t r0 = (size_t)bl * TB + (size_t)chp * CH;
#pragma unroll
            for (int k = 0; k < 2; ++k) { const int i = 32 * k + (t2_ >> 3);
                const u32x4 v = *(const LAS u32x4*)(lds + SC_PB + ob * 64 * SC_VS + i * SC_VS + (t2_ & 7) * 16);
                *(u32x4*)(O + (r0 + i) * 1024 + h * 256 + dvq * 64 + (t2_ & 7) * 8) = v; }
        };
        const int ebp = 2 * (wq & 1);
        for (int s = 0; s < NCH; ++s) {
            const int cur = s & 1, stb = s & 1;
            const LAS unsigned char* Qc = lds + SC_QB + cur * 64 * SC_QS; const LAS unsigned char* Kc = lds + SC_KB + cur * 64 * SC_QS; const LAS unsigned char* Vc = lds + SC_VB + cur * 64 * SC_VS;
            if (po) {
#pragma unroll
                for (int x = 0; x < 2; ++x)
#pragma unroll
                    for (int ks = 0; ks < 4; ++ks) R[4 * x + ks] = __builtin_bit_cast(f32x4, *(const LAS bf16x8*)(Qc + (16 * (ib2 + x) + fr) * SC_QS + ks * 64 + fq * 16));
                bf16x8 pb[2][2];
#pragma unroll
                for (int s2 = 0; s2 < 2; ++s2) {
                    bf16x8 kfr[2][4];
#pragma unroll
                    for (int y = 0; y < 2; ++y)
#pragma unroll
                        for (int ks = 0; ks < 4; ++ks) kfr[y][ks] = *(const LAS bf16x8*)(Kc + (16 * (2 * s2 + y) + fr) * SC_QS + ks * 64 + fq * 16);
                    __builtin_amdgcn_sched_barrier(0);
                    f32x4 c[2][2];
#pragma unroll
                    for (int y = 0; y < 2; ++y)
#pragma unroll
                        for (int x = 0; x < 2; ++x) c[y][x] = (f32x4){0.f, 0.f, 0.f, 0.f};
#pragma unroll
                    for (int ks = 0; ks < 4; ++ks)
#pragma unroll
                        for (int y = 0; y < 2; ++y)
#pragma unroll
                            for (int x = 0; x < 2; ++x) c[y][x] = __builtin_amdgcn_mfma_f32_16x16x32_bf16(kfr[y][ks], __builtin_bit_cast(bf16x8, R[4 * x + ks]), c[y][x], 0, 0, 0);
#pragma unroll
                    for (int x = 0; x < 2; ++x) { const int i = 16 * (ib2 + x) + fr; u32x4 w4;
#pragma unroll
                        for (int y = 0; y < 2; ++y) { const int j0 = 16 * (2 * s2 + y) + 4 * fq; float v[4];
#pragma unroll
                            for (int jj = 0; jj < 4; ++jj) { const int j = j0 + jj; const bool keep = dir == 0 ? (j <= i) : (j > i); v[jj] = keep ? c[y][x][jj] : 0.f; }
                            if (y == 0) { w4.x = cvt_pk_bf16(v[0], v[1]); w4.y = cvt_pk_bf16(v[2], v[3]); } else { w4.z = cvt_pk_bf16(v[0], v[1]); w4.w = cvt_pk_bf16(v[2], v[3]); } }
                        pb[x][s2] = __builtin_bit_cast(bf16x8, w4); }
                }
                bf16x8 va[2][2], st[2][4];
#pragma unroll
                for (int y = 0; y < 2; ++y)
#pragma unroll
                    for (int s2 = 0; s2 < 2; ++s2) {
                        const u32x2 lo = *(const LAS u32x2*)(Vc + (16 * (ebp + y) + fr) * SC_VS + (32 * s2 + 4 * fq) * 2), hi = *(const LAS u32x2*)(Vc + (16 * (ebp + y) + fr) * SC_VS + (32 * s2 + 16 + 4 * fq) * 2);
                        va[y][s2] = __builtin_bit_cast(bf16x8, (u32x4){lo.x, lo.y, hi.x, hi.y}); }
#pragma unroll
                for (int y = 0; y < 2; ++y)
#pragma unroll
                    for (int ks = 0; ks < 4; ++ks) st[y][ks] = *(const LAS bf16x8*)(lds + SC_ST + stb * 64 * SC_QS + (16 * (ebp + y) + fr) * SC_QS + ks * 64 + fq * 16);
                __builtin_amdgcn_sched_barrier(0);
                f32x4 co[2][2];
#pragma unroll
                for (int y = 0; y < 2; ++y)
#pragma unroll
                    for (int x = 0; x < 2; ++x) co[y][x] = (f32x4){0.f, 0.f, 0.f, 0.f};
#pragma unroll
                for (int ks = 0; ks < 4; ++ks)
#pragma unroll
                    for (int y = 0; y < 2; ++y)
#pragma unroll
                        for (int x = 0; x < 2; ++x) co[y][x] = __builtin_amdgcn_mfma_f32_16x16x32_bf16(st[y][ks], __builtin_bit_cast(bf16x8, R[4 * x + ks]), co[y][x], 0, 0, 0);
#pragma unroll
                for (int s2 = 0; s2 < 2; ++s2)
#pragma unroll
                    for (int y = 0; y < 2; ++y)
#pragma unroll
                        for (int x = 0; x < 2; ++x) co[y][x] = __builtin_amdgcn_mfma_f32_16x16x32_bf16(va[y][s2], pb[x][s2], co[y][x], 0, 0, 0);
#pragma unroll
                for (int y = 0; y < 2; ++y)
#pragma unroll
                    for (int x = 0; x < 2; ++x) { const f32x4 cc = co[y][x] * fo[x]; const int i = 16 * (ib2 + x) + fr;
                        u32x2 w; w.x = cvt_pk_bf16(cc[0], cc[1]); w.y = cvt_pk_bf16(cc[2], cc[3]);
                        *(LAS u32x2*)(lds + SC_PB + (s & 1) * 64 * SC_VS + i * SC_VS + (16 * (ebp + y) + 4 * fq) * 2) = w; }
            } else {
                if (s > 0) ostore(chunk_of(s - 1), (s - 1) & 1);
                bf16x8 ka[2][2], vb[2][4];
#pragma unroll
                for (int x = 0; x < 2; ++x)
#pragma unroll
                    for (int ks = 0; ks < 2; ++ks) {
                        typedef short s16x4_t __attribute__((ext_vector_type(4)));
                        const LAS unsigned char* tp = Kc + (32 * ks + 8 * fq + (fr >> 2)) * SC_QS + (16 * (db2 + x) + 4 * (fr & 3)) * 2;
                        const s16x4_t t0 = __builtin_amdgcn_ds_read_tr16_b64_v4i16((LAS s16x4_t*)tp), t1 = __builtin_amdgcn_ds_read_tr16_b64_v4i16((LAS s16x4_t*)(tp + 4 * SC_QS));
                        ka[x][ks] = (bf16x8){t0[0], t0[1], t0[2], t0[3], t1[0], t1[1], t1[2], t1[3]};
                    }
#pragma unroll
                for (int ks = 0; ks < 2; ++ks)
#pragma unroll
                    for (int eb = 0; eb < 4; ++eb) vb[ks][eb] = *(const LAS bf16x8*)(Vc + (16 * eb + fr) * SC_VS + ks * 64 + fq * 16);
                f32x4 dv[2];
#pragma unroll
                for (int x = 0; x < 2; ++x) dv[x] = *(const LAS f32x4*)(lds + SC_DEC + (cur * 128 + 16 * (db2 + x) + 4 * fq) * 4);
                __builtin_amdgcn_sched_barrier(0);
#pragma unroll
                for (int ks = 0; ks < 2; ++ks)
#pragma unroll
                    for (int x = 0; x < 2; ++x)
#pragma unroll
                        for (int eb = 0; eb < 4; ++eb) R[4 * x + eb] = __builtin_amdgcn_mfma_f32_16x16x32_bf16(ka[x][ks], vb[ks][eb], R[4 * x + eb], 0, 0, 0);
#pragma unroll
                for (int x = 0; x < 2; ++x)
#pragma unroll
                    for (int eb = 0; eb < 4; ++eb) { const f32x4 sv = R[4 * x + eb] * dv[x]; R[4 * x + eb] = sv;
                        u32x2 w; w.x = cvt_pk_bf16(sv[0], sv[1]); w.y = cvt_pk_bf16(sv[2], sv[3]);
                        *(LAS u32x2*)(lds + SC_ST + (stb ^ 1) * 64 * SC_QS + (16 * eb + fr) * SC_QS + (16 * (db2 + x) + 4 * fq) * 2) = w; }
                lstore(cur ^ 1);
                gload(chunk_of(s + 2 < NCH ? s + 2 : NCH - 1));
            }
            __syncthreads();
        }
        if (!po) ostore(chunk_of(NCH - 1), (NCH - 1) & 1);
    }
}
#endif

#if NAIVE_ATTN
__device__ __forceinline__ void attn_naive(KP p, int layer, int g, LAS unsigned char* lds) {
    unsigned char* reg = p.ws + OFF_REG; const int tid_ = tid_fresh(); const int lane = tid_ & 63, wid = tid_ >> 6;
    bf16_t* AQ = (bf16_t*)(reg + R_AQ); const bf16_t* AK = (const bf16_t*)(reg + R_AK); const bf16_t* AVT = (const bf16_t*)(reg + R_AVT);
    LAS float* qs = (LAS float*)lds + wid * 1024; LAS float* ps = qs + 128;
    for (int u = blockIdx.x; u < TG / 64; u += gridDim.x) {
#pragma unroll 1
        for (int pr = wid; pr < 512; pr += 8) {
            const int R = u * 64 + (pr >> 3), hq = pr & 7, hkv = hq >> 2; const int bl = R / TB, t = R - bl * TB;
            { const unsigned w = *(const unsigned*)(AQ + (size_t)R * 1024 + hq * 128 + 2 * lane); qs[2 * lane] = bflo(w); qs[2 * lane + 1] = bfhi(w); }
            const bool lat = t >= NCTX; const int i = t - NCTX;
            const int jlo = lat ? (i - 128 < 0 ? 0 : i - 128) : 0, jhi = lat ? (i + 128 > LSEQ - 1 ? LSEQ - 1 : i + 128) : -1;
            const float sink2 = p.in[12][layer * 8 + hq] * LOG2E;
            float mx = sink2;
#pragma unroll 1
            for (int rd = 0; rd < 9; ++rd) {
                int key; bool valid;
                if (rd < 4) { key = rd * 64 + lane; valid = true; } else { const int j = jlo + (rd - 4) * 64 + lane; key = NCTX + j; valid = j <= jhi; }
                float s = -3.0e38f;
                if (valid) { const bf16_t* kr = AK + (size_t)(bl * TB + key) * 256 + hkv * 128; s = 0.f;
#pragma unroll 4
                    for (int d8 = 0; d8 < 16; ++d8) { const u32x4 kv = *(const u32x4*)(kr + d8 * 8); const LAS float* q = qs + d8 * 8;
                        s += q[0] * bflo(kv.x) + q[1] * bfhi(kv.x) + q[2] * bflo(kv.y) + q[3] * bfhi(kv.y) + q[4] * bflo(kv.z) + q[5] * bfhi(kv.z) + q[6] * bflo(kv.w) + q[7] * bfhi(kv.w); } }
                ps[rd * 64 + lane] = s; mx = fmaxf(mx, s);
            }
            mx = wave_max(mx, lane);
            float sum = 0.f;
#pragma unroll 1
            for (int rd = 0; rd < 9; ++rd) { const float sv = ps[rd * 64 + lane]; const float pv = sv > -1.0e38f ? exp2f(sv - mx) : 0.f; ps[rd * 64 + lane] = pv; sum += pv; }
            sum = wave_sum(sum, lane) + exp2f(sink2 - mx);
            const float inv = 1.0f / sum;
            float o0 = 0.f, o1 = 0.f;
            const bf16_t* v0 = AVT + ((size_t)bl * 256 + hkv * 128 + 2 * lane) * TB; const bf16_t* v1 = v0 + TB;
#pragma unroll 4
            for (int k = 0; k < NCTX; ++k) { const float pv = ps[k]; o0 += pv * bf2f(v0[k]); o1 += pv * bf2f(v1[k]); }
#pragma unroll 4
            for (int j = jlo; j <= jhi; ++j) { const float pv = ps[256 + (j - jlo)]; o0 += pv * bf2f(v0[NCTX + j]); o1 += pv * bf2f(v1[NCTX + j]); }
            *(unsigned*)(AQ + (size_t)R * 1024 + hq * 128 + 2 * lane) = cvt_pk_bf16(o0 * inv, o1 * inv);
        }
    }
}
#endif


#if !NAIVE_ATTN
constexpr int AT_KS = 272, AT_VS = 144;
constexpr int AT_KB = 0, AT_VB = AT_KB + 2 * 64 * AT_KS, AT_END = AT_VB + 2 * 128 * AT_VS;
static_assert(AT_END <= 131072, "attn LDS");
__device__ __forceinline__ void attn_mfma(KP p, int layer, int g, LAS unsigned char* lds, bool to_spare) {
    unsigned char* reg = p.ws + OFF_REG; const int tid = tid_fresh(), wid = tid >> 6, lane = tid & 63, fr = lane & 15, fq = lane >> 4;
    bf16_t* AQ = (bf16_t*)(reg + R_AQ); const bf16_t* AK = (const bf16_t*)(reg + R_AK); const bf16_t* AVT = (const bf16_t*)(reg + R_AVT);
    const int nqb = layer == 1 ? NCH - 4 : NCH;
    const int nunits = BG * 2 * nqb;
    for (int it = 0;; ++it) {
        const int u = gridDim.x == 256 ? (it * 8 + (int)(blockIdx.x & 7)) * 32 + (int)(blockIdx.x >> 3) : it * (int)gridDim.x + (int)blockIdx.x;
        if (gridDim.x == 256 ? (it * 256 >= nunits) : (u >= nunits)) break;
        if (u >= nunits) continue;
        const int qblk = u < 1024 ? 4 + (u & 127) : (u & 3), hkv = u < 1024 ? (u >> 7) & 1 : (u >> 2) & 1, bl = u < 1024 ? u >> 8 : (u - 1024) >> 3;
        const int t0 = qblk * 64; const bool isctx = t0 < NCTX;
        const int hq = hkv * 4 + (wid >> 1); const int qoff = (wid & 1) * 32;
        const size_t qrow0 = (size_t)bl * TB + t0 + qoff;
        bf16x8 qf[2][4];
#pragma unroll
        for (int qb = 0; qb < 2; ++qb)
#pragma unroll
            for (int ks = 0; ks < 4; ++ks) qf[qb][ks] = *(const bf16x8*)(AQ + (qrow0 + 16 * qb + fr) * 1024 + hq * 128 + 32 * ks + 8 * fq);
        int mlo = 0, nloc = 0;
        if (!isctx) { mlo = (384 - t0) > 0 ? (384 - t0) / 64 : 0; int mhi = (TB + 64 - t0) / 64; mhi = mhi > 4 ? 4 : mhi; nloc = mhi - mlo + 1; }
        const int ntile = 4 + nloc;
        const float sink2 = p.in[12][layer * 8 + hq] * LOG2E;
        float mrun[2], lrun[2];
        mrun[0] = mrun[1] = sink2; lrun[0] = lrun[1] = (fq == 0) ? 1.0f : 0.0f;
        f32x4 oT[8][2];
#pragma unroll
        for (int db = 0; db < 8; ++db) { oT[db][0] = (f32x4){0.f, 0.f, 0.f, 0.f}; oT[db][1] = oT[db][0]; }
        const int krow = tid >> 4, kc = tid & 15;
        const int vrow = tid >> 3, vc = tid & 7;
        u32x4 rk[2], rv[2];
        auto tile_tok = [&](int ti) { return ti < 4 ? ti * 64 : t0 - 128 + 64 * (mlo + ti - 4); };
        auto gload = [&](int ti) {
            const int k0 = tile_tok(ti);
#pragma unroll
            for (int x = 0; x < 2; ++x) {
                rk[x] = *(const u32x4*)(AK + ((size_t)bl * TB + k0 + krow + 32 * x) * 256 + hkv * 128 + kc * 8);
                rv[x] = *(const u32x4*)(AVT + ((size_t)bl * 256 + hkv * 128 + vrow + 64 * x) * TB + k0 + vc * 8);
            }
        };
        auto lstore = [&](int buf) {
#pragma unroll
            for (int x = 0; x < 2; ++x) {
                *(LAS u32x4*)(lds + AT_KB + buf * 64 * AT_KS + (krow + 32 * x) * AT_KS + kc * 16) = rk[x];
                *(LAS u32x4*)(lds + AT_VB + buf * 128 * AT_VS + (vrow + 64 * x) * AT_VS + vc * 16) = rv[x];
            }
        };
        __syncthreads();
        gload(0); lstore(0);
        __syncthreads();
        for (int ti = 0; ti < ntile; ++ti) {
            const int cur = ti & 1;
            if (ti + 1 < ntile) gload(ti + 1);
            const LAS unsigned char* Kc = lds + AT_KB + cur * 64 * AT_KS; const LAS unsigned char* Vc = lds + AT_VB + cur * 128 * AT_VS;
            f32x4 sT[4][2];
#pragma unroll
            for (int kb = 0; kb < 4; ++kb) { sT[kb][0] = (f32x4){0.f, 0.f, 0.f, 0.f}; sT[kb][1] = sT[kb][0]; }
#pragma unroll
            for (int ks = 0; ks < 4; ++ks)
#pragma unroll
                for (int kb = 0; kb < 4; ++kb) { const bf16x8 a = *(const LAS bf16x8*)(Kc + (16 * kb + fr) * AT_KS + ks * 64 + fq * 16);
                    sT[kb][0] = __builtin_amdgcn_mfma_f32_16x16x32_bf16(a, qf[0][ks], sT[kb][0], 0, 0, 0);
                    sT[kb][1] = __builtin_amdgcn_mfma_f32_16x16x32_bf16(a, qf[1][ks], sT[kb][1], 0, 0, 0);
                    if (kb & 1) __builtin_amdgcn_sched_barrier(0); }
            if (ti >= 4) { const int m = mlo + ti - 4;
                if (m == 0 || m == 4) { const int k0 = tile_tok(ti);
#pragma unroll
                    for (int kb = 0; kb < 4; ++kb)
#pragma unroll
                        for (int qb = 0; qb < 2; ++qb)
#pragma unroll
                            for (int jj = 0; jj < 4; ++jj) { const int dt = (t0 + qoff + 16 * qb + fr) - (k0 + 16 * kb + 4 * fq + jj); if (dt > 128 || dt < -128) sT[kb][qb][jj] = -1.0e30f; } } }
            bf16x8 pb[2][2];
#pragma unroll
            for (int qb = 0; qb < 2; ++qb) {
                float tmax = -1.0e30f;
#pragma unroll
                for (int kb = 0; kb < 4; ++kb) tmax = fmaxf(tmax, fmaxf(fmaxf(sT[kb][qb][0], sT[kb][qb][1]), fmaxf(sT[kb][qb][2], sT[kb][qb][3])));
                tmax = fmaxf(tmax, sx(tmax, 16, lane)); tmax = fmaxf(tmax, sx(tmax, 32, lane));
                if (__any(tmax > mrun[qb] + 8.0f)) {
                    const float mnew_ = fmaxf(mrun[qb], tmax); const float alpha = __builtin_amdgcn_exp2f(mrun[qb] - mnew_); mrun[qb] = mnew_;
                    lrun[qb] = lrun[qb] * alpha;
#pragma unroll
                    for (int db = 0; db < 8; ++db) oT[db][qb] = oT[db][qb] * alpha;
                }
                const float mnew = mrun[qb];
                float psum = 0.f;
#pragma unroll
                for (int kb = 0; kb < 4; ++kb)
#pragma unroll
                    for (int jj = 0; jj < 4; ++jj) { const float pv = __builtin_amdgcn_exp2f(sT[kb][qb][jj] - mnew); psum += pv; sT[kb][qb][jj] = pv; }
                lrun[qb] = lrun[qb] + psum;
#pragma unroll
                for (int s2 = 0; s2 < 2; ++s2) { u32x4 w;
                    w.x = cvt_pk_bf16(sT[2 * s2][qb][0], sT[2 * s2][qb][1]); w.y = cvt_pk_bf16(sT[2 * s2][qb][2], sT[2 * s2][qb][3]);
                    w.z = cvt_pk_bf16(sT[2 * s2 + 1][qb][0], sT[2 * s2 + 1][qb][1]); w.w = cvt_pk_bf16(sT[2 * s2 + 1][qb][2], sT[2 * s2 + 1][qb][3]);
                    pb[qb][s2] = __builtin_bit_cast(bf16x8, w); }
            }
#pragma unroll
            for (int s2 = 0; s2 < 2; ++s2)
#pragma unroll
                for (int db = 0; db < 8; ++db) {
                    const u32x2 lo = *(const LAS u32x2*)(Vc + (16 * db + fr) * AT_VS + (32 * s2 + 4 * fq) * 2), hi = *(const LAS u32x2*)(Vc + (16 * db + fr) * AT_VS + (32 * s2 + 16 + 4 * fq) * 2);
                    const bf16x8 a = __builtin_bit_cast(bf16x8, (u32x4){lo.x, lo.y, hi.x, hi.y});
                    oT[db][0] = __builtin_amdgcn_mfma_f32_16x16x32_bf16(a, pb[0][s2], oT[db][0], 0, 0, 0);
                    oT[db][1] = __builtin_amdgcn_mfma_f32_16x16x32_bf16(a, pb[1][s2], oT[db][1], 0, 0, 0);
                    if (db & 1) __builtin_amdgcn_sched_barrier(0);
                }
            __syncthreads();
            if (ti + 1 < ntile) lstore(cur ^ 1);
            __syncthreads();
        }
#pragma unroll
        for (int qb = 0; qb < 2; ++qb) {
            float l = lrun[qb]; l += sx(l, 16, lane); l += sx(l, 32, lane);
            const float inv = 1.0f / l;
            bf16_t* orow = (to_spare ? (bf16_t*)(p.ws + WS_NEED) : AQ) + (qrow0 + 16 * qb + fr) * 1024 + hq * 128 + 4 * fq;
#pragma unroll
            for (int db = 0; db < 8; ++db) { const f32x4 v = oT[db][qb] * inv; u32x2 w; w.x = cvt_pk_bf16(v[0], v[1]); w.y = cvt_pk_bf16(v[2], v[3]); *(u32x2*)(orow + 16 * db) = w; }
        }
    }
}
#endif

__global__ void __launch_bounds__(512, 2) mega(Params pv) {
    extern __shared__ __attribute__((aligned(16))) unsigned char smem_raw[];
    LAS unsigned char* lds = (LAS unsigned char*)smem_raw;
    LAS unsigned* xbw = (LAS unsigned*)(lds + 131072);
    LAS int* tab = (LAS int*)(lds + 131072 + 256);
#if LDS_POISON
    for (int e = threadIdx.x; e < LDS_BYTES / 4; e += 512) ((LAS unsigned*)lds)[e] = 0x447A447Au;
    __syncthreads();
#endif
    if (threadIdx.x == 0) { xbw[0] = 0u; xbw[1] = 0u; xbw[2] = 0u; xbw[3] = 0u; }
    __syncthreads();
    KPS* kp = (KPS*)__builtin_amdgcn_kernarg_segment_ptr();
    const int ph0 = pv.ph0, ph1 = pv.ph1;
    XcdBarrier bar = xcd_barrier_post((unsigned*)(pv.ws + OFF_BAR), (volatile LAS unsigned*)xbw);
    int ph = 0;
#define PH_RUN(tag, ...) do { if (ph >= ph0 && ph < ph1 && PSEL_OK(tag)) { for (int rep_ = 0; rep_ < (((REP_MASK >> (tag)) & 1) ? REP_N : 1); ++rep_) { KPS* q_ = kp; asm volatile("" : "+s"(q_)); KP p = *q_; __VA_ARGS__ } } \
        if (ph >= ph0 && ph + 1 < ph1) xcd_barrier(bar); ++ph; } while (0)
    PH_RUN(0, prologue1(p, lds););
    PH_RUN(1, prologue2(p););
    for (int layer = 0; layer < 2; ++layer) {
        PH_RUN(2, const bool dry_ = rep_ + 1 < (((REP_MASK >> 2) & 1) ? REP_N : 1); if (layer == 0) norm_phase2<0>(p, 0, dry_); else norm_phase2<1>(p, 1, dry_););
        for (int g = 0; g < NGRP; ++g) {
            PH_RUN(3,
                unsigned char* ws = p.ws; const bf16_t* Hg = (const bf16_t*)(ws + OFF_H) + (size_t)g * TG * 1024; const bf16_t* WIN = (const bf16_t*)(ws + OFF_WINT) + (size_t)layer * WIN_ROWS * 1024;
                SchedDense S{}; S.A = Hg; S.B = WIN; S.lda = 1024; S.K = 1024; S.nM = TG / 256; S.nN = 23; S.nNb = 23; S.qkvswap = true;
                EpiQKV E{ws + OFF_REG, g, (const f32x2*)(ws + OFF_ATAB), (const f32x2*)(ws + OFF_RTAB), rep_ + 1 < (((REP_MASK >> 3) & 1) ? REP_N : 1)};
                g8::gemm_call(lds, S, E););
            PH_RUN(4, gate_phase(p, layer, g, lds););
                        PH_RUN(5, scan_mfma(p, layer, g, lds, false); __syncthreads(); attn_mfma(p, layer, g, lds, false););
            PH_RUN(7, stats_phase(p, g, false););
            PH_RUN(8,
                unsigned char* ws = p.ws; const bf16_t* Hg = (const bf16_t*)(ws + OFF_H) + (size_t)g * TG * 1024; const bf16_t* WIN = (const bf16_t*)(ws + OFF_WINT) + (size_t)layer * WIN_ROWS * 1024;
                SchedDense S{}; S.A = Hg; S.B = WIN + (size_t)5888 * 1024; S.lda = 1024; S.K = 1024; S.nM = layer == 1 ? 128 : TG / 256; S.nN = 8; S.nNb = 8; S.skipctx = layer == 1;
                EpiGateR E{ws + OFF_REG, (const f32x2*)(ws + OFF_STATS), p.in[11] + layer * 1024, p.in[13] + layer * 1024, rep_ + 1 < (((REP_MASK >> 8) & 1) ? REP_N : 1)};
                g8::gemm_call(lds, S, E););
            PH_RUN(9,
                unsigned char* ws = p.ws; unsigned char* reg = ws + OFF_REG;
                const bf16_t* Yb = (const bf16_t*)(reg + R_OGF); const bf16_t* WBb = (const bf16_t*)(ws + OFF_WBRT) + (size_t)layer * 3 * 1024 * 1024; const bf16_t* Hb = (const bf16_t*)(ws + OFF_H) + (size_t)g * TG * 1024;
                const bf16_t* WGb = (const bf16_t*)(ws + OFF_WINT) + (size_t)layer * WIN_ROWS * 1024 + (size_t)7936 * 1024; bf16_t* Zb = (bf16_t*)(reg + (g == 0 ? R_ZG0 : R_GQK));
                { SchedZGc S{Yb, WBb, Hb, WGb, 128, true}; EpiZGc E{Zb}; g8::gemm_call(lds, S, E); }
                if (layer == 0) { SchedZG S{Yb, WBb, Hb, WGb, BG, false, true}; EpiZG E{Zb, false}; g8::gemm_call(lds, S, E); });
        }
        PH_RUN(11,
            unsigned char* ws = p.ws;
            EpiOut E{layer == 0 ? p.in[0] : p.out, layer == 0 ? p.in[2] : (const float*)(ws + OFF_CTXS), p.out, (float*)(ws + OFF_CTXS), (const float*)(ws + OFF_MOD) + (size_t)layer * 9 * 6144, 0, false};
            for (int d_ = 0; d_ < (int)(blockIdx.x & 7); ++d_) __builtin_amdgcn_s_sleep(64);
            if (layer == 0) { SchedOut2 S{(const bf16_t*)(ws + OFF_REG + R_ZG0), (const bf16_t*)(ws + OFF_REG + R_GQK), (const bf16_t*)(ws + OFF_WO3T), false, 3072, true, false}; g8::gemm_call(lds, S, E); }
            { SchedOut2 S{(const bf16_t*)(ws + OFF_REG + R_ZG0), (const bf16_t*)(ws + OFF_REG + R_GQK), (const bf16_t*)(ws + OFF_WO1T) + (size_t)layer * 1024 * 1024, true, 1024, false, layer == 0}; g8::gemm_call(lds, S, E); });
        PH_RUN(13, moe_convert(p, layer, lds); __syncthreads(); norm2_router(p, layer, lds, false););
        PH_RUN(14, dispatch_phase(p, layer, tab););
        PH_RUN(15,
            unsigned char* ws = p.ws;
            moe_table(p, layer, tab);
            LAS int* tok = (LAS int*)(lds + 131072 + 1024);
            moe_tok_table(p, tab, tok);
            SchedMoeG S{(const bf16_t*)(ws + OFF_H), (const bf16_t*)(ws + OFF_REG + M_W13T), tab, tok};
            EpiMoe1 E{(bf16_t*)(ws + OFF_REG + M_HMID)};
            g8::gemm_call(lds, S, E););
        PH_RUN(16,
            unsigned char* ws = p.ws;
            moe_table(p, layer, tab);
            SchedMoe S{(const bf16_t*)(ws + OFF_REG + M_HMID), (const bf16_t*)(ws + OFF_REG + M_W2T), 1024, 1024, 4, 1024, tab};
            EpiMoe2 E{(bf16_t*)(ws + OFF_REG + M_XG), (const float*)(ws + OFF_SLOTW)};
            g8::gemm_call(lds, S, E););
    }
    PH_RUN(17, norm_phase2<3>(p, 1, rep_ + 1 < (((REP_MASK >> 17) & 1) ? REP_N : 1)););
#if BAR_PROBE
    if (ph1 - ph0 > 1) for (int i_ = 0; i_ < 100; ++i_) xcd_barrier(bar);
#endif
}
constexpr int N_PHASES = 2 + 2 * (1 + NGRP * 6 + 1 + 4) + 1;

extern "C" void kernel_launch(void* const* d_in, const int* in_sizes, int n_in, void* d_out, int out_size, void* d_ws, size_t ws_size, hipStream_t stream) {
    static int grid = 0;
    if (!grid) {
        int dev = 0, cus = 0, per_cu = 0;
        hipGetDevice(&dev);
        hipDeviceGetAttribute(&cus, hipDeviceAttributeMultiprocessorCount, dev);
        hipFuncSetAttribute((const void*)mega, hipFuncAttributeMaxDynamicSharedMemorySize, LDS_BYTES);
        hipOccupancyMaxActiveBlocksPerMultiprocessor(&per_cu, mega, 512, LDS_BYTES);
        grid = per_cu >= 1 ? cus : 0;
    }
    if (!grid || ws_size < WS_NEED || n_in < 26) { fprintf(stderr, "kernel_launch: cannot run (grid %d, ws %zu need %zu)\n", grid, ws_size, (size_t)WS_NEED); return; }
    hipMemsetAsync(d_ws, 0, ZERO_BYTES, stream);
    Params p{};
    for (int i = 0; i < 26; ++i) p.in[i] = (const float*)d_in[i];
    p.out = (float*)d_out; p.ws = (unsigned char*)d_ws;
#if MK_MULTI
    for (int ph = 0; ph < N_PHASES; ++ph) { p.ph0 = ph; p.ph1 = ph + 1; hipLaunchKernelGGL(mega, dim3(grid), dim3(512), LDS_BYTES, stream, p); }
#else
    p.ph0 = 0; p.ph1 = N_PHASES;
    hipLaunchKernelGGL(mega, dim3(grid), dim3(512), LDS_BYTES, stream, p);
#endif
}
```

```cpp
#include <hip/hip_runtime.h>
#include <stdint.h>
#include <stdio.h>

#ifndef MK_MULTI
#define MK_MULTI 0
#endif
#ifndef NAIVE_SCAN
#define NAIVE_SCAN 1
#endif
#ifndef SCAN_MASK
#define SCAN_MASK 15
#endif
#ifndef SCAN_E1
#define SCAN_E1 0
#endif
#ifndef E2_SEL
#define E2_SEL (layer == 1 && g == 0 && mix == 1 && ch == 126 && (u & 7) == 2)
#endif
#ifndef LDS_POISON
#define LDS_POISON 0
#endif
#ifndef SCAN_DELAY
#define SCAN_DELAY 0
#endif
#ifndef E2_KEY
#define E2_KEY (fminf(60000.0f, 100.0f * fmaxf(fmaxf(fabsf(c[0] - r0_), fabsf(c[1] - r1_)), fmaxf(fabsf(c[2] - r2_), fabsf(c[3] - r3_)))))
#endif
#ifndef REP_MASK
#define REP_MASK 0u
#define REP_N 3
#endif
#ifndef BAR_PROBE
#define BAR_PROBE 0
#endif
#ifndef NAIVE_ATTN
#define NAIVE_ATTN 0
#endif

#define LAS __attribute__((address_space(3)))
#ifndef PSEL
#define PSEL -1
#endif
#ifndef PMASK
#define PMASK 0xFFFFFFFFu
#endif
#define PSEL_OK(t) ((PSEL < 0 || PSEL == (t)) && ((PMASK >> (t)) & 1u))
typedef unsigned short bf16_t;
typedef short bf16x8 __attribute__((ext_vector_type(8)));
typedef float f32x4 __attribute__((ext_vector_type(4)));
typedef float f32x2 __attribute__((ext_vector_type(2)));
typedef unsigned u32x4 __attribute__((ext_vector_type(4)));
typedef unsigned u32x2 __attribute__((ext_vector_type(2)));

constexpr int D = 1024, NBATCH = 8, LSEQ = 8192, NCTX = 256, TB = 8448, TALL = 67584;
constexpr int NGRP = 2, BG = 4, TG = 33792;
constexpr int NIN = 10784, NE = 32;
constexpr int NSLOT = 2 * TALL;
constexpr int WIN_ROWS = 11008;
constexpr int CH = 64, NCH = TB / CH;
constexpr float LOG2E = 1.4426950408889634f;

constexpr size_t al(size_t x) { return (x + 4095) & ~(size_t)4095; }
constexpr size_t OFF_BAR   = 0;
constexpr size_t OFF_CNT   = 16384;
constexpr size_t ZERO_BYTES = 32768;
constexpr size_t OFF_MOD   = ZERO_BYTES;
constexpr size_t OFF_MODP  = OFF_MOD   + al((size_t)2 * 9 * 6144 * 4);
constexpr size_t OFF_ATAB  = OFF_MODP  + al((size_t)16 * 2 * 9 * 6144 * 4);
constexpr size_t OFF_RTAB  = OFF_ATAB  + al((size_t)128 * 32 * 8);
constexpr size_t OFF_WR    = OFF_RTAB  + al((size_t)TB * 64 * 8);
constexpr size_t OFF_CTXS  = OFF_WR    + al((size_t)2 * 2 * 48 * 1024 * 2);
constexpr size_t OFF_WINT  = OFF_CTXS  + al((size_t)8 * 256 * 1024 * 4);
constexpr size_t OFF_WBRT  = OFF_WINT  + al((size_t)2 * WIN_ROWS * 1024 * 2);
constexpr size_t OFF_WO3T  = OFF_WBRT  + al((size_t)2 * 3 * 1024 * 1024 * 2);
constexpr size_t OFF_WO1T  = OFF_WO3T  + al((size_t)2 * 1024 * 3072 * 2);
constexpr size_t OFF_EXPID = OFF_WO1T  + al((size_t)2 * 1024 * 1024 * 2);
constexpr size_t OFF_GATEW = OFF_EXPID + al((size_t)TALL * 2 * 4);
constexpr size_t OFF_RANK  = OFF_GATEW + al((size_t)TALL * 2 * 4);
constexpr size_t OFF_TOKSL = OFF_RANK  + al((size_t)TALL * 2 * 4);
constexpr size_t OFF_SLOTW = OFF_TOKSL + al((size_t)TALL * 2 * 4);
constexpr size_t OFF_SLOTTOK = OFF_SLOTW + al((size_t)(NSLOT + 256) * 4);
constexpr size_t OFF_STATS = OFF_SLOTTOK + al((size_t)(NSLOT + 256) * 4);
constexpr size_t OFF_H     = OFF_STATS + al((size_t)2 * TG * 4 * 8);
constexpr size_t OFF_REG   = OFF_H     + al((size_t)TALL * 1024 * 2);
constexpr size_t SZ_T1K = (size_t)TG * 1024 * 2;
constexpr size_t R_GQK  = 0;
constexpr size_t R_GIN  = R_GQK + SZ_T1K;
constexpr size_t R_GDEC = R_GIN + 2 * SZ_T1K;
constexpr size_t R_GVT  = R_GDEC + al((size_t)2 * BG * NCH * 512 * 4);
constexpr size_t R_GLR  = R_GVT + SZ_T1K;
constexpr size_t R_AK   = R_GLR + al((size_t)TG * 32 * 4);
constexpr size_t R_AVT  = R_AK + SZ_T1K / 4;
constexpr size_t R_RQK  = R_AVT + SZ_T1K / 4;
constexpr size_t R_RVT  = R_RQK + SZ_T1K;
constexpr size_t R_OGF  = R_RVT + SZ_T1K;
constexpr size_t R_AQ   = R_OGF + SZ_T1K;
constexpr size_t R_ORF  = R_AQ + SZ_T1K;
constexpr size_t R_OGB  = R_ORF + SZ_T1K;
constexpr size_t R_ORB  = R_OGB + SZ_T1K;
constexpr size_t R_ZG0  = R_ORB + SZ_T1K;
constexpr size_t R_MIX_END = R_ZG0 + 3 * SZ_T1K;
constexpr size_t M_W13T = 0;
constexpr size_t M_W2T  = M_W13T + (size_t)32 * 2048 * 1024 * 2;
constexpr size_t M_XG   = M_W2T + (size_t)32 * 1024 * 1024 * 2;
constexpr size_t M_HMID = M_XG + al((size_t)(NSLOT + 256) * 1024 * 2);
constexpr size_t M_END  = M_HMID + al((size_t)(NSLOT + 256) * 1024 * 2);
constexpr size_t REG_BYTES = R_MIX_END > M_END ? R_MIX_END : M_END;
constexpr size_t WS_NEED = OFF_REG + REG_BYTES;

constexpr int LDS_BYTES = 155648;

struct Params {
    const float* in[26];
    float* out;
    unsigned char* ws;
    int ph0, ph1;
};
typedef const __attribute__((address_space(4))) Params KPS;
typedef KPS& KP;

__device__ __forceinline__ bf16_t f2bf(float f) { unsigned u = __float_as_uint(f); u += 0x7FFFu + ((u >> 16) & 1u); return (bf16_t)(u >> 16); }
__device__ __forceinline__ float bf2f(unsigned b) { return __uint_as_float(b << 16); }
__device__ __forceinline__ float bflo(unsigned w) { return __uint_as_float(w << 16); }
__device__ __forceinline__ float bfhi(unsigned w) { return __uint_as_float(w & 0xFFFF0000u); }
typedef __bf16 bf16x2_t __attribute__((ext_vector_type(2)));
__device__ __forceinline__ unsigned cvt_pk_bf16(float lo, float hi) { const f32x2 v = (f32x2){lo, hi}; const bf16x2_t b = __builtin_convertvector(v, bf16x2_t); return __builtin_bit_cast(unsigned, b); }
__device__ __forceinline__ float sx(float v, int m, int lane) { return __int_as_float(__builtin_amdgcn_ds_bpermute((lane ^ m) << 2, __float_as_int(v))); }
__device__ __forceinline__ float wave_sum(float v, int lane) {
#pragma unroll
    for (int o = 32; o; o >>= 1) v += sx(v, o, lane);
    return v;
}
__device__ __forceinline__ float wave_max(float v, int lane) {
#pragma unroll
    for (int o = 32; o; o >>= 1) v = fmaxf(v, sx(v, o, lane));
    return v;
}
__device__ __forceinline__ int tid_fresh() { int t = threadIdx.x; asm volatile("" : "+v"(t)); return t; }
__device__ __forceinline__ int bid_fresh() { int t = blockIdx.x; asm volatile("" : "+s"(t)); return t; }
__device__ __forceinline__ float sigmoid_f(float x) { return __builtin_amdgcn_rcpf(1.0f + __builtin_amdgcn_exp2f(x * -LOG2E)); }
__device__ __forceinline__ float silu_f(float x) { return x * sigmoid_f(x); }

#define XB_TMO      128
#define XB_XCNT(j)  (256  + 64 * (j))
#define XB_XSUB(j)  (1280 + 64 * (j))
#define XB_XGEN(j)  (2304 + 64 * (j))
#define XB_TOP      3328
#define XB_TOPGEN   3392
#define XCD_BAR_WORDS 3456
#define XB_SPIN_CAP (1u << 18)

__device__ __forceinline__ unsigned xb_ld(unsigned* p)              { return __hip_atomic_load(p, __ATOMIC_RELAXED, __HIP_MEMORY_SCOPE_AGENT); }
__device__ __forceinline__ unsigned xb_add(unsigned* p, unsigned v) { return __hip_atomic_fetch_add(p, v, __ATOMIC_RELAXED, __HIP_MEMORY_SCOPE_AGENT); }
__device__ __forceinline__ unsigned xb_xcc_id() { return (unsigned)__builtin_amdgcn_s_getreg((3 << 11) | 20) & 0xFu; }
#define XB_SPIN(cond, bar) do { unsigned _sp = 0; while (cond) { __builtin_amdgcn_s_sleep(1); \
    if ((++_sp & 255u) == 0u) { if (xb_ld(&(bar)[XB_TMO])) break; if (_sp > XB_SPIN_CAP) { atomicAdd(&(bar)[XB_TMO], 1u); break; } } } } while (0)

struct XcdBarrier { unsigned* bar; unsigned x; volatile LAS unsigned* st; };

__device__ __forceinline__ XcdBarrier xcd_barrier_post(unsigned* bar, volatile LAS unsigned* st) {
    XcdBarrier b; b.bar = bar; b.x = xb_xcc_id(); b.st = st;
    if (threadIdx.x == 0) (void)xb_add(&bar[XB_XCNT(b.x)], 1u);
    return b;
}
__device__ __forceinline__ void xcd_barrier_complete(unsigned* bar, unsigned x, unsigned& nloc, unsigned& nx) {
    const unsigned G = gridDim.x * gridDim.y * gridDim.z;
    unsigned sum, cnt, mine, sp = 0u;
    for (;;) {
        sum = 0u; cnt = 0u; mine = 0u;
#pragma unroll
        for (unsigned j = 0; j < 16; ++j) { const unsigned c = xb_ld(&bar[XB_XCNT(j)]); sum += c; cnt += (c > 0u) ? 1u : 0u; mine = (j == x) ? c : mine; }
        if (sum == G) break;
        __builtin_amdgcn_s_sleep(1);
        if ((++sp & 255u) == 0u) { if (xb_ld(&bar[XB_TMO])) break; if (sp > XB_SPIN_CAP) { atomicAdd(&bar[XB_TMO], 1u); break; } }
    }
    nloc = mine > 0u ? mine : 1u; nx = cnt > 0u ? cnt : 1u;
}
__device__ __forceinline__ void xcd_barrier(const XcdBarrier& b) {
    asm volatile("s_waitcnt vmcnt(0)" ::: "memory");
    __syncthreads();
    if (threadIdx.x == 0) {
        unsigned* bar = b.bar;
        __builtin_amdgcn_s_waitcnt(0);
        unsigned nloc = b.st[0], nx = b.st[1];
        if (nloc == 0u) { xcd_barrier_complete(bar, b.x, nloc, nx); b.st[0] = nloc; b.st[1] = nx; }
        const unsigned old = xb_add(&bar[XB_XSUB(b.x)], 1u);
        const unsigned gen = old / nloc;
        if (old + 1u == (gen + 1u) * nloc) {
            __builtin_amdgcn_fence(__ATOMIC_RELEASE, "agent");
            asm volatile("s_waitcnt vmcnt(0)" ::: "memory");
            const unsigned og = xb_add(&bar[XB_TOP], 1u);
            const unsigned tg = og / nx;
            if (og + 1u == (tg + 1u) * nx) xb_add(&bar[XB_TOPGEN], 1u);
            else XB_SPIN(xb_ld(&bar[XB_TOPGEN]) == tg, bar);
            __builtin_amdgcn_fence(__ATOMIC_ACQUIRE, "agent");
            xb_add(&bar[XB_XGEN(b.x)], 1u);
            asm volatile("s_waitcnt vmcnt(0)" ::: "memory");
        } else {
            XB_SPIN(xb_ld(&bar[XB_XGEN(b.x)]) == gen, bar);
            __builtin_amdgcn_fence(__ATOMIC_ACQUIRE, "agent");
            asm volatile("s_waitcnt vmcnt(0)" ::: "memory");
        }
    }
    __syncthreads();
}

__device__ __forceinline__ size_t lat_off(int b, int t) { return ((size_t)b * LSEQ + (t - NCTX)) * D; }
__device__ __forceinline__ size_t ctx_off(int b, int t) { return ((size_t)b * NCTX + t) * D; }

namespace g8 {
constexpr int BM = 256, BK = 64, HALF = 128, HTB = HALF * BK * 2, STAGE_BYTES = 8 * HTB, NXCD = 8, WGM = 8;
__device__ __forceinline__ int lds_byte(int r, int c) { const int st = (r >> 4) * 2 + (c >> 5), rr = r & 15, cc = c & 31, ob = rr * 64 + cc * 2; return st * 1024 + (ob ^ (((ob >> 9) & 1) << 5)); }
__device__ __forceinline__ void stage_rc(int b, int& R, int& C) { const int st = b / 1024, sb = b % 1024, swz = sb ^ (((sb >> 9) & 1) << 5); R = (st >> 1) * 16 + swz / 64; C = (st & 1) * 32 + (swz % 64) / 2; }
__device__ __forceinline__ int perm32(int rho) { const int n = rho >> 4, i = rho & 15; return 8 * (i >> 2) + 4 * n + (i & 3); }

struct GUnit { const char* a; const char* b; int pm, pn, x0, x1, xi; };

__device__ __forceinline__ bool static_tile(int i, int G, int c, int nM, int nN, int& pm, int& pn) {
    const int nwg = nM * nN; const long L = (long)i * G + c; if (L >= nwg) return false;
    int wgid = (int)L; { const int q = nwg / NXCD, r = nwg % NXCD, xcd = wgid % NXCD, off = wgid / NXCD; wgid = (xcd < r ? xcd * (q + 1) : r * (q + 1) + (xcd - r) * q) + off; }
    const int nig = WGM * nN, gid = wgid / nig, fm = gid * WGM, gsz = (nM - fm) < WGM ? (nM - fm) : WGM;
    pm = fm + ((wgid % nig) % gsz); pn = (wgid % nig) / gsz; return true;
}

template <class Epi, class Sched>
__device__ __forceinline__ void gemm_phase(LAS unsigned char* lds, const Sched& S, const Epi& E) {
    const int tid = tid_fresh(), wid = __builtin_amdgcn_readfirstlane(tid >> 6), lane = tid & 63, wr = wid >> 2, wc = wid & 3, fr = lane & 15, fq = lane >> 4;
    const int K = S.K, nt = K / BK;
    const int lda = S.lda;
    unsigned voffA[2], voffB[2]; int Rr[2], Cc[2];
#pragma unroll
    for (int i = 0; i < 2; ++i) { int R, C; stage_rc(tid * 16 + i * 8192, R, C); const int Rb = Epi::PERM ? ((R & ~31) + perm32(R & 31)) : R; Rr[i] = R; Cc[i] = C;
        voffA[i] = (unsigned)(R * lda + C) * 2u; voffB[i] = (unsigned)(Rb * K + C) * 2u; }
    unsigned vAc[2][2], vAn[2][2];
    const size_t kstep = (size_t)(BK * 2);
    const size_t hstepA = (size_t)HALF * lda * 2, hstepB = (size_t)HALF * K * 2;
    const unsigned ldsw = (unsigned)wid * 1024u;
    const int aoff = lds_byte(wr * 64 + fr, fq * 8), boff = lds_byte(wc * 32 + fr, fq * 8);
#define G8_SA(b, h) (((b) * 2 + (h)) * HTB)
#define G8_SB(b, h) ((4 + (b) * 2 + (h)) * HTB)
#define G8_STAGE(bufoff, gbase, voff) do { _Pragma("unroll") for (int _i = 0; _i < 2; ++_i) \
        __builtin_amdgcn_global_load_lds((const unsigned*)((const char*)(gbase) + (voff)[_i]), (LAS unsigned*)(lds + (bufoff) + ldsw + _i * 8192), 16, 0, 0); } while (0)
#define G8_STAGE_A(bufoff, basep, h, usenext) do { if constexpr (Sched::GATHER) { unsigned _v[2]; _v[0] = (usenext) ? vAn[h][0] : vAc[h][0]; _v[1] = (usenext) ? vAn[h][1] : vAc[h][1]; G8_STAGE(bufoff, basep, _v); } \
        else { G8_STAGE(bufoff, (basep) + (h) * hstepA, voffA); } } while (0)
#define G8_LDA(dst, b, h) do { _Pragma("unroll") for (int m = 0; m < 4; ++m) _Pragma("unroll") for (int k = 0; k < 2; ++k) dst[m][k] = *(const LAS bf16x8*)(lds + G8_SA(b, h) + aoff + m * 2048 + k * 1024); } while (0)
#define G8_LDB(dst, b, h) do { _Pragma("unroll") for (int n = 0; n < 2; ++n) _Pragma("unroll") for (int k = 0; k < 2; ++k) dst[n][k] = *(const LAS bf16x8*)(lds + G8_SB(b, h) + boff + n * 2048 + k * 1024); } while (0)
#define G8_MMA(ai, bj, At, Bt) do { __builtin_amdgcn_s_setprio(1); _Pragma("unroll") for (int m = 0; m < 4; ++m) _Pragma("unroll") for (int n = 0; n < 2; ++n) _Pragma("unroll") for (int k = 0; k < 2; ++k) \
        acc[ai][bj][m][n] = __builtin_amdgcn_mfma_f32_16x16x32_bf16(Bt[n][k], At[m][k], acc[ai][bj][m][n], 0, 0, 0); __builtin_amdgcn_s_setprio(0); } while (0)
#define G8_WAIT_V(n) asm volatile("s_waitcnt vmcnt(" #n ")" ::: "memory")
#define G8_WAIT_L(n) asm volatile("s_waitcnt lgkmcnt(" #n ")" ::: "memory")
#define G8_BAR __builtin_amdgcn_s_barrier()
#define G8_SCHED __builtin_amdgcn_sched_barrier(0)
    GUnit cur, nxt; int ui = 0;
    if (!S.next(0, cur)) return;
    f32x4 acc[2][2][4][2];
#pragma unroll
    for (int a = 0; a < 2; ++a)
#pragma unroll
        for (int b = 0; b < 2; ++b)
#pragma unroll
            for (int m = 0; m < 4; ++m)
#pragma unroll
                for (int n = 0; n < 2; ++n) acc[a][b][m][n] = (f32x4){0.f, 0.f, 0.f, 0.f};
    bf16x8 At[4][2], B0[2][2], B1[2][2];
    const char* cA = cur.a; const char* cB = cur.b;
    if constexpr (Sched::GATHER) { S.aoff(cur, Rr, Cc, vAc); asm volatile("s_waitcnt lgkmcnt(0)" ::: "memory"); }
    G8_STAGE(G8_SB(0, 0), cB, voffB); G8_STAGE_A(G8_SA(0, 0), cA, 0, false); G8_STAGE(G8_SB(0, 1), cB + hstepB, voffB); G8_STAGE_A(G8_SA(0, 1), cA, 1, false);
    if (wr == 1) G8_BAR;
    G8_WAIT_V(4); G8_BAR;
    G8_STAGE(G8_SB(1, 0), cB + kstep, voffB); G8_STAGE_A(G8_SA(1, 0), cA + kstep, 0, false); G8_STAGE(G8_SB(1, 1), cB + hstepB + kstep, voffB);
    G8_WAIT_V(6); G8_BAR;
    for (;;) {
        const bool has_next = S.next(ui + 1, nxt);
        const char* nA = has_next ? nxt.a : cA; const char* nB = has_next ? nxt.b : cB;
        if constexpr (Sched::GATHER) {
            if (has_next) S.aoff(nxt, Rr, Cc, vAn); else { vAn[0][0] = vAc[0][0]; vAn[0][1] = vAc[0][1]; vAn[1][0] = vAc[1][0]; vAn[1][1] = vAc[1][1]; }
            asm volatile("s_waitcnt lgkmcnt(0)" : "+v"(vAn[0][0]), "+v"(vAn[0][1]), "+v"(vAn[1][0]), "+v"(vAn[1][1]) :: "memory");
        }
        for (int t = 0; t < nt; t += 2) {
            const bool last = (t == nt - 2);
            const char* a1 = cA + (size_t)(t + 1) * kstep;
            const char* a2 = last ? nA : cA + (size_t)(t + 2) * kstep; const char* b2 = last ? nB : cB + (size_t)(t + 2) * kstep;
            const char* a3 = a2 + kstep; const char* b3 = b2 + kstep;
            G8_LDB(B0, 0, 0); G8_SCHED; G8_LDA(At, 0, 0); G8_STAGE_A(G8_SA(1, 1), a1, 1, false);
            G8_WAIT_L(8); G8_BAR; G8_WAIT_L(0); G8_MMA(0, 0, At, B0); G8_BAR; G8_SCHED;
            G8_LDB(B1, 0, 1); G8_STAGE(G8_SB(0, 0), b2, voffB);
            G8_BAR; G8_WAIT_L(0); G8_MMA(0, 1, At, B1); G8_BAR;
            G8_LDA(At, 0, 1); G8_STAGE_A(G8_SA(0, 0), a2, 0, last);
            G8_BAR; G8_WAIT_L(0); G8_MMA(1, 0, At, B0); G8_BAR; G8_SCHED;
            G8_STAGE(G8_SB(0, 1), b2 + hstepB, voffB);
            G8_WAIT_V(6); G8_BAR; G8_MMA(1, 1, At, B1); G8_BAR;
            G8_LDB(B0, 1, 0); G8_SCHED; G8_LDA(At, 1, 0); G8_STAGE_A(G8_SA(0, 1), a2, 1, last);
            G8_WAIT_L(8); G8_BAR; G8_WAIT_L(0); G8_MMA(0, 0, At, B0); G8_BAR; G8_SCHED;
            G8_LDB(B1, 1, 1); G8_STAGE(G8_SB(1, 0), b3, voffB);
            G8_BAR; G8_WAIT_L(0); G8_MMA(0, 1, At, B1); G8_BAR;
            G8_LDA(At, 1, 1); G8_STAGE_A(G8_SA(1, 0), a3, 0, last);
            G8_BAR; G8_WAIT_L(0); G8_MMA(1, 0, At, B0); G8_BAR; G8_SCHED;
            G8_STAGE(G8_SB(1, 1), b3 + hstepB, voffB);
            G8_WAIT_V(6); G8_BAR; G8_MMA(1, 1, At, B1); G8_BAR;
        }
        E(acc, cur, wr, wc, fr, fq);
        if (!has_next) break;
#pragma unroll
        for (int a = 0; a < 2; ++a)
#pragma unroll
            for (int b = 0; b < 2; ++b)
#pragma unroll
                for (int m = 0; m < 4; ++m)
#pragma unroll
                    for (int n = 0; n < 2; ++n) acc[a][b][m][n] = (f32x4){0.f, 0.f, 0.f, 0.f};
        cur = nxt; cA = nA; cB = nB; ++ui;
        if constexpr (Sched::GATHER) { vAc[0][0] = vAn[0][0]; vAc[0][1] = vAn[0][1]; vAc[1][0] = vAn[1][0]; vAc[1][1] = vAn[1][1]; }
    }
    G8_WAIT_V(0);
    if (wr == 0) G8_BAR;
    G8_BAR;
#undef G8_SA
#undef G8_SB
#undef G8_STAGE
#undef G8_STAGE_A
#undef G8_LDA
#undef G8_LDB
#undef G8_MMA
#undef G8_WAIT_V
#undef G8_WAIT_L
#undef G8_BAR
#undef G8_SCHED
}
template <class Epi, class Sched>
__device__ __forceinline__ void gemm_call(LAS unsigned char* lds, Sched S, Epi E) { gemm_phase(lds, S, E); }
}
using g8::GUnit;

__device__ __forceinline__ int skipctx_pm(int pmc) { return (pmc >> 5) * 33 + 1 + (pmc & 31); }
struct SchedDense {       static constexpr bool GATHER = false;
    const bf16_t* A; const bf16_t* B; size_t strideA, strideB; int lda, K, nM, nN, nNb; bool skipctx; bool qkvswap;
    __device__ __forceinline__ bool next(int i, GUnit& u) const {
        int pm, pn; if (!g8::static_tile(i, gridDim.x, blockIdx.x, nM, nN, pm, pn)) return false;
        if (skipctx) pm = skipctx_pm(pm);
        const int br = pn / nNb, pl = pn - br * nNb;
        u.pm = pm; u.pn = pn; u.x0 = br; u.x1 = pl;
        u.a = (const char*)(A + (size_t)br * strideA + (size_t)pm * 256 * lda);
        u.b = (const char*)(B + (size_t)br * strideB + (size_t)pl * 256 * K);
        { const bool vt_ = qkvswap && ((0x3C20F0u >> pn) & 1u); const unsigned long long x_ = ((unsigned long long)u.a ^ (unsigned long long)u.b) & (vt_ ? ~0ull : 0ull); u.a = (const char*)((unsigned long long)u.a ^ x_); u.b = (const char*)((unsigned long long)u.b ^ x_); }
        return true;
    }
};
struct SchedZG {
    static constexpr bool GATHER = false;
    const bf16_t* Y; const bf16_t* WB; const bf16_t* Hm; const bf16_t* WG; int nM; bool skipctx; bool ctxonly;
    static constexpr int lda = 1024, K = 1024;
    __device__ __forceinline__ bool next(int i, GUnit& u) const {
        int pm, pn; if (!g8::static_tile(i >> 1, gridDim.x, blockIdx.x, nM, 12, pm, pn)) return false;
        if (skipctx) pm = skipctx_pm(pm);
        if (ctxonly) pm = pm * 33;
        const int sub = i & 1, br = pn >> 2, pl = pn & 3;
        u.pm = pm; u.pn = pn; u.x0 = sub; u.x1 = 0;
        if (sub == 0) { u.a = (const char*)(Y + (size_t)br * TG * 1024 + (size_t)pm * 256 * 1024); u.b = (const char*)(WB + (size_t)br * 1024 * 1024 + (size_t)pl * 256 * 1024); }
        else { u.a = (const char*)(Hm + (size_t)pm * 256 * 1024); u.b = (const char*)(WG + (size_t)pn * 256 * 1024); }
        return true;
    }
};
struct SchedZGc {
    static constexpr bool GATHER = false;
    const bf16_t* Y; const bf16_t* WB; const bf16_t* Hm; const bf16_t* WG; int nM; bool skipctx;
    static constexpr int lda = 1024, K = 1024;
    __device__ __forceinline__ bool next(int i, GUnit& u) const {
        const int q = i / 6, st = i - q * 6;
        int pm, pc; if (!g8::static_tile(q, gridDim.x, blockIdx.x, nM, 4, pm, pc)) return false;
        if (skipctx) pm = skipctx_pm(pm);
        const int sub = st & 1, br = st >> 1, pn = br * 4 + pc;
        u.pm = pm; u.pn = pn; u.x0 = sub; u.x1 = br;
        if (sub == 0) { u.a = (const char*)(Y + (size_t)br * TG * 1024 + (size_t)pm * 256 * 1024); u.b = (const char*)(WB + (size_t)br * 1024 * 1024 + (size_t)pc * 256 * 1024); }
        else { u.a = (const char*)(Hm + (size_t)pm * 256 * 1024); u.b = (const char*)(WG + (size_t)pn * 256 * 1024); }
        return true;
    }
};
struct SchedOut2 {
    static constexpr bool GATHER = false;
    const bf16_t* Z0; const bf16_t* Z1; const bf16_t* B; bool skipctx; int K; bool ctxonly; bool skew;
    static constexpr int lda = 3072;
    __device__ __forceinline__ bool next(int i, GUnit& u) const {
        int pm, pn;
        if (skew && gridDim.x == 256) {
            int L; const int b = (int)blockIdx.x;
            if (b < 32) { if (i >= 2) return false; L = b + 32 * i; } else { L = 64 + i * 224 + (b - 32); if (L >= 1024) return false; }
            g8::static_tile(0, 1, L, 256, 4, pm, pn);
        } else if (!g8::static_tile(i, gridDim.x, blockIdx.x, ctxonly ? 8 : (skipctx ? 256 : 2 * (TG / 256)), 4, pm, pn)) return false;
        if (skipctx) pm = skipctx_pm(pm);
        if (ctxonly) pm = pm * 33;
        u.pm = pm; u.pn = pn; u.x0 = 0; u.x1 = 0;
        const bf16_t* z1adj = Z1 - (size_t)(TG / 256) * 256 * 3072; const long long d = (pm < TG / 256) ? (long long)(Z0 - z1adj) : 0ll;
        u.a = (const char*)(z1adj + d + (size_t)pm * 256 * 3072);
        u.b = (const char*)(B + (size_t)pn * 256 * K);
        return true;
    }
};
struct SchedMoe {
    static constexpr bool GATHER = false;
    const bf16_t* A; const bf16_t* B; int lda, K, npn, brows;
    const LAS int* tab;
    __device__ __forceinline__ bool next(int i, GUnit& u) const {
        const int L = i * (int)gridDim.x + (int)blockIdx.x;
        const int ntile = tab[96];
        if (L >= ntile * npn) return false;
        const int tg = L / npn, pn = L - tg * npn;
        int e = 0;
#pragma unroll 1
        for (int j = 1; j < 32; ++j) e = (tab[64 + j] <= tg) ? j : e;
        const int mt = tg - tab[64 + e];
        const int slot0 = tab[32 + e] + 256 * mt;
        u.pm = slot0; u.pn = pn; u.x0 = e; u.x1 = tab[e] - 256 * mt;
        u.a = (const char*)(A + (size_t)slot0 * lda);
        u.b = (const char*)(B + ((size_t)e * brows + (size_t)pn * 256) * K);
        return true;
    }
};

struct SchedMoeG {
    static constexpr bool GATHER = true;
    const bf16_t* Hm; const bf16_t* B; const LAS int* tab; const LAS int* tok;
    static constexpr int lda = 1024, K = 1024;
    __device__ __forceinline__ bool next(int i, GUnit& u) const {
        const int L = i * (int)gridDim.x + (int)blockIdx.x;
        const int ntile = tab[96];
        if (L >= ntile * 8) return false;
        const int tg = L >> 3, pn = L & 7;
        int e = 0;
#pragma unroll 1
        for (int j = 1; j < 32; ++j) e = (tab[64 + j] <= tg) ? j : e;
        const int mt = tg - tab[64 + e];
        const int slot0 = tab[32 + e] + 256 * mt;
        u.pm = slot0; u.pn = pn; u.x0 = e; u.x1 = tab[e] - 256 * mt; u.xi = i;
        u.a = (const char*)Hm;
        u.b = (const char*)(B + ((size_t)e * 2048 + (size_t)pn * 256) * 1024);
        return true;
    }
    __device__ __forceinline__ void aoff(const GUnit& u, const int (&R)[2], const int (&C)[2], unsigned (&vo)[2][2]) const {
        const LAS int* tk = tok + u.xi * 256;
#pragma unroll
        for (int h = 0; h < 2; ++h)
#pragma unroll
            for (int q = 0; q < 2; ++q) vo[h][q] = (unsigned)(tk[h * 128 + R[q]] * 1024 + C[q]) * 2u;
    }
};

struct EpiQKV {
    static constexpr bool PERM = true;
    unsigned char* reg; int g;
    const f32x2* atab; const f32x2* rtab; bool dry;
    __device__ __forceinline__ void operator()(const f32x4 (&acc)[2][2][4][2], const GUnit& u, int wr, int wc, int fr, int fq) const {
        const int pn = u.pn;
        if (dry) { if (acc[0][0][0][0][0] == 1234.5678f) reg[0] = 1; return; }
        const int rg0 = u.pm * 256;
        const int bl = rg0 / TB, t0 = rg0 - bl * TB;
        bf16_t* GQK = (bf16_t*)(reg + R_GQK); bf16_t* GVT = (bf16_t*)(reg + R_GVT); float* GLR = (float*)(reg + R_GLR);
        bf16_t* AQ = (bf16_t*)(reg + R_AQ); bf16_t* AK = (bf16_t*)(reg + R_AK); bf16_t* AVT = (bf16_t*)(reg + R_AVT);
        bf16_t* RQK = (bf16_t*)(reg + R_RQK); bf16_t* RVT = (bf16_t*)(reg + R_RVT);
        if (pn < 4) {
            const float sc = pn < 2 ? 0.08838834764831845f : 1.0f;
#pragma unroll
            for (int ai = 0; ai < 2; ++ai)
#pragma unroll
                for (int m = 0; m < 4; ++m) { const int r = rg0 + ai * 128 + wr * 64 + m * 16 + fr; bf16_t* rowp = GQK + (size_t)r * 1024 + pn * 256 + wc * 32 + 8 * fq;
#pragma unroll
                    for (int bj = 0; bj < 2; ++bj) { const f32x4 v0 = acc[ai][bj][m][0] * sc, v1 = acc[ai][bj][m][1] * sc; u32x4 w; w.x = cvt_pk_bf16(v0[0], v0[1]); w.y = cvt_pk_bf16(v0[2], v0[3]); w.z = cvt_pk_bf16(v1[0], v1[1]); w.w = cvt_pk_bf16(v1[2], v1[3]);
                        *(u32x4*)(rowp + bj * 128) = w; } }
        } else if ((0x3C20F0u >> pn) & 1u) {
            bf16_t* VT; int dim0, nd;
            if (pn < 8) { VT = GVT; dim0 = (pn - 4) * 256; nd = 1024; } else if (pn == 13) { VT = AVT; dim0 = 0; nd = 256; } else { VT = RVT; dim0 = (pn - 18) * 256; nd = 1024; }
#pragma unroll
            for (int ai = 0; ai < 2; ++ai)
#pragma unroll
                for (int m = 0; m < 4; ++m) { const int dimr = ai * 128 + wr * 64 + m * 16 + fr; bf16_t* rowp = VT + ((size_t)bl * nd + dim0 + dimr) * TB + t0 + wc * 32 + 8 * fq;
#pragma unroll
                    for (int bj = 0; bj < 2; ++bj) { const f32x4 v0 = acc[ai][bj][m][0], v1 = acc[ai][bj][m][1]; u32x4 w; w.x = cvt_pk_bf16(v0[0], v0[1]); w.y = cvt_pk_bf16(v0[2], v0[3]); w.z = cvt_pk_bf16(v1[0], v1[1]); w.w = cvt_pk_bf16(v1[2], v1[3]);
                        *(u32x4*)(rowp + bj * 128) = w; } }
        } else if (pn == 22) {
            if (wc == 0) {
#pragma unroll
                for (int ai = 0; ai < 2; ++ai)
#pragma unroll
                    for (int m = 0; m < 4; ++m) { const int r = rg0 + ai * 128 + wr * 64 + m * 16 + fr;
#pragma unroll
                        for (int n = 0; n < 2; ++n) *(f32x4*)(GLR + (size_t)r * 32 + 8 * fq + 4 * n) = acc[ai][0][m][n]; }
            }
        } else {
            const bool isatt = pn <= 12;
            bf16_t* O; int ld, colbase; float sc;
            if (pn < 12)       { O = AQ;  ld = 1024; colbase = (pn - 8) * 256;  sc = 0.08838834764831845f * LOG2E; }
            else if (pn == 12) { O = AK;  ld = 256;  colbase = 0;               sc = 1.0f; }
            else if (pn < 16)  { O = RQK; ld = 1024; colbase = (pn - 14) * 256; sc = 1.0f; }
            else               { O = RQK; ld = 1024; colbase = 512 + (pn - 16) * 256; sc = 0.08838834764831845f; }
            const int hb = isatt ? ((wc & 1) * 16 + (wc >> 1) * 64) : 16 * wc;
            const int pstep = isatt ? 32 : 64;
            const int fi = isatt ? ((wc & 1) * 16 + 4 * fq) : (16 * wc + 4 * fq);
#pragma unroll
            for (int ai = 0; ai < 2; ++ai) {
                f32x4 tb[4][2];
#pragma unroll
                for (int m = 0; m < 4; ++m) { const int t = t0 + ai * 128 + wr * 64 + m * 16 + fr;
                    const f32x4* tp;
                    if (isatt) { const int lt = t - NCTX; const int pos = (t < NCTX) ? 0 : ((wc < 2) ? (lt >> 6) : (lt & 63)); tp = (const f32x4*)(atab + pos * 32 + fi); }
                    else tp = (const f32x4*)(rtab + (size_t)t * 64 + fi);
                    tb[m][0] = tp[0]; tb[m][1] = tp[1]; }
#pragma unroll
                for (int m = 0; m < 4; ++m) {
                    const int rl = ai * 128 + wr * 64 + m * 16 + fr; const int r = rg0 + rl;
                    f32x2 cs[4]; { const f32x4 a = tb[m][0], b = tb[m][1]; cs[0] = (f32x2){a[0], a[1]}; cs[1] = (f32x2){a[2], a[3]}; cs[2] = (f32x2){b[0], b[1]}; cs[3] = (f32x2){b[2], b[3]}; }
#pragma unroll
                    for (int bj = 0; bj < 2; ++bj) {
                        const f32x4 x1 = acc[ai][bj][m][0], x2 = acc[ai][bj][m][1];
                        float o1[4], o2[4];
#pragma unroll
                        for (int j = 0; j < 4; ++j) { o1[j] = (x1[j] * cs[j].x - x2[j] * cs[j].y) * sc; o2[j] = (x2[j] * cs[j].x + x1[j] * cs[j].y) * sc; }
                        bf16_t* p = O + (size_t)r * ld + colbase + bj * 128 + hb + 4 * fq;
                        u32x2 w1, w2; w1.x = cvt_pk_bf16(o1[0], o1[1]); w1.y = cvt_pk_bf16(o1[2], o1[3]); w2.x = cvt_pk_bf16(o2[0], o2[1]); w2.y = cvt_pk_bf16(o2[2], o2[3]);
                        *(u32x2*)p = w1; *(u32x2*)(p + pstep) = w2;
                    }
                }
            }
        }
    }
};

struct EpiGateR {
    static constexpr bool PERM = true;
    unsigned char* reg; const f32x2* stats; const float* gng; const float* rng; bool dry;
    __device__ __forceinline__ void operator()(const f32x4 (&acc)[2][2][4][2], const GUnit& u, int wr, int wc, int fr, int fq) const {
        const int mix = u.pn >> 2, head = u.pn & 3;
        bf16_t* O = (bf16_t*)(reg + (mix ? R_ORF : R_OGF));
        const float* gn = (mix ? rng : gng) + head * 256;
        const f32x2* st = stats + (size_t)mix * TG * 4;
        f32x4 ga[2], gb[2];
#pragma unroll
        for (int bj = 0; bj < 2; ++bj) { const int c0 = bj * 128 + wc * 32 + 8 * fq; ga[bj] = *(const f32x4*)(gn + c0); gb[bj] = *(const f32x4*)(gn + c0 + 4); }
#pragma unroll
        for (int ai = 0; ai < 2; ++ai) {
            u32x4 ov[4][2]; f32x2 sv[4];
#pragma unroll
            for (int m = 0; m < 4; ++m) { const int r = u.pm * 256 + ai * 128 + wr * 64 + m * 16 + fr; sv[m] = st[(size_t)r * 4 + head];
#pragma unroll
                for (int bj = 0; bj < 2; ++bj) ov[m][bj] = *(const u32x4*)(O + (size_t)r * 1024 + head * 256 + bj * 128 + wc * 32 + 8 * fq); }
#pragma unroll
            for (int m = 0; m < 4; ++m) { const int r = u.pm * 256 + ai * 128 + wr * 64 + m * 16 + fr; const float mu = sv[m].x, rs = sv[m].y;
#pragma unroll
                for (int bj = 0; bj < 2; ++bj) {
                    const u32x4 o4 = ov[m][bj]; const f32x4 a0 = acc[ai][bj][m][0], a1 = acc[ai][bj][m][1]; const f32x4 g0 = ga[bj], g1 = gb[bj];
                    float y[8];
                    y[0] = (bflo(o4.x) - mu) * rs * g0[0] * silu_f(a0[0]); y[1] = (bfhi(o4.x) - mu) * rs * g0[1] * silu_f(a0[1]);
                    y[2] = (bflo(o4.y) - mu) * rs * g0[2] * silu_f(a0[2]); y[3] = (bfhi(o4.y) - mu) * rs * g0[3] * silu_f(a0[3]);
                    y[4] = (bflo(o4.z) - mu) * rs * g1[0] * silu_f(a1[0]); y[5] = (bfhi(o4.z) - mu) * rs * g1[1] * silu_f(a1[1]);
                    y[6] = (bflo(o4.w) - mu) * rs * g1[2] * silu_f(a1[2]); y[7] = (bfhi(o4.w) - mu) * rs * g1[3] * silu_f(a1[3]);
                    u32x4 w; w.x = cvt_pk_bf16(y[0], y[1]); w.y = cvt_pk_bf16(y[2], y[3]); w.z = cvt_pk_bf16(y[4], y[5]); w.w = cvt_pk_bf16(y[6], y[7]);
                    if (!dry) *(u32x4*)(O + (size_t)r * 1024 + head * 256 + bj * 128 + wc * 32 + 8 * fq) = w;
                } }
        }
    }
};

struct EpiBf16 {
    static constexpr bool PERM = true;
    bf16_t* O; int ld;
    __device__ __forceinline__ void operator()(const f32x4 (&acc)[2][2][4][2], const GUnit& u, int wr, int wc, int fr, int fq) const {
#pragma unroll
        for (int ai = 0; ai < 2; ++ai)
#pragma unroll
            for (int m = 0; m < 4; ++m) { bf16_t* rowp = O + (size_t)(u.pm * 256 + ai * 128 + wr * 64 + m * 16 + fr) * ld + u.pn * 256 + wc * 32 + 8 * fq;
#pragma unroll
                for (int bj = 0; bj < 2; ++bj) { const f32x4 v0 = acc[ai][bj][m][0], v1 = acc[ai][bj][m][1]; u32x4 w; w.x = cvt_pk_bf16(v0[0], v0[1]); w.y = cvt_pk_bf16(v0[2], v0[3]); w.z = cvt_pk_bf16(v1[0], v1[1]); w.w = cvt_pk_bf16(v1[2], v1[3]);
                    *(u32x4*)(rowp + bj * 128) = w; } }
    }
};
struct EpiGZ {
    static constexpr bool PERM = true;
    bf16_t* Z; bool dry;
    __device__ __forceinline__ void operator()(const f32x4 (&acc)[2][2][4][2], const GUnit& u, int wr, int wc, int fr, int fq) const {
#pragma unroll
        for (int ai = 0; ai < 2; ++ai) {
            u32x4 zv[4][2];
#pragma unroll
            for (int m = 0; m < 4; ++m)
#pragma unroll
                for (int bj = 0; bj < 2; ++bj) zv[m][bj] = *(const u32x4*)(Z + (size_t)(u.pm * 256 + ai * 128 + wr * 64 + m * 16 + fr) * 3072 + u.pn * 256 + wc * 32 + 8 * fq + bj * 128);
#pragma unroll
            for (int m = 0; m < 4; ++m) { bf16_t* rowp = Z + (size_t)(u.pm * 256 + ai * 128 + wr * 64 + m * 16 + fr) * 3072 + u.pn * 256 + wc * 32 + 8 * fq;
#pragma unroll
                for (int bj = 0; bj < 2; ++bj) { const f32x4 v0 = acc[ai][bj][m][0], v1 = acc[ai][bj][m][1]; const u32x4 z = zv[m][bj]; u32x4 w;
                    w.x = cvt_pk_bf16(sigmoid_f(v0[0]) * bflo(z.x), sigmoid_f(v0[1]) * bfhi(z.x)); w.y = cvt_pk_bf16(sigmoid_f(v0[2]) * bflo(z.y), sigmoid_f(v0[3]) * bfhi(z.y));
                    w.z = cvt_pk_bf16(sigmoid_f(v1[0]) * bflo(z.z), sigmoid_f(v1[1]) * bfhi(z.z)); w.w = cvt_pk_bf16(sigmoid_f(v1[2]) * bflo(z.w), sigmoid_f(v1[3]) * bfhi(z.w));
                    if (!dry) *(u32x4*)(rowp + bj * 128) = w; } }
        }
    }
};
struct EpiZG {
    static constexpr bool PERM = true;
    bf16_t* Z; bool dry;
    __device__ __forceinline__ void operator()(const f32x4 (&acc)[2][2][4][2], const GUnit& u, int wr, int wc, int fr, int fq) const {
        if (dry) { if (acc[0][0][0][0][0] == 1234.5678f) Z[0] = 1; return; }
        if (u.x0 == 0) { EpiBf16 e{Z, 3072}; e(acc, u, wr, wc, fr, fq); } else { EpiGZ e{Z, false}; e(acc, u, wr, wc, fr, fq); }
    }
};
struct EpiZGc {
    static constexpr bool PERM = true;
    bf16_t* Z;
    __device__ __forceinline__ void operator()(const f32x4 (&acc)[2][2][4][2], const GUnit& u, int wr, int wc, int fr, int fq) const {
        if (u.x0 == 0) { EpiBf16 e{Z, 3072}; e(acc, u, wr, wc, fr, fq); return; }
        const int br = u.x1, pc = u.pn - br * 4;
#pragma unroll
        for (int ai = 0; ai < 2; ++ai) {
            u32x4 zv[4][2], mv[4][2];
#pragma unroll
            for (int m = 0; m < 4; ++m)
#pragma unroll
                for (int bj = 0; bj < 2; ++bj) { const bf16_t* rp = Z + (size_t)(u.pm * 256 + ai * 128 + wr * 64 + m * 16 + fr) * 3072 + wc * 32 + 8 * fq + bj * 128;
                    zv[m][bj] = *(const u32x4*)(rp + u.pn * 256); mv[m][bj] = (br > 0) ? *(const u32x4*)(rp + pc * 256) : (u32x4){0u, 0u, 0u, 0u}; }
#pragma unroll
            for (int m = 0; m < 4; ++m) { bf16_t* rowp = Z + (size_t)(u.pm * 256 + ai * 128 + wr * 64 + m * 16 + fr) * 3072 + pc * 256 + wc * 32 + 8 * fq;
#pragma unroll
                for (int bj = 0; bj < 2; ++bj) { const f32x4 v0 = acc[ai][bj][m][0], v1 = acc[ai][bj][m][1]; const u32x4 z = zv[m][bj], mm = mv[m][bj]; u32x4 w;
                    w.x = cvt_pk_bf16(bflo(mm.x) + sigmoid_f(v0[0]) * bflo(z.x), bfhi(mm.x) + sigmoid_f(v0[1]) * bfhi(z.x)); w.y = cvt_pk_bf16(bflo(mm.y) + sigmoid_f(v0[2]) * bflo(z.y), bfhi(mm.y) + sigmoid_f(v0[3]) * bfhi(z.y));
                    w.z = cvt_pk_bf16(bflo(mm.z) + sigmoid_f(v1[0]) * bflo(z.z), bfhi(mm.z) + sigmoid_f(v1[1]) * bfhi(z.z)); w.w = cvt_pk_bf16(bflo(mm.w) + sigmoid_f(v1[2]) * bflo(z.w), bfhi(mm.w) + sigmoid_f(v1[3]) * bfhi(z.w));
                    *(u32x4*)(rowp + bj * 128) = w; } }
        }
    }
};
struct EpiOut {
    static constexpr bool PERM = false;
    const float* xin_lat; const float* xin_ctx; float* xout_lat; float* xout_ctx; const float* mod; int g; bool dry;
    __device__ __forceinline__ void operator()(const f32x4 (&acc)[2][2][4][2], const GUnit& u, int wr, int wc, int fr, int fq) const {
        const int rg0 = u.pm * 256; const int bl = rg0 / TB, t0 = rg0 - bl * TB; const int b = g * BG + bl;
        const bool isctx = t0 < NCTX;
        const float* g1 = mod + (size_t)(isctx ? 8 : b) * 6144 + 2048 + u.pn * 256 + wc * 32 + 4 * fq;
        f32x4 gv[2][2];
#pragma unroll
        for (int bj = 0; bj < 2; ++bj)
#pragma unroll
            for (int n = 0; n < 2; ++n) gv[bj][n] = *(const f32x4*)(g1 + bj * 128 + n * 16);
#pragma unroll
        for (int ai = 0; ai < 2; ++ai) {
            f32x4 xv[4][2][2];
#pragma unroll
            for (int m = 0; m < 4; ++m) { const int t = t0 + ai * 128 + wr * 64 + m * 16 + fr;
                const float* ip = (isctx ? xin_ctx : xin_lat) + (isctx ? ctx_off(b, t) : lat_off(b, t)) + u.pn * 256 + wc * 32 + 4 * fq;
#pragma unroll
                for (int bj = 0; bj < 2; ++bj)
#pragma unroll
                    for (int n = 0; n < 2; ++n) xv[m][bj][n] = *(const f32x4*)(ip + bj * 128 + n * 16); }
#pragma unroll
            for (int m = 0; m < 4; ++m) { const int t = t0 + ai * 128 + wr * 64 + m * 16 + fr;
                float* op = (isctx ? xout_ctx : xout_lat) + (isctx ? ctx_off(b, t) : lat_off(b, t)) + u.pn * 256 + wc * 32 + 4 * fq;
#pragma unroll
                for (int bj = 0; bj < 2; ++bj)
#pragma unroll
                    for (int n = 0; n < 2; ++n) { if (!dry) *(f32x4*)(op + bj * 128 + n * 16) = xv[m][bj][n] + gv[bj][n] * acc[ai][bj][m][n]; } }
        }
    }
};
struct EpiMoe1 {
    static constexpr bool PERM = true;
    bf16_t* Hm;
    __device__ __forceinline__ void operator()(const f32x4 (&acc)[2][2][4][2], const GUnit& u, int wr, int wc, int fr, int fq) const {
#pragma unroll
        for (int ai = 0; ai < 2; ++ai)
#pragma unroll
            for (int m = 0; m < 4; ++m) { const int rl = ai * 128 + wr * 64 + m * 16 + fr;
                if (rl < u.x1) { bf16_t* p = Hm + (size_t)(u.pm + rl) * 1024 + u.pn * 128 + wc * 32 + 8 * fq;
                    const f32x4 a0 = acc[ai][0][m][0], a1 = acc[ai][0][m][1], b0 = acc[ai][1][m][0], b1 = acc[ai][1][m][1]; u32x4 w;
                    w.x = cvt_pk_bf16(silu_f(a0[0]) * b0[0], silu_f(a0[1]) * b0[1]); w.y = cvt_pk_bf16(silu_f(a0[2]) * b0[2], silu_f(a0[3]) * b0[3]);
                    w.z = cvt_pk_bf16(silu_f(a1[0]) * b1[0], silu_f(a1[1]) * b1[1]); w.w = cvt_pk_bf16(silu_f(a1[2]) * b1[2], silu_f(a1[3]) * b1[3]);
                    *(u32x4*)p = w; } }
    }
};
struct EpiMoe2 {
    static constexpr bool PERM = true;
    bf16_t* Y; const float* slotw;
    __device__ __forceinline__ void operator()(const f32x4 (&acc)[2][2][4][2], const GUnit& u, int wr, int wc, int fr, int fq) const {
        float sw[2][4];
#pragma unroll
        for (int ai = 0; ai < 2; ++ai)
#pragma unroll
            for (int m = 0; m < 4; ++m) sw[ai][m] = slotw[u.pm + ai * 128 + wr * 64 + m * 16 + fr];
#pragma unroll
        for (int ai = 0; ai < 2; ++ai)
#pragma unroll
            for (int m = 0; m < 4; ++m) { const int rl = ai * 128 + wr * 64 + m * 16 + fr;
                if (rl < u.x1) { const float w8 = sw[ai][m]; bf16_t* rowp = Y + (size_t)(u.pm + rl) * 1024 + u.pn * 256 + wc * 32 + 8 * fq;
#pragma unroll
                    for (int bj = 0; bj < 2; ++bj) { const f32x4 v0 = acc[ai][bj][m][0] * w8, v1 = acc[ai][bj][m][1] * w8; u32x4 w; w.x = cvt_pk_bf16(v0[0], v0[1]); w.y = cvt_pk_bf16(v0[2], v0[3]); w.z = cvt_pk_bf16(v1[0], v1[1]); w.w = cvt_pk_bf16(v1[2], v1[3]);
                        *(u32x4*)(rowp + bj * 128) = w; } } }
    }
};

template <class F>
__device__ __forceinline__ void conv_tile(LAS float* tile, F f, int n0, int k0src, size_t ldsrc, bf16_t* dst, size_t dst_ld, int k0dst) {
    const int tid = tid_fresh(), c4 = tid & 31, kb = tid >> 5;
    const float* colp = f(n0 + 4 * c4);
#pragma unroll
    for (int i = 0; i < 4; ++i) { const int kl = kb + 16 * i; const f32x4 v = colp ? *(const f32x4*)(colp + (size_t)(k0src + kl) * ldsrc) : (f32x4){0.f, 0.f, 0.f, 0.f}; *(LAS f32x4*)(tile + kl * 132 + 4 * c4) = v; }
    __syncthreads();
    const int n2 = tid >> 2, k16 = (tid & 3) * 16;
    u32x4 w0, w1;
    w0.x = cvt_pk_bf16(tile[(k16 + 0) * 132 + n2], tile[(k16 + 1) * 132 + n2]); w0.y = cvt_pk_bf16(tile[(k16 + 2) * 132 + n2], tile[(k16 + 3) * 132 + n2]);
    w0.z = cvt_pk_bf16(tile[(k16 + 4) * 132 + n2], tile[(k16 + 5) * 132 + n2]); w0.w = cvt_pk_bf16(tile[(k16 + 6) * 132 + n2], tile[(k16 + 7) * 132 + n2]);
    w1.x = cvt_pk_bf16(tile[(k16 + 8) * 132 + n2], tile[(k16 + 9) * 132 + n2]); w1.y = cvt_pk_bf16(tile[(k16 + 10) * 132 + n2], tile[(k16 + 11) * 132 + n2]);
    w1.z = cvt_pk_bf16(tile[(k16 + 12) * 132 + n2], tile[(k16 + 13) * 132 + n2]); w1.w = cvt_pk_bf16(tile[(k16 + 14) * 132 + n2], tile[(k16 + 15) * 132 + n2]);
    bf16_t* dp = dst + (size_t)(n0 + n2) * dst_ld + k0dst + k16;
    *(u32x4*)dp = w0; *(u32x4*)(dp + 8) = w1;
    __syncthreads();
}
__device__ __forceinline__ int win_col(int np) {
    if (np < 5888) {
        const int tile = np >> 8, p = np & 255, hh = p >> 7, pp = p & 127, wc = pp >> 5, n = (pp >> 2) & 1, q = 4 * ((pp >> 3) & 3) + (pp & 3);
        const int fatt = (wc & 1) * 16 + (wc >> 1) * 64 + q + 32 * n, fret = 16 * wc + q + 64 * n;
        if (tile < 8) return np;
        if (tile < 12) return 3104 + (2 * (tile - 8) + hh) * 128 + fatt;
        if (tile == 12) return 4128 + hh * 128 + fatt;
        if (tile == 13) return 4384 + p;
        if (tile < 16) return 4640 + (2 * (tile - 14) + hh) * 128 + fret;
        if (tile < 18) return 5152 + (2 * (tile - 16) + hh) * 128 + fret;
        if (tile < 22) return 5664 + (np - 18 * 256);
        return p < 32 ? 3072 + p : -1;
    }
    if (np < 7936) { const int m = np - 5888; return m < 1024 ? 2048 + m : 6688 + (m - 1024); }
    return 7712 + (np - 7936);
}
struct FWin { const float* w; __device__ __forceinline__ const float* operator()(int np) const { const int c = win_col(np); return c < 0 ? nullptr : w + c; } };
struct FPlain { const float* w; __device__ __forceinline__ const float* operator()(int n) const { return w + n; } };
struct FW13 { const float* w1; const float* w3; __device__ __forceinline__ const float* operator()(int np) const { const int tile = np >> 8, r = np & 255; return r < 128 ? w1 + tile * 128 + r : w3 + tile * 128 + (r - 128); } };

constexpr int PRO_MOD = 384, PRO_TAB = 8 + 1056, PRO_WR = 192, PRO_WIN = 2 * 86 * 16, PRO_WBR = 2 * 3 * 8 * 16, PRO_WO3 = 2 * 8 * 48, PRO_WO1 = 2 * 8 * 16;
constexpr int PRO_UNITS = PRO_MOD + PRO_TAB + PRO_WR + PRO_WIN + PRO_WBR + PRO_WO3 + PRO_WO1;

__device__ __forceinline__ void prologue1(KP p, LAS unsigned char* lds) {
    unsigned char* ws = p.ws; const int tid = tid_fresh();
    LAS float* tile = (LAS float*)lds;
    for (int u = blockIdx.x; u < PRO_UNITS; u += gridDim.x) {
        int idx = u;
        if (idx < PRO_MOD) {
            const int l = idx / 192, rem = idx % 192, cb = rem / 16, ks = rem % 16, k0 = ks * 64;
            LAS float* sv = tile;
            for (int e = tid; e < 9 * 64; e += 512) { const int r = e >> 6, kk = e & 63; const float cv = (r < 8) ? p.in[1][r * 1024 + k0 + kk] : p.in[3][k0 + kk]; sv[e] = cv / (1.0f + expf(-cv)); }
            __syncthreads();
            const int n = cb * 512 + tid; const float* w = p.in[4] + ((size_t)l * 1024 + k0) * 6144 + n;
            float a[9];
#pragma unroll
            for (int r = 0; r < 9; ++r) a[r] = 0.f;
            for (int kk = 0; kk < 64; ++kk) { const float wv = w[(size_t)kk * 6144];
#pragma unroll
                for (int r = 0; r < 9; ++r) a[r] += sv[r * 64 + kk] * wv; }
            float* mp = (float*)(ws + OFF_MODP);
#pragma unroll
            for (int r = 0; r < 9; ++r) mp[((size_t)(ks * 2 + l) * 9 + r) * 6144 + n] = a[r];
            __syncthreads();
            continue;
        }
        idx -= PRO_MOD;
        if (idx < PRO_TAB) {
            const int e = idx * 512 + tid;
            if (e < 4096) { const int pos = e >> 5, i = e & 31; const float inv = powf(10000.0f, -(float)i / 32.0f); const float ang = (float)pos * inv; float s, c; sincosf(ang, &s, &c); ((f32x2*)(ws + OFF_ATAB))[e] = (f32x2){c, s}; }
            else { const int e2 = e - 4096; if (e2 < TB * 64) { const int pos = e2 >> 6, i = e2 & 63; const float inv = powf(10000.0f, -(float)i / 64.0f); const float ang = (float)pos * inv; float s, c; sincosf(ang, &s, &c); ((f32x2*)(ws + OFF_RTAB))[e2] = (f32x2){c, s}; } }
            continue;
        }
        idx -= PRO_TAB;
        if (idx < PRO_WR) {
            const int e = idx * 512 + tid; const int k = e & 1023, n = (e >> 10) % 48, l = e / (48 * 1024);
            const float v = n < 4 ? p.in[18][((size_t)l * 1024 + k) * 4 + n] : (n < 36 ? p.in[20][((size_t)l * 1024 + k) * 32 + (n - 4)] : 0.f);
            const bf16_t hi = f2bf(v); const bf16_t lo = f2bf(v - bf2f(hi));
            bf16_t* W = (bf16_t*)(ws + OFF_WR) + (size_t)l * 2 * 48 * 1024;
            W[(size_t)n * 1024 + k] = hi; W[(size_t)(48 + n) * 1024 + k] = lo;
            continue;
        }
        idx -= PRO_WR;
        if (idx < PRO_WIN) {
            const int l = idx / (86 * 16), rem = idx % (86 * 16), nt = rem / 16, kt = rem % 16;
            FWin f{p.in[8] + (size_t)l * 1024 * NIN};
            conv_tile(tile, f, nt * 128, kt * 64, NIN, (bf16_t*)(ws + OFF_WINT) + (size_t)l * WIN_ROWS * 1024, 1024, kt * 64);
            continue;
        }
        idx -= PRO_WIN;
        if (idx < PRO_WBR) {
            const int lb = idx / 128, rem = idx % 128, nt = rem / 16, kt = rem % 16; const int l = lb / 3, br = lb % 3;
            FPlain f{p.in[14 + br] + (size_t)l * 1024 * 1024};
            conv_tile(tile, f, nt * 128, kt * 64, 1024, (bf16_t*)(ws + OFF_WBRT) + (size_t)lb * 1024 * 1024, 1024, kt * 64);
            continue;
        }
        idx -= PRO_WBR;
        if (idx < PRO_WO3) {
            const int l = idx / (8 * 48), rem = idx % (8 * 48), nt = rem / 48, kt = rem % 48;
            FPlain f{p.in[17] + (size_t)l * 1024 * 1024};
            conv_tile(tile, f, nt * 128, (kt % 16) * 64, 1024, (bf16_t*)(ws + OFF_WO3T) + (size_t)l * 1024 * 3072, 3072, kt * 64);
            continue;
        }
        idx -= PRO_WO3;
        {
            const int l = idx / 128, rem = idx % 128, nt = rem / 16, kt = rem % 16;
            FPlain f{p.in[17] + (size_t)l * 1024 * 1024};
            conv_tile(tile, f, nt * 128, kt * 64, 1024, (bf16_t*)(ws + OFF_WO1T) + (size_t)l * 1024 * 1024, 1024, kt * 64);
        }
    }
}
__device__ __forceinline__ void prologue2(KP p) {

    const float* mp = (const float*)(p.ws + OFF_MODP); float* mo = (float*)(p.ws + OFF_MOD);
    for (int e = blockIdx.x * 512 + tid_fresh(); e < 2 * 9 * 6144; e += gridDim.x * 512) {
        const int l = e / (9 * 6144), n = e % 6144;
        float s = p.in[5][l * 6144 + n];
#pragma unroll
        for (int ks = 0; ks < 16; ++ks) s += mp[(size_t)ks * 2 * 9 * 6144 + e];
        mo[e] = s;
    }
}
__device__ __forceinline__ void moe_convert(KP p, int layer, LAS unsigned char* lds) {
    bf16_t* W13T = (bf16_t*)(p.ws + OFF_REG + M_W13T); bf16_t* W2T = (bf16_t*)(p.ws + OFF_REG + M_W2T);
    const int tid = tid_fresh(), n2 = tid >> 2, k16 = (tid & 3) * 16;
    const float* w1 = p.in[22] + (size_t)layer * 32 * 1024 * 1024; const float* w3 = p.in[23] + (size_t)layer * 32 * 1024 * 1024; const float* w2 = p.in[24] + (size_t)layer * 32 * 1024 * 1024;
    constexpr int NT = 32 * 16 * 16 + 32 * 8 * 16;
#pragma unroll 2
    for (int u = blockIdx.x; u < NT; u += gridDim.x) {
        const float* sp; bf16_t* dp;
        if (u < 32 * 16 * 16) { const int e = u >> 8, rem = u & 255, nt = rem >> 4, kt = rem & 15; const int np = nt * 128 + n2, tl = np >> 8, r = np & 255;
            sp = (r < 128 ? w1 + tl * 128 + r : w3 + tl * 128 + (r - 128)) + (size_t)e * 1024 * 1024 + (size_t)(kt * 64 + k16) * 1024;
            dp = W13T + ((size_t)e * 2048 + np) * 1024 + kt * 64 + k16; }
        else { const int v = u - 32 * 16 * 16; const int e = v >> 7, rem = v & 127, nt = rem >> 4, kt = rem & 15;
            sp = w2 + (size_t)e * 1024 * 1024 + (size_t)(kt * 64 + k16) * 1024 + nt * 128 + n2;
            dp = W2T + ((size_t)e * 1024 + nt * 128 + n2) * 1024 + kt * 64 + k16; }
        float v[16];
#pragma unroll
        for (int i = 0; i < 16; ++i) v[i] = sp[(size_t)i * 1024];
        u32x4 w0, w1v;
        w0.x = cvt_pk_bf16(v[0], v[1]); w0.y = cvt_pk_bf16(v[2], v[3]); w0.z = cvt_pk_bf16(v[4], v[5]); w0.w = cvt_pk_bf16(v[6], v[7]);
        w1v.x = cvt_pk_bf16(v[8], v[9]); w1v.y = cvt_pk_bf16(v[10], v[11]); w1v.z = cvt_pk_bf16(v[12], v[13]); w1v.w = cvt_pk_bf16(v[14], v[15]);
        *(u32x4*)dp = w0; *(u32x4*)(dp + 8) = w1v;
    }
}

template <int MODE>
__device__ __forceinline__ void norm_phase(KP p, int layer, bool dry) {
    unsigned char* ws = p.ws; const int tid_ = tid_fresh(); const int lane = tid_ & 63, wid = tid_ >> 6;
    const float* MOD = (const float*)(ws + OFF_MOD); float* CTXS = (float*)(ws + OFF_CTXS); bf16_t* H = (bf16_t*)(ws + OFF_H);
    const int* TOKSL = (const int*)(ws + OFF_TOKSL); const bf16_t* YS = (const bf16_t*)(ws + OFF_REG + M_XG);
    for (int R = blockIdx.x * 8 + wid; R < TALL; R += gridDim.x * 8) {
        const int b = R / TB, t = R - b * TB; const bool isctx = t < NCTX; const int r9 = isctx ? 8 : b;
        if ((MODE == 3 || (MODE == 2 && layer == 1)) && isctx) continue;
        const float* src; float* dstx;
        if (MODE == 0) { src = isctx ? p.in[2] + ctx_off(b, t) : p.in[0] + lat_off(b, t); dstx = nullptr; }
        else { dstx = isctx ? CTXS + ctx_off(b, t) : p.out + lat_off(b, t); src = dstx; }
        f32x4 x[4];
#pragma unroll
        for (int i = 0; i < 4; ++i) x[i] = *(const f32x4*)(src + 256 * i + 4 * lane);
        if (MODE == 1 || MODE == 3) {
            const int pl = (MODE == 1) ? layer - 1 : 1;
            const float* g2 = MOD + ((size_t)pl * 9 + r9) * 6144 + 5120;
            const int sa = TOKSL[R * 2], sb = TOKSL[R * 2 + 1];
#pragma unroll
            for (int i = 0; i < 4; ++i) { const int c = 256 * i + 4 * lane; const u32x2 ya = *(const u32x2*)(YS + (size_t)sa * 1024 + c), yb = *(const u32x2*)(YS + (size_t)sb * 1024 + c); const f32x4 gv = *(const f32x4*)(g2 + c);
                x[i][0] += gv[0] * (bflo(ya.x) + bflo(yb.x)); x[i][1] += gv[1] * (bfhi(ya.x) + bfhi(yb.x)); x[i][2] += gv[2] * (bflo(ya.y) + bflo(yb.y)); x[i][3] += gv[3] * (bfhi(ya.y) + bfhi(yb.y)); }
            if (MODE == 1 && !dry) {
#pragma unroll
                for (int i = 0; i < 4; ++i) *(f32x4*)(dstx + 256 * i + 4 * lane) = x[i];
            }
        }
        float ss = 0.f;
#pragma unroll
        for (int i = 0; i < 4; ++i) ss += x[i][0] * x[i][0] + x[i][1] * x[i][1] + x[i][2] * x[i][2] + x[i][3] * x[i][3];
        ss = wave_sum(ss, lane);
        const float rstd = rsqrtf(ss * (1.0f / 1024.0f) + 1e-6f);
        if (MODE == 3) {
#pragma unroll
            for (int i = 0; i < 4; ++i) { const int c = 256 * i + 4 * lane; const f32x4 g = *(const f32x4*)(p.in[25] + c);
                if (!dry) *(f32x4*)(p.out + lat_off(b, t) + c) = x[i] * rstd * g; }
            continue;
        }
        const float* gain = (MODE == 2 ? p.in[7] : p.in[6]) + layer * 1024;
        const float* mrow = MOD + ((size_t)layer * 9 + r9) * 6144 + (MODE == 2 ? 3072 : 0);
        f32x4 h[4];
#pragma unroll
        for (int i = 0; i < 4; ++i) { const int c = 256 * i + 4 * lane; const f32x4 g = *(const f32x4*)(gain + c), sh = *(const f32x4*)(mrow + c), sc = *(const f32x4*)(mrow + 1024 + c);
            h[i] = (x[i] * rstd * g) * (sc + 1.0f) + sh;
            u32x2 w; w.x = cvt_pk_bf16(h[i][0], h[i][1]); w.y = cvt_pk_bf16(h[i][2], h[i][3]); *(u32x2*)(H + (size_t)R * 1024 + c) = w; }
        if (MODE == 2) {
            const float* WR = (const float*)(ws + OFF_WR) + (size_t)layer * 1024 * 36;
            float a[36];
#pragma unroll
            for (int o = 0; o < 36; ++o) a[o] = 0.f;
#pragma unroll
            for (int i = 0; i < 4; ++i)
#pragma unroll
                for (int jj = 0; jj < 4; ++jj) { const float hv = h[i][jj]; const f32x4* wrow = (const f32x4*)(WR + (size_t)(256 * i + 4 * lane + jj) * 36);
#pragma unroll
                    for (int o4 = 0; o4 < 9; ++o4) { const f32x4 w = wrow[o4]; a[4 * o4] += hv * w[0]; a[4 * o4 + 1] += hv * w[1]; a[4 * o4 + 2] += hv * w[2]; a[4 * o4 + 3] += hv * w[3]; } }
#pragma unroll
            for (int o = 0; o < 36; ++o) a[o] = wave_sum(a[o], lane);
            if (lane == 0) {
                const float* bg = p.in[19] + layer * 4; const float* be = p.in[21] + layer * 32;
                float gl[4];
#pragma unroll
                for (int j = 0; j < 4; ++j) gl[j] = a[j] + bg[j];
                int grp = 0; float gm = gl[0];
#pragma unroll
                for (int j = 1; j < 4; ++j) if (gl[j] > gm) { gm = gl[j]; grp = j; }
                float den = 0.f;
#pragma unroll
                for (int j = 0; j < 4; ++j) den += expf(gl[j] - gm);
                const float gp = 1.0f / den;
                float v1 = -3.0e38f, v2 = -3.0e38f; int i1 = 0, i2 = 0;
#pragma unroll
                for (int j = 0; j < 8; ++j) {
                    const float lv = (grp == 0 ? a[4 + j] : grp == 1 ? a[12 + j] : grp == 2 ? a[20 + j] : a[28 + j]) + be[grp * 8 + j];
                    if (lv > v1) { v2 = v1; i2 = i1; v1 = lv; i1 = j; } else if (lv > v2) { v2 = lv; i2 = j; }
                }
                const float e2 = expf(v2 - v1); const float w1 = gp / (1.0f + e2), w2 = gp * e2 / (1.0f + e2);
                const int ex1 = grp * 8 + i1, ex2 = grp * 8 + i2;
                unsigned* cnt = (unsigned*)(ws + OFF_CNT) + layer * 32;
                const unsigned r1 = atomicAdd(cnt + ex1, 1u), r2 = atomicAdd(cnt + ex2, 1u);
                int* EX = (int*)(ws + OFF_EXPID); float* GW = (float*)(ws + OFF_GATEW); int* RK = (int*)(ws + OFF_RANK);
                EX[R * 2] = ex1; EX[R * 2 + 1] = ex2; GW[R * 2] = w1; GW[R * 2 + 1] = w2; RK[R * 2] = (int)r1; RK[R * 2 + 1] = (int)r2;
            }
        }
    }
}

template <int MODE>
__device__ __forceinline__ void norm_phase2(KP p, int layer, bool dry) {
    unsigned char* ws = p.ws; const int tid_ = tid_fresh(); const int lane = tid_ & 63, wid = tid_ >> 6;
    const float* MOD = (const float*)(ws + OFF_MOD); float* CTXS = (float*)(ws + OFF_CTXS); bf16_t* H = (bf16_t*)(ws + OFF_H);
    const int* TOKSL = (const int*)(ws + OFF_TOKSL); const bf16_t* YS = (const bf16_t*)(ws + OFF_REG + M_XG);
    const int stride = gridDim.x * 8;
    for (int R0 = blockIdx.x * 8 + wid; R0 < TALL; R0 += 2 * stride) {
        int Rr[2], bb[2], tt[2]; bool ok[2], ic[2];
#pragma unroll
        for (int rr = 0; rr < 2; ++rr) { const int R = R0 + rr * stride; ok[rr] = R < TALL; Rr[rr] = ok[rr] ? R : R0; bb[rr] = Rr[rr] / TB; tt[rr] = Rr[rr] - bb[rr] * TB; ic[rr] = tt[rr] < NCTX; if (MODE == 3 && ic[rr]) ok[rr] = false; }
        f32x4 x[2][4]; int sa[2], sb[2];
#pragma unroll
        for (int rr = 0; rr < 2; ++rr) {
            const float* src;
            if (MODE == 0) src = ic[rr] ? p.in[2] + ctx_off(bb[rr], tt[rr]) : p.in[0] + lat_off(bb[rr], tt[rr]);
            else src = ic[rr] ? CTXS + ctx_off(bb[rr], tt[rr]) : p.out + lat_off(bb[rr], tt[rr]);
#pragma unroll
            for (int i = 0; i < 4; ++i) x[rr][i] = *(const f32x4*)(src + 256 * i + 4 * lane);
            if (MODE == 1 || MODE == 3) { sa[rr] = TOKSL[Rr[rr] * 2]; sb[rr] = TOKSL[Rr[rr] * 2 + 1]; }
        }
        u32x2 ya[2][4], yb[2][4];
        if (MODE == 1 || MODE == 3) {
#pragma unroll
            for (int rr = 0; rr < 2; ++rr)
#pragma unroll
                for (int i = 0; i < 4; ++i) { const int c = 256 * i + 4 * lane; ya[rr][i] = *(const u32x2*)(YS + (size_t)sa[rr] * 1024 + c); yb[rr][i] = *(const u32x2*)(YS + (size_t)sb[rr] * 1024 + c); }
        }
#pragma unroll
        for (int rr = 0; rr < 2; ++rr) {
            if (!ok[rr]) continue;
            const int R = Rr[rr], b = bb[rr], t = tt[rr]; const int r9 = ic[rr] ? 8 : b;
            if (MODE == 1 || MODE == 3) {
                const int pl = (MODE == 1) ? layer - 1 : 1;
                const float* g2 = MOD + ((size_t)pl * 9 + r9) * 6144 + 5120;
#pragma unroll
                for (int i = 0; i < 4; ++i) { const int c = 256 * i + 4 * lane; const f32x4 gv = *(const f32x4*)(g2 + c); const u32x2 a = ya[rr][i], b2 = yb[rr][i];
                    x[rr][i][0] += gv[0] * (bflo(a.x) + bflo(b2.x)); x[rr][i][1] += gv[1] * (bfhi(a.x) + bfhi(b2.x)); x[rr][i][2] += gv[2] * (bflo(a.y) + bflo(b2.y)); x[rr][i][3] += gv[3] * (bfhi(a.y) + bfhi(b2.y)); }
                if (MODE == 1 && !dry) { float* dstx = ic[rr] ? CTXS + ctx_off(b, t) : p.out + lat_off(b, t);
#pragma unroll
                    for (int i = 0; i < 4; ++i) *(f32x4*)(dstx + 256 * i + 4 * lane) = x[rr][i]; }
            }
            float ss = 0.f;
#pragma unroll
            for (int i = 0; i < 4; ++i) ss += x[rr][i][0] * x[rr][i][0] + x[rr][i][1] * x[rr][i][1] + x[rr][i][2] * x[rr][i][2] + x[rr][i][3] * x[rr][i][3];
            ss = wave_sum(ss, lane);
            const float rstd = rsqrtf(ss * (1.0f / 1024.0f) + 1e-6f);
            if (MODE == 3) {
#pragma unroll
                for (int i = 0; i < 4; ++i) { const int c = 256 * i + 4 * lane; const f32x4 g = *(const f32x4*)(p.in[25] + c);
                    if (!dry) *(f32x4*)(p.out + lat_off(b, t) + c) = x[rr][i] * rstd * g; }
            } else {
                const float* gain = p.in[6] + layer * 1024;
                const float* mrow = MOD + ((size_t)layer * 9 + r9) * 6144;
#pragma unroll
                for (int i = 0; i < 4; ++i) { const int c = 256 * i + 4 * lane; const f32x4 g = *(const f32x4*)(gain + c), sh = *(const f32x4*)(mrow + c), sc = *(const f32x4*)(mrow + 1024 + c);
                    const f32x4 h = (x[rr][i] * rstd * g) * (sc + 1.0f) + sh;
                    u32x2 w; w.x = cvt_pk_bf16(h[0], h[1]); w.y = cvt_pk_bf16(h[2], h[3]); *(u32x2*)(H + (size_t)R * 1024 + c) = w; }
            }
        }
    }
}

__device__ __forceinline__ void norm2_router(KP p, int layer, LAS unsigned char* lds, bool dry) {
    (void)dry;
    unsigned char* ws = p.ws; const int tid_ = tid_fresh(); const int lane = tid_ & 63, wid = tid_ >> 6, fr = lane & 15, fq = lane >> 4;
    const float* MOD = (const float*)(ws + OFF_MOD); const float* CTXS = (const float*)(ws + OFF_CTXS); bf16_t* H = (bf16_t*)(ws + OFF_H);
    const bf16_t* WH = (const bf16_t*)(ws + OFF_WR) + (size_t)layer * 2 * 48 * 1024; const bf16_t* WL = WH + 48 * 1024;
    LAS float* ssp = (LAS float*)lds;
    LAS float* part = (LAS float*)(lds + 512);
    LAS float* lgf = (LAS float*)(lds + 512 + 8 * 16 * 48 * 4);
    LAS unsigned* lcnt = (LAS unsigned*)(lds + 512 + 8 * 16 * 48 * 4 + 16 * 48 * 4);
    __syncthreads();
    if (tid_ < 64) lcnt[tid_] = 0u;
    __syncthreads();
    const float* gain = p.in[7] + layer * 1024;
    const int cw = 128 * wid + 8 * fq;
    const int ntask = TALL / 16;
    auto xrow = [&](int task) -> const float* { const int R0 = task * 16; const int b = R0 / TB, t = R0 - b * TB; return (t < NCTX ? CTXS + ctx_off(b, t + fr) : p.out + lat_off(b, t + fr)) + cw; };
    auto skip = [&](int task) -> bool { return layer == 1 && ((task * 16) % TB) < NCTX; };
    f32x4 xn[4][2];
    int task = blockIdx.x; while (task < ntask && skip(task)) task += gridDim.x;
    if (task < ntask) { const float* src = xrow(task);
#pragma unroll
        for (int s2 = 0; s2 < 4; ++s2) { xn[s2][0] = *(const f32x4*)(src + 32 * s2); xn[s2][1] = *(const f32x4*)(src + 32 * s2 + 4); } }
    while (task < ntask) {
        const int R0 = task * 16; const int b = R0 / TB, t = R0 - b * TB; const bool isctx = t < NCTX; const int r9 = isctx ? 8 : b;
        f32x4 x[4][2];
#pragma unroll
        for (int s2 = 0; s2 < 4; ++s2) { x[s2][0] = xn[s2][0]; x[s2][1] = xn[s2][1]; }
        int nxt = task + gridDim.x; while (nxt < ntask && skip(nxt)) nxt += gridDim.x;
        if (nxt < ntask) { const float* src = xrow(nxt);
#pragma unroll
            for (int s2 = 0; s2 < 4; ++s2) { xn[s2][0] = *(const f32x4*)(src + 32 * s2); xn[s2][1] = *(const f32x4*)(src + 32 * s2 + 4); } }
        float ss = 0.f;
#pragma unroll
        for (int s2 = 0; s2 < 4; ++s2) { const f32x4 a = x[s2][0], c = x[s2][1]; ss += a[0] * a[0] + a[1] * a[1] + a[2] * a[2] + a[3] * a[3] + c[0] * c[0] + c[1] * c[1] + c[2] * c[2] + c[3] * c[3]; }
        ss += sx(ss, 16, lane); ss += sx(ss, 32, lane);
        if (fq == 0) ssp[wid * 16 + fr] = ss;
        __syncthreads();
        float tot = 0.f;
#pragma unroll
        for (int w2 = 0; w2 < 8; ++w2) tot += ssp[w2 * 16 + fr];
        const float rstd = rsqrtf(tot * (1.0f / 1024.0f) + 1e-6f);
        const float* mrow = MOD + ((size_t)layer * 9 + r9) * 6144 + 3072 + cw;
        const float* grow = gain + cw;
        bf16_t* hrow = H + (size_t)(R0 + fr) * 1024 + cw;
        f32x4 acc[3];
#pragma unroll
        for (int nb = 0; nb < 3; ++nb) acc[nb] = (f32x4){0.f, 0.f, 0.f, 0.f};
#pragma unroll
        for (int s2 = 0; s2 < 4; ++s2) {
            const int c = 32 * s2;
            const f32x4 g0 = *(const f32x4*)(grow + c), g1 = *(const f32x4*)(grow + c + 4);
            const f32x4 sh0 = *(const f32x4*)(mrow + c), sh1 = *(const f32x4*)(mrow + c + 4), sc0 = *(const f32x4*)(mrow + 1024 + c), sc1 = *(const f32x4*)(mrow + 1024 + c + 4);
            const f32x4 h0 = (x[s2][0] * rstd * g0) * (sc0 + 1.0f) + sh0, h1 = (x[s2][1] * rstd * g1) * (sc1 + 1.0f) + sh1;
            u32x4 hw; hw.x = cvt_pk_bf16(h0[0], h0[1]); hw.y = cvt_pk_bf16(h0[2], h0[3]); hw.z = cvt_pk_bf16(h1[0], h1[1]); hw.w = cvt_pk_bf16(h1[2], h1[3]);
            *(u32x4*)(hrow + c) = hw;
            u32x4 lw; lw.x = cvt_pk_bf16(h0[0] - bflo(hw.x), h0[1] - bfhi(hw.x)); lw.y = cvt_pk_bf16(h0[2] - bflo(hw.y), h0[3] - bfhi(hw.y));
            lw.z = cvt_pk_bf16(h1[0] - bflo(hw.z), h1[1] - bfhi(hw.z)); lw.w = cvt_pk_bf16(h1[2] - bflo(hw.w), h1[3] - bfhi(hw.w));
            const bf16x8 ahi = __builtin_bit_cast(bf16x8, hw), alo = __builtin_bit_cast(bf16x8, lw);
#pragma unroll
            for (int nb = 0; nb < 3; ++nb) {
                const bf16x8 bhi = *(const bf16x8*)(WH + (size_t)(16 * nb + fr) * 1024 + cw + c), blo = *(const bf16x8*)(WL + (size_t)(16 * nb + fr) * 1024 + cw + c);
                acc[nb] = __builtin_amdgcn_mfma_f32_16x16x32_bf16(ahi, bhi, acc[nb], 0, 0, 0);
                acc[nb] = __builtin_amdgcn_mfma_f32_16x16x32_bf16(alo, bhi, acc[nb], 0, 0, 0);
                acc[nb] = __builtin_amdgcn_mfma_f32_16x16x32_bf16(ahi, blo, acc[nb], 0, 0, 0);
            }
        }
#pragma unroll
        for (int nb = 0; nb < 3; ++nb)
#pragma unroll
            for (int jj = 0; jj < 4; ++jj) part[(wid * 16 + 4 * fq + jj) * 48 + 16 * nb + fr] = acc[nb][jj];
        __syncthreads();
        for (int e = tid_; e < 16 * 48; e += 512) { float sm = 0.f;
#pragma unroll
            for (int w2 = 0; w2 < 8; ++w2) sm += part[w2 * 16 * 48 + e];
            lgf[e] = sm; }
        __syncthreads();
        if (tid_ < 16) {
            const LAS float* a = lgf + tid_ * 48; const int R = R0 + tid_;
            const float* bg = p.in[19] + layer * 4; const float* be = p.in[21] + layer * 32;
            float gl[4];
#pragma unroll
            for (int j = 0; j < 4; ++j) gl[j] = a[j] + bg[j];
            int grp = 0; float gm = gl[0];
#pragma unroll
            for (int j = 1; j < 4; ++j) if (gl[j] > gm) { gm = gl[j]; grp = j; }
            float den = 0.f;
#pragma unroll
            for (int j = 0; j < 4; ++j) den += expf(gl[j] - gm);
            const float gp = 1.0f / den;
            float v1 = -3.0e38f, v2 = -3.0e38f; int i1 = 0, i2 = 0;
#pragma unroll
            for (int j = 0; j < 8; ++j) { const float lv = a[4 + grp * 8 + j] + be[grp * 8 + j];
                if (lv > v1) { v2 = v1; i2 = i1; v1 = lv; i1 = j; } else if (lv > v2) { v2 = lv; i2 = j; } }
            const float e2 = expf(v2 - v1); const float w1 = gp / (1.0f + e2), w2 = gp * e2 / (1.0f + e2);
            const int ex1 = grp * 8 + i1, ex2 = grp * 8 + i2;
            const unsigned r1 = __hip_atomic_fetch_add(lcnt + ex1, 1u, __ATOMIC_RELAXED, __HIP_MEMORY_SCOPE_WORKGROUP), r2 = __hip_atomic_fetch_add(lcnt + ex2, 1u, __ATOMIC_RELAXED, __HIP_MEMORY_SCOPE_WORKGROUP);
            int* EX = (int*)(ws + OFF_EXPID); float* GW = (float*)(ws + OFF_GATEW); int* RK = (int*)(ws + OFF_RANK);
            EX[R * 2] = ex1; EX[R * 2 + 1] = ex2; GW[R * 2] = w1; GW[R * 2 + 1] = w2; RK[R * 2] = (int)r1; RK[R * 2 + 1] = (int)r2;
        }
        task = nxt;
    }
    __syncthreads();
    if (tid_ < 32) { unsigned* cnt = (unsigned*)(ws + OFF_CNT) + layer * 32; const unsigned c = lcnt[tid_]; lcnt[32 + tid_] = c ? atomicAdd(cnt + tid_, c) : 0u; }
    __syncthreads();
    if (tid_ < 16) {
        int* EX = (int*)(ws + OFF_EXPID); int* RK = (int*)(ws + OFF_RANK);
        for (int tk = blockIdx.x; tk < ntask; tk += gridDim.x) {
            if (skip(tk)) continue;
            const int R = tk * 16 + tid_;
            RK[R * 2] += (int)lcnt[32 + EX[R * 2]]; RK[R * 2 + 1] += (int)lcnt[32 + EX[R * 2 + 1]];
        }
    }
}

__device__ __forceinline__ void moe_table(KP p, int layer, LAS int* tab) {
    if (tid_fresh() == 0) {
        const unsigned* cnt = (const unsigned*)(p.ws + OFF_CNT) + layer * 32; int s = 0, tl = 0;
        for (int e = 0; e < 32; ++e) { const int c = (int)__hip_atomic_load(cnt + e, __ATOMIC_RELAXED, __HIP_MEMORY_SCOPE_AGENT); tab[e] = c; tab[32 + e] = s; tab[64 + e] = tl; s += c; tl += (c + 255) >> 8; }
        tab[96] = tl;
    }
    __syncthreads();
}
__device__ __forceinline__ void dispatch_phase(KP p, int layer, LAS int* tab) {
    unsigned char* ws = p.ws; const int tid_ = tid_fresh();
    moe_table(p, layer, tab);
    const int* EX = (const int*)(ws + OFF_EXPID); const float* GW = (const float*)(ws + OFF_GATEW); const int* RK = (const int*)(ws + OFF_RANK);
    int* TOKSL = (int*)(ws + OFF_TOKSL); float* SLOTW = (float*)(ws + OFF_SLOTW); int* SLOTTOK = (int*)(ws + OFF_SLOTTOK);
    for (int idx = blockIdx.x * 512 + tid_; idx < TALL * 2; idx += gridDim.x * 512) {
        const int R = idx >> 1;
        if (layer == 1 && (R % TB) < NCTX) continue;
        const int slot = tab[32 + EX[idx]] + RK[idx];
        TOKSL[idx] = slot; SLOTW[slot] = GW[idx]; SLOTTOK[slot] = R;
    }
}
__device__ __forceinline__ void moe_tok_table(KP p, const LAS int* tab, LAS int* tok) {
    const int tid_ = tid_fresh(); const int* SLOTTOK = (const int*)(p.ws + OFF_SLOTTOK);
    LAS int* uinf = tok + 22 * 256;
    const int ntile = tab[96];
    if (tid_ < 22) {
        const int L = tid_ * (int)gridDim.x + (int)blockIdx.x; int s0 = -1, vl = 0;
        if (L < ntile * 8) { const int tg = L >> 3; int e = 0;
#pragma unroll 1
            for (int j = 1; j < 32; ++j) e = (tab[64 + j] <= tg) ? j : e;
            const int mt = tg - tab[64 + e]; s0 = tab[32 + e] + 256 * mt; vl = tab[e] - 256 * mt; }
        uinf[2 * tid_] = s0; uinf[2 * tid_ + 1] = vl;
    }
    __syncthreads();
    int tv[11];
#pragma unroll
    for (int k = 0; k < 11; ++k) { const int j = tid_ + 512 * k; const int i = j >> 8, r = j & 255; const int s0 = uinf[2 * i], vl = uinf[2 * i + 1];
        tv[k] = SLOTTOK[s0 >= 0 ? s0 + (r < vl ? r : 0) : 0]; }
#pragma unroll
    for (int k = 0; k < 11; ++k) { const int j = tid_ + 512 * k; if (uinf[2 * (j >> 8)] >= 0) tok[j] = tv[k]; }
    __syncthreads();
}

__device__ __forceinline__ void gate_phase(KP p, int layer, int g, LAS unsigned char* lds) {
    unsigned char* reg = p.ws + OFF_REG; const int tid = tid_fresh();
    const bf16_t* GQK = (const bf16_t*)(reg + R_GQK); bf16_t* GIN = (bf16_t*)(reg + R_GIN); float* GDEC = (float*)(reg + R_GDEC); const float* GLR = (const float*)(reg + R_GLR);
    LAS float* lr = (LAS float*)lds;
    const float* wa = p.in[9] + (size_t)layer * 2 * 16 * 512; const float* ba = p.in[10] + layer * 2 * 512;
    for (int u = blockIdx.x; u < BG * NCH * 2; u += gridDim.x) {
        const int dir = u & 1, rest = u >> 1, bl = rest / NCH, ch = rest - bl * NCH; const int r0 = bl * TB + ch * CH;
        float w[16];
#pragma unroll
        for (int r = 0; r < 16; ++r) w[r] = wa[(dir * 16 + r) * 512 + tid] * LOG2E;
        const float bav = ba[dir * 512 + tid] * LOG2E;
        __syncthreads();
        for (int e = tid; e < 64 * 16; e += 512) lr[e] = GLR[(size_t)(r0 + (e >> 4)) * 32 + dir * 16 + (e & 15)];
        __syncthreads();
        bf16_t* GO = GIN + (size_t)dir * TG * 1024;
        float cum = 0.f;
#pragma unroll 1
        for (int hh = 0; hh < 2; ++hh) {
            unsigned short qv[32], kv[32];
#pragma unroll
            for (int s2 = 0; s2 < 32; ++s2) { const int st = hh * 32 + s2; const int j = dir ? CH - 1 - st : st; const size_t ro = (size_t)(r0 + j) * 1024; qv[s2] = GQK[ro + tid]; kv[s2] = GQK[ro + 512 + tid]; }
#pragma unroll
            for (int s2 = 0; s2 < 32; ++s2) {
                const int st = hh * 32 + s2; const int j = dir ? CH - 1 - st : st;
                const LAS f32x4* l4 = (const LAS f32x4*)(lr + j * 16);
                const f32x4 a0 = l4[0], a1 = l4[1], a2 = l4[2], a3 = l4[3];
                float z = bav;
                z += a0[0] * w[0] + a0[1] * w[1] + a0[2] * w[2] + a0[3] * w[3] + a1[0] * w[4] + a1[1] * w[5] + a1[2] * w[6] + a1[3] * w[7]
                   + a2[0] * w[8] + a2[1] * w[9] + a2[2] * w[10] + a2[3] * w[11] + a3[0] * w[12] + a3[1] * w[13] + a3[2] * w[14] + a3[3] * w[15];
                const float la = -(fmaxf(-z, 0.f) + __builtin_amdgcn_logf(1.0f + __builtin_amdgcn_exp2f(-fabsf(z)))) * (1.0f / 16.0f);
                cum += la; const float e = __builtin_amdgcn_exp2f(cum), ei = __builtin_amdgcn_exp2f(-cum);
                const size_t ro = (size_t)(r0 + j) * 1024;
                GO[ro + tid] = f2bf(bf2f(qv[s2]) * e); GO[ro + 512 + tid] = f2bf(bf2f(kv[s2]) * ei);
            }
        }
        GDEC[((size_t)(dir * BG + bl) * NCH + ch) * 512 + tid] = __builtin_amdgcn_exp2f(cum);
    }
}
__device__ __forceinline__ void stats_phase(KP p, int g, bool dry) {
    unsigned char* reg = p.ws + OFF_REG; const int tid_ = tid_fresh(); const int lane = tid_ & 63, wid = tid_ >> 6;
    f32x2* ST = (f32x2*)(p.ws + OFF_STATS);
    const int stride = gridDim.x * 8;
    for (int R0 = blockIdx.x * 8 + wid; R0 < TG; R0 += 2 * stride) {
        const int R1 = R0 + stride; const bool two = R1 < TG; const int R1c = two ? R1 : R0;
        u32x2 av[2][2][4], bv[2][2][4];
#pragma unroll
        for (int rr = 0; rr < 2; ++rr)
#pragma unroll
            for (int mix = 0; mix < 2; ++mix) {
                const bf16_t* of = (const bf16_t*)(reg + (mix ? R_ORF : R_OGF)) + (size_t)(rr ? R1c : R0) * 1024; const bf16_t* ob = (const bf16_t*)(reg + (mix ? R_ORB : R_OGB)) + (size_t)(rr ? R1c : R0) * 1024;
#pragma unroll
                for (int i = 0; i < 4; ++i) { av[rr][mix][i] = *(const u32x2*)(of + 256 * i + 4 * lane); bv[rr][mix][i] = *(const u32x2*)(ob + 256 * i + 4 * lane); }
            }
#pragma unroll
        for (int rr = 0; rr < 2; ++rr) {
            if (rr == 1 && !two) break;
            const int R = rr ? R1 : R0;
#pragma unroll
            for (int mix = 0; mix < 2; ++mix) {
                bf16_t* of = (bf16_t*)(reg + (mix ? R_ORF : R_OGF)) + (size_t)R * 1024;
#pragma unroll
                for (int i = 0; i < 4; ++i) {
                    const int c = 256 * i + 4 * lane; const u32x2 a = av[rr][mix][i], b2 = bv[rr][mix][i];
                    const float o0 = bflo(a.x) + bflo(b2.x), o1 = bfhi(a.x) + bfhi(b2.x), o2 = bflo(a.y) + bflo(b2.y), o3 = bfhi(a.y) + bfhi(b2.y);
                    const float mean = wave_sum(o0 + o1 + o2 + o3, lane) * (1.0f / 256.0f);
                    const float d0 = o0 - mean, d1 = o1 - mean, d2 = o2 - mean, d3 = o3 - mean;
                    const float var = wave_sum(d0 * d0 + d1 * d1 + d2 * d2 + d3 * d3, lane) * (1.0f / 256.0f);
                    u32x2 w; w.x = cvt_pk_bf16(o0, o1); w.y = cvt_pk_bf16(o2, o3); if (!dry) *(u32x2*)(of + c) = w;
                    if (lane == 0) ST[((size_t)mix * TG + R) * 4 + i] = (f32x2){mean, rsqrtf(var + 1e-6f)};
                }
            }
        }
    }
}

#if 1
__device__ __forceinline__ void scan_naive(KP p, int layer, int g, LAS unsigned char* lds) {
    unsigned char* reg = p.ws + OFF_REG; const int tid = tid_fresh(), sub = tid >> 8, e = tid & 255;
    LAS float* sh = (LAS float*)lds + sub * 512;
    for (int u = blockIdx.x; u < 32; u += gridDim.x) {
        const int chain = u * 2 + sub; const int dir = chain & 1, h = (chain >> 1) & 3, bl = (chain >> 3) & 3, mix = chain >> 5;
        if (!SCAN_E1 && ((SCAN_MASK >> (mix * 2 + dir)) & 1)) continue;
        const bf16_t* QK = (const bf16_t*)(reg + (mix ? R_RQK : R_GQK)); const bf16_t* VT = (const bf16_t*)(reg + (mix ? R_RVT : R_GVT));
        bf16_t* O = (bf16_t*)(reg + (mix ? (dir ? R_ORB : R_ORF) : (dir ? R_OGB : R_OGF)));
        const float* GLR = (const float*)(reg + R_GLR);
        float wa[16]; float bav = 0.f;
        if (e < 128) {
#pragma unroll
            for (int r = 0; r < 16; ++r) wa[r] = p.in[9][(((size_t)layer * 2 + dir) * 16 + r) * 512 + h * 128 + e];
            bav = p.in[10][((size_t)layer * 2 + dir) * 512 + h * 128 + e];
        }
        const float gam = 1.0f - exp2f(-5.0f - (float)h);
        float S[128];
#pragma unroll
        for (int d = 0; d < 128; ++d) S[d] = 0.f;
        const bf16_t* vrow = VT + ((size_t)bl * 1024 + h * 256 + e) * TB;
        for (int s = 0; s < TB; ++s) {
            const int t = dir == 0 ? s : (s < NCTX ? NCTX - 1 - s : TB - 1 - (s - NCTX));
            const size_t ro = (size_t)(bl * TB + t);
            __syncthreads();
            if (e < 128) {
                sh[e] = bf2f(QK[ro * 1024 + h * 128 + e]); sh[128 + e] = bf2f(QK[ro * 1024 + 512 + h * 128 + e]);
                float a;
                if (mix == 0) { float z = bav;
#pragma unroll
                    for (int r = 0; r < 16; ++r) z += GLR[ro * 32 + dir * 16 + r] * wa[r];
                    a = expf(-(fmaxf(-z, 0.f) + log1pf(expf(-fabsf(z)))) * (1.0f / 16.0f)); }
                else a = gam;
                sh[256 + e] = a;
            }
            __syncthreads();
            const float v = bf2f(vrow[t]);
            float o = 0.f;
            if (dir == 0) {
#pragma unroll
                for (int d = 0; d < 128; ++d) { S[d] = sh[256 + d] * S[d] + sh[128 + d] * v; o += sh[d] * S[d]; }
            } else {
#pragma unroll
                for (int d = 0; d < 128; ++d) { const float sd = sh[256 + d] * S[d]; o += sh[d] * sd; S[d] = sd + sh[128 + d] * v; }
            }
            O[ro * 1024 + h * 256 + e] = f2bf(o);
        }
    }
}
#endif


#if 1
constexpr int SC_QS = 272, SC_VS = 144;
constexpr int SC_QB = 0, SC_KB = SC_QB + 2 * 64 * SC_QS, SC_VB = SC_KB + 2 * 64 * SC_QS, SC_ST = SC_VB + 2 * 64 * SC_VS,
              SC_DEC = SC_ST + 2 * 64 * SC_QS, SC_SCL = SC_DEC + 2 * 128 * 4, SC_END = SC_SCL + 128 * 4, SC_PB = 132096, SC_OB = SC_PB + 64 * SC_VS;
static_assert(SC_OB + 64 * SC_VS <= LDS_BYTES, "scan LDS tail");
static_assert(SC_END <= 131072, "scan LDS");
__device__ __forceinline__ u32x4 scale8(u32x4 v, float s) {
    u32x4 r; r.x = cvt_pk_bf16(bflo(v.x) * s, bfhi(v.x) * s); r.y = cvt_pk_bf16(bflo(v.y) * s, bfhi(v.y) * s); r.z = cvt_pk_bf16(bflo(v.z) * s, bfhi(v.z) * s); r.w = cvt_pk_bf16(bflo(v.w) * s, bfhi(v.w) * s); return r;
}
__device__ __forceinline__ void scan_mfma(KP p, int layer, int g, LAS unsigned char* lds, bool cmp_mode) {
    unsigned char* reg = p.ws + OFF_REG; const int tid = tid_fresh(), wid = tid >> 6, lane = tid & 63, fr = lane & 15, fq = lane >> 4;
#if SCAN_DELAY
    { const long long t0_ = clock64(); while (clock64() - t0_ < 4000000ll) __builtin_amdgcn_s_sleep(8); }
#endif
    for (int u = blockIdx.x; u < 256; u += gridDim.x) {
        const int dvq = (u >> 3) & 3, chain = (u & 7) + 8 * (u >> 5); const int dir = chain & 1, h = (chain >> 1) & 3, bl = (chain >> 3) & 3, mix = chain >> 5;
        if (!((SCAN_MASK >> (mix * 2 + dir)) & 1)) continue;
        const bf16_t* QI; const bf16_t* KI;
        if (mix == 0) { QI = (const bf16_t*)(reg + R_GIN) + (size_t)dir * TG * 1024; KI = QI + 512; } else { QI = (const bf16_t*)(reg + R_RQK); KI = QI + 512; }
        const bf16_t* VT = (const bf16_t*)(reg + (mix ? R_RVT : R_GVT)) + ((size_t)bl * 1024 + h * 256 + dvq * 64) * TB;
        bf16_t* O = (bf16_t*)(reg + (mix ? (dir ? R_ORB : R_ORF) : (dir ? R_OGB : R_OGF)));
        const float* GDEC = (const float*)(reg + R_GDEC) + ((size_t)(dir * BG + bl) * NCH) * 512 + h * 128;
        const float lam = logf(1.0f - exp2f(-5.0f - (float)h));
        __syncthreads();
        for (int e = tid; e < 2 * 64 * SC_QS / 16; e += 512) *(LAS u32x4*)(lds + SC_ST + e * 16) = (u32x4){0u, 0u, 0u, 0u};
        __syncthreads();
        const bool po = wid < 4; const int wq = wid & 3, t2_ = tid & 255;
        const int jb2 = 2 * (wq & 1), ib2 = 2 * (wq >> 1);
        const int db2 = 2 * wq;
        f32x4 R[8];
#pragma unroll
        for (int x = 0; x < 8; ++x) R[x] = (f32x4){0.f, 0.f, 0.f, 0.f};
        const int qrow0 = t2_ >> 4, qc8 = t2_ & 15;
        const int ve = t2_ >> 3, vj8 = t2_ & 7;
        u32x4 rq[4], rk[4], rv[2]; float rdec = 0.f;
        const float rdecay = expf(64.0f * lam);
        auto chunk_of = [&](int s) { return dir == 0 ? s : (s < 4 ? 3 - s : 131 - (s - 4)); };
        auto gload = [&](int ch) {
            const size_t r0 = (size_t)bl * TB + (size_t)ch * CH;
#pragma unroll
            for (int x = 0; x < 4; ++x) { const size_t ro = (r0 + qrow0 + 16 * x) * 1024 + h * 128 + qc8 * 8; rq[x] = *(const u32x4*)(QI + ro); rk[x] = *(const u32x4*)(KI + ro); }
#pragma unroll
            for (int x = 0; x < 2; ++x) rv[x] = *(const u32x4*)(VT + (size_t)(ve + 32 * x) * TB + ch * CH + vj8 * 8);
            const float gd = GDEC[(size_t)ch * 512 + (t2_ & 127)];
            rdec = mix ? rdecay : gd;
        };
        const float vs0 = mix ? expf(-(dir == 0 ? (float)(vj8 * 8 + 1) : (float)(64 - vj8 * 8)) * lam) : 1.0f;
        const float rr = mix ? expf(dir == 0 ? -lam : lam) : 1.0f; const float vs1 = vs0 * rr, rr2 = rr * rr;
        auto lstore = [&](int buf) {
#pragma unroll
            for (int x = 0; x < 4; ++x) {
                *(LAS u32x4*)(lds + SC_QB + buf * 64 * SC_QS + (qrow0 + 16 * x) * SC_QS + qc8 * 16) = rq[x];
                *(LAS u32x4*)(lds + SC_KB + buf * 64 * SC_QS + (qrow0 + 16 * x) * SC_QS + qc8 * 16) = rk[x]; }
#pragma unroll
            for (int x = 0; x < 2; ++x) { const u32x4 r = rv[x];
                float fa = vs0, fb = vs1; u32x4 v2; v2.x = cvt_pk_bf16(bflo(r.x) * fa, bfhi(r.x) * fb); fa *= rr2; fb *= rr2; v2.y = cvt_pk_bf16(bflo(r.y) * fa, bfhi(r.y) * fb); fa *= rr2; fb *= rr2;
                v2.z = cvt_pk_bf16(bflo(r.z) * fa, bfhi(r.z) * fb); fa *= rr2; fb *= rr2; v2.w = cvt_pk_bf16(bflo(r.w) * fa, bfhi(r.w) * fb);
                *(LAS u32x4*)(lds + SC_VB + buf * 64 * SC_VS + (ve + 32 * x) * SC_VS + vj8 * 16) = v2; }
            if (t2_ < 128) ((LAS float*)(lds + SC_DEC))[buf * 128 + t2_] = rdec;
        };
        if (!po) { gload(chunk_of(0)); lstore(0); gload(chunk_of(1)); }
        __syncthreads();
        float fo[2];
#pragma unroll
        for (int x = 0; x < 2; ++x) { const int i = 16 * (ib2 + x) + fr; fo[x] = mix ? expf((dir == 0 ? (float)(i + 1) : (float)(64 - i)) * lam) : 1.0f; }
        auto ostore = [&](int chp, int ob) {
            const size_t r0 = (size_t)bl * TB + (size_t)chp * CH;
#pragma unroll
            for (int k = 0; k < 2; ++k) { const int i = 32 * k + (t2_ >> 3);
                const u32x4 v = *(const LAS u32x4*)(lds + SC_PB + ob * 64 * SC_VS + i * SC_VS + (t2_ & 7) * 16);
                *(u32x4*)(O + (r0 + i) * 1024 + h * 256 + dvq * 64 + (t2_ & 7) * 8) = v; }
        };
        const int ebp = 2 * (wq & 1);
        for (int s = 0; s < NCH; ++s) {
            const int cur = s & 1, stb = s & 1;
            const LAS unsigned char* Qc = lds + SC_QB + cur * 64 * SC_QS; const LAS unsigned char* Kc = lds + SC_KB + cur * 64 * SC_QS; const LAS unsigned char* Vc = lds + SC_VB + cur * 64 * SC_VS;
            if (po) {
#pragma unroll
                for (int x = 0; x < 2; ++x)
#pragma unroll
                    for (int ks = 0; ks < 4; ++ks) R[4 * x + ks] = __builtin_bit_cast(f32x4, *(const LAS bf16x8*)(Qc + (16 * (ib2 + x) + fr) * SC_QS + ks * 64 + fq * 16));
                bf16x8 pb[2][2];
#pragma unroll
                for (int s2 = 0; s2 < 2; ++s2) {
                    bf16x8 kfr[2][4];
#pragma unroll
                    for (int y = 0; y < 2; ++y)
#pragma unroll
                        for (int ks = 0; ks < 4; ++ks) kfr[y][ks] = *(const LAS bf16x8*)(Kc + (16 * (2 * s2 + y) + fr) * SC_QS + ks * 64 + fq * 16);
                    __builtin_amdgcn_sched_barrier(0);
                    f32x4 c[2][2];
#pragma unroll
                    for (int y = 0; y < 2; ++y)
#pragma unroll
                        for (int x = 0; x < 2; ++x) c[y][x] = (f32x4){0.f, 0.f, 0.f, 0.f};
#pragma unroll
                    for (int ks = 0; ks < 4; ++ks)
#pragma unroll
                        for (int y = 0; y < 2; ++y)
#pragma unroll
                            for (int x = 0; x < 2; ++x) c[y][x] = __builtin_amdgcn_mfma_f32_16x16x32_bf16(kfr[y][ks], __builtin_bit_cast(bf16x8, R[4 * x + ks]), c[y][x], 0, 0, 0);
#pragma unroll
                    for (int x = 0; x < 2; ++x) { const int i = 16 * (ib2 + x) + fr; u32x4 w4;
#pragma unroll
                        for (int y = 0; y < 2; ++y) { const int j0 = 16 * (2 * s2 + y) + 4 * fq; float v[4];
#pragma unroll
                            for (int jj = 0; jj < 4; ++jj) { const int j = j0 + jj; const bool keep = dir == 0 ? (j <= i) : (j > i); v[jj] = keep ? c[y][x][jj] : 0.f; }
                            if (y == 0) { w4.x = cvt_pk_bf16(v[0], v[1]); w4.y = cvt_pk_bf16(v[2], v[3]); } else { w4.z = cvt_pk_bf16(v[0], v[1]); w4.w = cvt_pk_bf16(v[2], v[3]); } }
                        pb[x][s2] = __builtin_bit_cast(bf16x8, w4); }
                }
                bf16x8 va[2][2], st[2][4];
#pragma unroll
                for (int y = 0; y < 2; ++y)
#pragma unroll
                    for (int s2 = 0; s2 < 2; ++s2) {
                        const u32x2 lo = *(const LAS u32x2*)(Vc + (16 * (ebp + y) + fr) * SC_VS + (32 * s2 + 4 * fq) * 2), hi = *(const LAS u32x2*)(Vc + (16 * (ebp + y) + fr) * SC_VS + (32 * s2 + 16 + 4 * fq) * 2);
                        va[y][s2] = __builtin_bit_cast(bf16x8, (u32x4){lo.x, lo.y, hi.x, hi.y}); }
#pragma unroll
                for (int y = 0; y < 2; ++y)
#pragma unroll
                    for (int ks = 0; ks < 4; ++ks) st[y][ks] = *(const LAS bf16x8*)(lds + SC_ST + stb * 64 * SC_QS + (16 * (ebp + y) + fr) * SC_QS + ks * 64 + fq * 16);
                __builtin_amdgcn_sched_barrier(0);
                f32x4 co[2][2];
#pragma unroll
                for (int y = 0; y < 2; ++y)
#pragma unroll
                    for (int x = 0; x < 2; ++x) co[y][x] = (f32x4){0.f, 0.f, 0.f, 0.f};
#pragma unroll
                for (int ks = 0; ks < 4; ++ks)
#pragma unroll
                    for (int y = 0; y < 2; ++y)
#pragma unroll
                        for (int x = 0; x < 2; ++x) co[y][x] = __builtin_amdgcn_mfma_f32_16x16x32_bf16(st[y][ks], __builtin_bit_cast(bf16x8, R[4 * x + ks]), co[y][x], 0, 0, 0);
#pragma unroll
                for (int s2 = 0; s2 < 2; ++s2)
#pragma unroll
                    for (int y = 0; y < 2; ++y)
#pragma unroll
                        for (int x = 0; x < 2; ++x) co[y][x] = __builtin_amdgcn_mfma_f32_16x16x32_bf16(va[y][s2], pb[x][s2], co[y][x], 0, 0, 0);
#pragma unroll
                for (int y = 0; y < 2; ++y)
#pragma unroll
                    for (int x = 0; x < 2; ++x) { const f32x4 cc = co[y][x] * fo[x]; const int i = 16 * (ib2 + x) + fr;
                        u32x2 w; w.x = cvt_pk_bf16(cc[0], cc[1]); w.y = cvt_pk_bf16(cc[2], cc[3]);
                        *(LAS u32x2*)(lds + SC_PB + (s & 1) * 64 * SC_VS + i * SC_VS + (16 * (ebp + y) + 4 * fq) * 2) = w; }
            } else {
                if (s > 0) ostore(chunk_of(s - 1), (s - 1) & 1);
                bf16x8 ka[2][2], vb[2][4];
#pragma unroll
                for (int x = 0; x < 2; ++x)
#pragma unroll
                    for (int ks = 0; ks < 2; ++ks) {
                        typedef short s16x4_t __attribute__((ext_vector_type(4)));
                        const LAS unsigned char* tp = Kc + (32 * ks + 8 * fq + (fr >> 2)) * SC_QS + (16 * (db2 + x) + 4 * (fr & 3)) * 2;
                        const s16x4_t t0 = __builtin_amdgcn_ds_read_tr16_b64_v4i16((LAS s16x4_t*)tp), t1 = __builtin_amdgcn_ds_read_tr16_b64_v4i16((LAS s16x4_t*)(tp + 4 * SC_QS));
                        ka[x][ks] = (bf16x8){t0[0], t0[1], t0[2], t0[3], t1[0], t1[1], t1[2], t1[3]};
                    }
#pragma unroll
                for (int ks = 0; ks < 2; ++ks)
#pragma unroll
                    for (int eb = 0; eb < 4; ++eb) vb[ks][eb] = *(const LAS bf16x8*)(Vc + (16 * eb + fr) * SC_VS + ks * 64 + fq * 16);
                f32x4 dv[2];
#pragma unroll
                for (int x = 0; x < 2; ++x) dv[x] = *(const LAS f32x4*)(lds + SC_DEC + (cur * 128 + 16 * (db2 + x) + 4 * fq) * 4);
                __builtin_amdgcn_sched_barrier(0);
#pragma unroll
                for (int ks = 0; ks < 2; ++ks)
#pragma unroll
                    for (int x = 0; x < 2; ++x)
#pragma unroll
                        for (int eb = 0; eb < 4; ++eb) R[4 * x + eb] = __builtin_amdgcn_mfma_f32_16x16x32_bf16(ka[x][ks], vb[ks][eb], R[4 * x + eb], 0, 0, 0);
#pragma unroll
                for (int x = 0; x < 2; ++x)
#pragma unroll
                    for (int eb = 0; eb < 4; ++eb) { const f32x4 sv = R[4 * x + eb] * dv[x]; R[4 * x + eb] = sv;
                        u32x2 w; w.x = cvt_pk_bf16(sv[0], sv[1]); w.y = cvt_pk_bf16(sv[2], sv[3]);
                        *(LAS u32x2*)(lds + SC_ST + (stb ^ 1) * 64 * SC_QS + (16 * eb + fr) * SC_QS + (16 * (db2 + x) + 4 * fq) * 2) = w; }
                lstore(cur ^ 1);
                gload(chunk_of(s + 2 < NCH ? s + 2 : NCH - 1));
            }
            __syncthreads();
        }
        if (!po) ostore(chunk_of(NCH - 1), (NCH - 1) & 1);
    }
}
#endif

#if NAIVE_ATTN
__device__ __forceinline__ void attn_naive(KP p, int layer, int g, LAS unsigned char* lds) {
    unsigned char* reg = p.ws + OFF_REG; const int tid_ = tid_fresh(); const int lane = tid_ & 63, wid = tid_ >> 6;
    bf16_t* AQ = (bf16_t*)(reg + R_AQ); const bf16_t* AK = (const bf16_t*)(reg + R_AK); const bf16_t* AVT = (const bf16_t*)(reg + R_AVT);
    LAS float* qs = (LAS float*)lds + wid * 1024; LAS float* ps = qs + 128;
    for (int u = blockIdx.x; u < TG / 64; u += gridDim.x) {
#pragma unroll 1
        for (int pr = wid; pr < 512; pr += 8) {
            const int R = u * 64 + (pr >> 3), hq = pr & 7, hkv = hq >> 2; const int bl = R / TB, t = R - bl * TB;
            { const unsigned w = *(const unsigned*)(AQ + (size_t)R * 1024 + hq * 128 + 2 * lane); qs[2 * lane] = bflo(w); qs[2 * lane + 1] = bfhi(w); }
            const bool lat = t >= NCTX; const int i = t - NCTX;
            const int jlo = lat ? (i - 128 < 0 ? 0 : i - 128) : 0, jhi = lat ? (i + 128 > LSEQ - 1 ? LSEQ - 1 : i + 128) : -1;
            const float sink2 = p.in[12][layer * 8 + hq] * LOG2E;
            float mx = sink2;
#pragma unroll 1
            for (int rd = 0; rd < 9; ++rd) {
                int key; bool valid;
                if (rd < 4) { key = rd * 64 + lane; valid = true; } else { const int j = jlo + (rd - 4) * 64 + lane; key = NCTX + j; valid = j <= jhi; }
                float s = -3.0e38f;
                if (valid) { const bf16_t* kr = AK + (size_t)(bl * TB + key) * 256 + hkv * 128; s = 0.f;
#pragma unroll 4
                    for (int d8 = 0; d8 < 16; ++d8) { const u32x4 kv = *(const u32x4*)(kr + d8 * 8); const LAS float* q = qs + d8 * 8;
                        s += q[0] * bflo(kv.x) + q[1] * bfhi(kv.x) + q[2] * bflo(kv.y) + q[3] * bfhi(kv.y) + q[4] * bflo(kv.z) + q[5] * bfhi(kv.z) + q[6] * bflo(kv.w) + q[7] * bfhi(kv.w); } }
                ps[rd * 64 + lane] = s; mx = fmaxf(mx, s);
            }
            mx = wave_max(mx, lane);
            float sum = 0.f;
#pragma unroll 1
            for (int rd = 0; rd < 9; ++rd) { const float sv = ps[rd * 64 + lane]; const float pv = sv > -1.0e38f ? exp2f(sv - mx) : 0.f; ps[rd * 64 + lane] = pv; sum += pv; }
            sum = wave_sum(sum, lane) + exp2f(sink2 - mx);
            const float inv = 1.0f / sum;
            float o0 = 0.f, o1 = 0.f;
            const bf16_t* v0 = AVT + ((size_t)bl * 256 + hkv * 128 + 2 * lane) * TB; const bf16_t* v1 = v0 + TB;
#pragma unroll 4
            for (int k = 0; k < NCTX; ++k) { const float pv = ps[k]; o0 += pv * bf2f(v0[k]); o1 += pv * bf2f(v1[k]); }
#pragma unroll 4
            for (int j = jlo; j <= jhi; ++j) { const float pv = ps[256 + (j - jlo)]; o0 += pv * bf2f(v0[NCTX + j]); o1 += pv * bf2f(v1[NCTX + j]); }
            *(unsigned*)(AQ + (size_t)R * 1024 + hq * 128 + 2 * lane) = cvt_pk_bf16(o0 * inv, o1 * inv);
        }
    }
}
#endif


#if !NAIVE_ATTN
constexpr int AT_KS = 272, AT_VS = 144;
constexpr int AT_KB = 0, AT_VB = AT_KB + 2 * 64 * AT_KS, AT_END = AT_VB + 2 * 128 * AT_VS;
static_assert(AT_END <= 131072, "attn LDS");
__device__ __forceinline__ void attn_mfma(KP p, int layer, int g, LAS unsigned char* lds, bool to_spare) {
    unsigned char* reg = p.ws + OFF_REG; const int tid = tid_fresh(), wid = tid >> 6, lane = tid & 63, fr = lane & 15, fq = lane >> 4;
    bf16_t* AQ = (bf16_t*)(reg + R_AQ); const bf16_t* AK = (const bf16_t*)(reg + R_AK); const bf16_t* AVT = (const bf16_t*)(reg + R_AVT);
    const int nqb = layer == 1 ? NCH - 4 : NCH;
    const int nunits = BG * 2 * nqb;
    for (int it = 0;; ++it) {
        const int u = gridDim.x == 256 ? (it * 8 + (int)(blockIdx.x & 7)) * 32 + (int)(blockIdx.x >> 3) : it * (int)gridDim.x + (int)blockIdx.x;
        if (gridDim.x == 256 ? (it * 256 >= nunits) : (u >= nunits)) break;
        if (u >= nunits) continue;
        const int qblk = u < 1024 ? 4 + (u & 127) : (u & 3), hkv = u < 1024 ? (u >> 7) & 1 : (u >> 2) & 1, bl = u < 1024 ? u >> 8 : (u - 1024) >> 3;
        const int t0 = qblk * 64; const bool isctx = t0 < NCTX;
        const int hq = hkv * 4 + (wid >> 1); const int qoff = (wid & 1) * 32;
        const size_t qrow0 = (size_t)bl * TB + t0 + qoff;
        bf16x8 qf[2][4];
#pragma unroll
        for (int qb = 0; qb < 2; ++qb)
#pragma unroll
            for (int ks = 0; ks < 4; ++ks) qf[qb][ks] = *(const bf16x8*)(AQ + (qrow0 + 16 * qb + fr) * 1024 + hq * 128 + 32 * ks + 8 * fq);
        int mlo = 0, nloc = 0;
        if (!isctx) { mlo = (384 - t0) > 0 ? (384 - t0) / 64 : 0; int mhi = (TB + 64 - t0) / 64; mhi = mhi > 4 ? 4 : mhi; nloc = mhi - mlo + 1; }
        const int ntile = 4 + nloc;
        const float sink2 = p.in[12][layer * 8 + hq] * LOG2E;
        float mrun[2], lrun[2];
        mrun[0] = mrun[1] = sink2; lrun[0] = lrun[1] = (fq == 0) ? 1.0f : 0.0f;
        f32x4 oT[8][2];
#pragma unroll
        for (int db = 0; db < 8; ++db) { oT[db][0] = (f32x4){0.f, 0.f, 0.f, 0.f}; oT[db][1] = oT[db][0]; }
        const int krow = tid >> 4, kc = tid & 15;
        const int vrow = tid >> 3, vc = tid & 7;
        u32x4 rk[2], rv[2];
        auto tile_tok = [&](int ti) { return ti < 4 ? ti * 64 : t0 - 128 + 64 * (mlo + ti - 4); };
        auto gload = [&](int ti) {
            const int k0 = tile_tok(ti);
#pragma unroll
            for (int x = 0; x < 2; ++x) {
                rk[x] = *(const u32x4*)(AK + ((size_t)bl * TB + k0 + krow + 32 * x) * 256 + hkv * 128 + kc * 8);
                rv[x] = *(const u32x4*)(AVT + ((size_t)bl * 256 + hkv * 128 + vrow + 64 * x) * TB + k0 + vc * 8);
            }
        };
        auto lstore = [&](int buf) {
#pragma unroll
            for (int x = 0; x < 2; ++x) {
                *(LAS u32x4*)(lds + AT_KB + buf * 64 * AT_KS + (krow + 32 * x) * AT_KS + kc * 16) = rk[x];
                *(LAS u32x4*)(lds + AT_VB + buf * 128 * AT_VS + (vrow + 64 * x) * AT_VS + vc * 16) = rv[x];
            }
        };
        __syncthreads();
        gload(0); lstore(0);
        __syncthreads();
        for (int ti = 0; ti < ntile; ++ti) {
            const int cur = ti & 1;
            if (ti + 1 < ntile) gload(ti + 1);
            const LAS unsigned char* Kc = lds + AT_KB + cur * 64 * AT_KS; const LAS unsigned char* Vc = lds + AT_VB + cur * 128 * AT_VS;
            f32x4 sT[4][2];
#pragma unroll
            for (int kb = 0; kb < 4; ++kb) { sT[kb][0] = (f32x4){0.f, 0.f, 0.f, 0.f}; sT[kb][1] = sT[kb][0]; }
#pragma unroll
            for (int ks = 0; ks < 4; ++ks)
#pragma unroll
                for (int kb = 0; kb < 4; ++kb) { const bf16x8 a = *(const LAS bf16x8*)(Kc + (16 * kb + fr) * AT_KS + ks * 64 + fq * 16);
                    sT[kb][0] = __builtin_amdgcn_mfma_f32_16x16x32_bf16(a, qf[0][ks], sT[kb][0], 0, 0, 0);
                    sT[kb][1] = __builtin_amdgcn_mfma_f32_16x16x32_bf16(a, qf[1][ks], sT[kb][1], 0, 0, 0);
                    if (kb & 1) __builtin_amdgcn_sched_barrier(0); }
            if (ti >= 4) { const int m = mlo + ti - 4;
                if (m == 0 || m == 4) { const int k0 = tile_tok(ti);
#pragma unroll
                    for (int kb = 0; kb < 4; ++kb)
#pragma unroll
                        for (int qb = 0; qb < 2; ++qb)
#pragma unroll
                            for (int jj = 0; jj < 4; ++jj) { const int dt = (t0 + qoff + 16 * qb + fr) - (k0 + 16 * kb + 4 * fq + jj); if (dt > 128 || dt < -128) sT[kb][qb][jj] = -1.0e30f; } } }
            bf16x8 pb[2][2];
#pragma unroll
            for (int qb = 0; qb < 2; ++qb) {
                float tmax = -1.0e30f;
#pragma unroll
                for (int kb = 0; kb < 4; ++kb) tmax = fmaxf(tmax, fmaxf(fmaxf(sT[kb][qb][0], sT[kb][qb][1]), fmaxf(sT[kb][qb][2], sT[kb][qb][3])));
                tmax = fmaxf(tmax, sx(tmax, 16, lane)); tmax = fmaxf(tmax, sx(tmax, 32, lane));
                if (__any(tmax > mrun[qb] + 8.0f)) {
                    const float mnew_ = fmaxf(mrun[qb], tmax); const float alpha = __builtin_amdgcn_exp2f(mrun[qb] - mnew_); mrun[qb] = mnew_;
                    lrun[qb] = lrun[qb] * alpha;
#pragma unroll
                    for (int db = 0; db < 8; ++db) oT[db][qb] = oT[db][qb] * alpha;
                }
                const float mnew = mrun[qb];
                float psum = 0.f;
#pragma unroll
                for (int kb = 0; kb < 4; ++kb)
#pragma unroll
                    for (int jj = 0; jj < 4; ++jj) { const float pv = __builtin_amdgcn_exp2f(sT[kb][qb][jj] - mnew); psum += pv; sT[kb][qb][jj] = pv; }
                lrun[qb] = lrun[qb] + psum;
#pragma unroll
                for (int s2 = 0; s2 < 2; ++s2) { u32x4 w;
                    w.x = cvt_pk_bf16(sT[2 * s2][qb][0], sT[2 * s2][qb][1]); w.y = cvt_pk_bf16(sT[2 * s2][qb][2], sT[2 * s2][qb][3]);
                    w.z = cvt_pk_bf16(sT[2 * s2 + 1][qb][0], sT[2 * s2 + 1][qb][1]); w.w = cvt_pk_bf16(sT[2 * s2 + 1][qb][2], sT[2 * s2 + 1][qb][3]);
                    pb[qb][s2] = __builtin_bit_cast(bf16x8, w); }
            }
#pragma unroll
            for (int s2 = 0; s2 < 2; ++s2)
#pragma unroll
                for (int db = 0; db < 8; ++db) {
                    const u32x2 lo = *(const LAS u32x2*)(Vc + (16 * db + fr) * AT_VS + (32 * s2 + 4 * fq) * 2), hi = *(const LAS u32x2*)(Vc + (16 * db + fr) * AT_VS + (32 * s2 + 16 + 4 * fq) * 2);
                    const bf16x8 a = __builtin_bit_cast(bf16x8, (u32x4){lo.x, lo.y, hi.x, hi.y});
                    oT[db][0] = __builtin_amdgcn_mfma_f32_16x16x32_bf16(a, pb[0][s2], oT[db][0], 0, 0, 0);
                    oT[db][1] = __builtin_amdgcn_mfma_f32_16x16x32_bf16(a, pb[1][s2], oT[db][1], 0, 0, 0);
                    if (db & 1) __builtin_amdgcn_sched_barrier(0);
                }
            __syncthreads();
            if (ti + 1 < ntile) lstore(cur ^ 1);
            __syncthreads();
        }
#pragma unroll
        for (int qb = 0; qb < 2; ++qb) {
            float l = lrun[qb]; l += sx(l, 16, lane); l += sx(l, 32, lane);
            const float inv = 1.0f / l;
            bf16_t* orow = (to_spare ? (bf16_t*)(p.ws + WS_NEED) : AQ) + (qrow0 + 16 * qb + fr) * 1024 + hq * 128 + 4 * fq;
#pragma unroll
            for (int db = 0; db < 8; ++db) { const f32x4 v = oT[db][qb] * inv; u32x2 w; w.x = cvt_pk_bf16(v[0], v[1]); w.y = cvt_pk_bf16(v[2], v[3]); *(u32x2*)(orow + 16 * db) = w; }
        }
    }
}
#endif

__global__ void __launch_bounds__(512, 2) mega(Params pv) {
    extern __shared__ __attribute__((aligned(16))) unsigned char smem_raw[];
    LAS unsigned char* lds = (LAS unsigned char*)smem_raw;
    LAS unsigned* xbw = (LAS unsigned*)(lds + 131072);
    LAS int* tab = (LAS int*)(lds + 131072 + 256);
#if LDS_POISON
    for (int e = threadIdx.x; e < LDS_BYTES / 4; e += 512) ((LAS unsigned*)lds)[e] = 0x447A447Au;
    __syncthreads();
#endif
    if (threadIdx.x == 0) { xbw[0] = 0u; xbw[1] = 0u; xbw[2] = 0u; xbw[3] = 0u; }
    __syncthreads();
    KPS* kp = (KPS*)__builtin_amdgcn_kernarg_segment_ptr();
    const int ph0 = pv.ph0, ph1 = pv.ph1;
    XcdBarrier bar = xcd_barrier_post((unsigned*)(pv.ws + OFF_BAR), (volatile LAS unsigned*)xbw);
    int ph = 0;
#define PH_RUN(tag, ...) do { if (ph >= ph0 && ph < ph1 && PSEL_OK(tag)) { for (int rep_ = 0; rep_ < (((REP_MASK >> (tag)) & 1) ? REP_N : 1); ++rep_) { KPS* q_ = kp; asm volatile("" : "+s"(q_)); KP p = *q_; __VA_ARGS__ } } \
        if (ph >= ph0 && ph + 1 < ph1) xcd_barrier(bar); ++ph; } while (0)
    PH_RUN(0, prologue1(p, lds););
    PH_RUN(1, prologue2(p););
    for (int layer = 0; layer < 2; ++layer) {
        PH_RUN(2, const bool dry_ = rep_ + 1 < (((REP_MASK >> 2) & 1) ? REP_N : 1); if (layer == 0) norm_phase2<0>(p, 0, dry_); else norm_phase2<1>(p, 1, dry_););
        for (int g = 0; g < NGRP; ++g) {
            PH_RUN(3,
                unsigned char* ws = p.ws; const bf16_t* Hg = (const bf16_t*)(ws + OFF_H) + (size_t)g * TG * 1024; const bf16_t* WIN = (const bf16_t*)(ws + OFF_WINT) + (size_t)layer * WIN_ROWS * 1024;
                SchedDense S{}; S.A = Hg; S.B = WIN; S.lda = 1024; S.K = 1024; S.nM = TG / 256; S.nN = 23; S.nNb = 23; S.qkvswap = true;
                EpiQKV E{ws + OFF_REG, g, (const f32x2*)(ws + OFF_ATAB), (const f32x2*)(ws + OFF_RTAB), rep_ + 1 < (((REP_MASK >> 3) & 1) ? REP_N : 1)};
                g8::gemm_call(lds, S, E););
            PH_RUN(4, gate_phase(p, layer, g, lds););
                        PH_RUN(5, scan_mfma(p, layer, g, lds, false); __syncthreads(); attn_mfma(p, layer, g, lds, false););
            PH_RUN(7, stats_phase(p, g, false););
            PH_RUN(8,
                unsigned char* ws = p.ws; const bf16_t* Hg = (const bf16_t*)(ws + OFF_H) + (size_t)g * TG * 1024; const bf16_t* WIN = (const bf16_t*)(ws + OFF_WINT) + (size_t)layer * WIN_ROWS * 1024;
                SchedDense S{}; S.A = Hg; S.B = WIN + (size_t)5888 * 1024; S.lda = 1024; S.K = 1024; S.nM = layer == 1 ? 128 : TG / 256; S.nN = 8; S.nNb = 8; S.skipctx = layer == 1;
                EpiGateR E{ws + OFF_REG, (const f32x2*)(ws + OFF_STATS), p.in[11] + layer * 1024, p.in[13] + layer * 1024, rep_ + 1 < (((REP_MASK >> 8) & 1) ? REP_N : 1)};
                g8::gemm_call(lds, S, E););
            PH_RUN(9,
                unsigned char* ws = p.ws; unsigned char* reg = ws + OFF_REG;
                const bf16_t* Yb = (const bf16_t*)(reg + R_OGF); const bf16_t* WBb = (const bf16_t*)(ws + OFF_WBRT) + (size_t)layer * 3 * 1024 * 1024; const bf16_t* Hb = (const bf16_t*)(ws + OFF_H) + (size_t)g * TG * 1024;
                const bf16_t* WGb = (const bf16_t*)(ws + OFF_WINT) + (size_t)layer * WIN_ROWS * 1024 + (size_t)7936 * 1024; bf16_t* Zb = (bf16_t*)(reg + (g == 0 ? R_ZG0 : R_GQK));
                { SchedZGc S{Yb, WBb, Hb, WGb, 128, true}; EpiZGc E{Zb}; g8::gemm_call(lds, S, E); }
                if (layer == 0) { SchedZG S{Yb, WBb, Hb, WGb, BG, false, true}; EpiZG E{Zb, false}; g8::gemm_call(lds, S, E); });
        }
        PH_RUN(11,
            unsigned char* ws = p.ws;
            EpiOut E{layer == 0 ? p.in[0] : p.out, layer == 0 ? p.in[2] : (const float*)(ws + OFF_CTXS), p.out, (float*)(ws + OFF_CTXS), (const float*)(ws + OFF_MOD) + (size_t)layer * 9 * 6144, 0, false};
            for (int d_ = 0; d_ < (int)(blockIdx.x & 7); ++d_) __builtin_amdgcn_s_sleep(64);
            if (layer == 0) { SchedOut2 S{(const bf16_t*)(ws + OFF_REG + R_ZG0), (const bf16_t*)(ws + OFF_REG + R_GQK), (const bf16_t*)(ws + OFF_WO3T), false, 3072, true, false}; g8::gemm_call(lds, S, E); }
            { SchedOut2 S{(const bf16_t*)(ws + OFF_REG + R_ZG0), (const bf16_t*)(ws + OFF_REG + R_GQK), (const bf16_t*)(ws + OFF_WO1T) + (size_t)layer * 1024 * 1024, true, 1024, false, layer == 0}; g8::gemm_call(lds, S, E); });
        PH_RUN(13, moe_convert(p, layer, lds); __syncthreads(); norm2_router(p, layer, lds, false););
        PH_RUN(14, dispatch_phase(p, layer, tab););
        PH_RUN(15,
            unsigned char* ws = p.ws;
            moe_table(p, layer, tab);
            LAS int* tok = (LAS int*)(lds + 131072 + 1024);
            moe_tok_table(p, tab, tok);
            SchedMoeG S{(const bf16_t*)(ws + OFF_H), (const bf16_t*)(ws + OFF_REG + M_W13T), tab, tok};
            EpiMoe1 E{(bf16_t*)(ws + OFF_REG + M_HMID)};
            g8::gemm_call(lds, S, E););
        PH_RUN(16,
            unsigned char* ws = p.ws;
            moe_table(p, layer, tab);
            SchedMoe S{(const bf16_t*)(ws + OFF_REG + M_HMID), (const bf16_t*)(ws + OFF_REG + M_W2T), 1024, 1024, 4, 1024, tab};
            EpiMoe2 E{(bf16_t*)(ws + OFF_REG + M_XG), (const float*)(ws + OFF_SLOTW)};
            g8::gemm_call(lds, S, E););
    }
    PH_RUN(17, norm_phase2<3>(p, 1, rep_ + 1 < (((REP_MASK >> 17) & 1) ? REP_N : 1)););
#if BAR_PROBE
    if (ph1 - ph0 > 1) for (int i_ = 0; i_ < 100; ++i_) xcd_barrier(bar);
#endif
}
constexpr int N_PHASES = 2 + 2 * (1 + NGRP * 6 + 1 + 4) + 1;

extern "C" void kernel_launch(void* const* d_in, const int* in_sizes, int n_in, void* d_out, int out_size, void* d_ws, size_t ws_size, hipStream_t stream) {
    static int grid = 0;
    if (!grid) {
        int dev = 0, cus = 0, per_cu = 0;
        hipGetDevice(&dev);
        hipDeviceGetAttribute(&cus, hipDeviceAttributeMultiprocessorCount, dev);
        hipFuncSetAttribute((const void*)mega, hipFuncAttributeMaxDynamicSharedMemorySize, LDS_BYTES);
        hipOccupancyMaxActiveBlocksPerMultiprocessor(&per_cu, mega, 512, LDS_BYTES);
        grid = per_cu >= 1 ? cus : 0;
    }
    if (!grid || ws_size < WS_NEED || n_in < 26) { fprintf(stderr, "kernel_launch: cannot run (grid %d, ws %zu need %zu)\n", grid, ws_size, (size_t)WS_NEED); return; }
    hipMemsetAsync(d_ws, 0, ZERO_BYTES, stream);
    Params p{};
    for (int i = 0; i < 26; ++i) p.in[i] = (const float*)d_in[i];
    p.out = (float*)d_out; p.ws = (unsigned char*)d_ws;
#if MK_MULTI
    for (int ph = 0; ph < N_PHASES; ++ph) { p.ph0 = ph; p.ph1 = ph + 1; hipLaunchKernelGGL(mega, dim3(grid), dim3(512), LDS_BYTES, stream, p); }
#else
    p.ph0 = 0; p.ph1 = N_PHASES;
    hipLaunchKernelGGL(mega, dim3(grid), dim3(512), LDS_BYTES, stream, p);
#endif
}
```

```cpp
#include <hip/hip_runtime.h>
#include <stdint.h>
#include <stdio.h>

#ifndef MK_MULTI
#define MK_MULTI 0
#endif
#ifndef NAIVE_SCAN
#define NAIVE_SCAN 1
#endif
#ifndef SCAN_MASK
#define SCAN_MASK 15
#endif
#ifndef SCAN_E1
#define SCAN_E1 0
#endif
#ifndef E2_SEL
#define E2_SEL (layer == 1 && g == 0 && mix == 1 && ch == 126 && (u & 7) == 2)
#endif
#ifndef LDS_POISON
#define LDS_POISON 0
#endif
#ifndef SCAN_DELAY
#define SCAN_DELAY 0
#endif
#ifndef E2_KEY
#define E2_KEY (fminf(60000.0f, 100.0f * fmaxf(fmaxf(fabsf(c[0] - r0_), fabsf(c[1] - r1_)), fmaxf(fabsf(c[2] - r2_), fabsf(c[3] - r3_)))))
#endif
#ifndef REP_MASK
#define REP_MASK 0u
#define REP_N 3
#endif
#ifndef BAR_PROBE
#define BAR_PROBE 0
#endif
#ifndef NAIVE_ATTN
#define NAIVE_ATTN 0
#endif

#define LAS __attribute__((address_space(3)))
#ifndef PSEL
#define PSEL -1
#endif
#ifndef PMASK
#define PMASK 0xFFFFFFFFu
#endif
#define PSEL_OK(t) ((PSEL < 0 || PSEL == (t)) && ((PMASK >> (t)) & 1u))
typedef unsigned short bf16_t;
typedef short bf16x8 __attribute__((ext_vector_type(8)));
typedef float f32x4 __attribute__((ext_vector_type(4)));
typedef float f32x2 __attribute__((ext_vector_type(2)));
typedef unsigned u32x4 __attribute__((ext_vector_type(4)));
typedef unsigned u32x2 __attribute__((ext_vector_type(2)));

constexpr int D = 1024, NBATCH = 8, LSEQ = 8192, NCTX = 256, TB = 8448, TALL = 67584;
constexpr int NGRP = 2, BG = 4, TG = 33792;
constexpr int NIN = 10784, NE = 32;
constexpr int NSLOT = 2 * TALL;
constexpr int WIN_ROWS = 11008;
constexpr int CH = 64, NCH = TB / CH;
constexpr float LOG2E = 1.4426950408889634f;

constexpr size_t al(size_t x) { return (x + 4095) & ~(size_t)4095; }
constexpr size_t OFF_BAR   = 0;
constexpr size_t OFF_CNT   = 16384;
constexpr size_t ZERO_BYTES = 32768;
constexpr size_t OFF_MOD   = ZERO_BYTES;
constexpr size_t OFF_MODP  = OFF_MOD   + al((size_t)2 * 9 * 6144 * 4);
constexpr size_t OFF_ATAB  = OFF_MODP  + al((size_t)16 * 2 * 9 * 6144 * 4);
constexpr size_t OFF_RTAB  = OFF_ATAB  + al((size_t)128 * 32 * 8);
constexpr size_t OFF_WR    = OFF_RTAB  + al((size_t)TB * 64 * 8);
constexpr size_t OFF_CTXS  = OFF_WR    + al((size_t)2 * 2 * 48 * 1024 * 2);
constexpr size_t OFF_WINT  = OFF_CTXS  + al((size_t)8 * 256 * 1024 * 4);
constexpr size_t OFF_WBRT  = OFF_WINT  + al((size_t)2 * WIN_ROWS * 1024 * 2);
constexpr size_t OFF_WO3T  = OFF_WBRT  + al((size_t)2 * 3 * 1024 * 1024 * 2);
constexpr size_t OFF_WO1T  = OFF_WO3T  + al((size_t)2 * 1024 * 3072 * 2);
constexpr size_t OFF_EXPID = OFF_WO1T  + al((size_t)2 * 1024 * 1024 * 2);
constexpr size_t OFF_GATEW = OFF_EXPID + al((size_t)TALL * 2 * 4);
constexpr size_t OFF_RANK  = OFF_GATEW + al((size_t)TALL * 2 * 4);
constexpr size_t OFF_TOKSL = OFF_RANK  + al((size_t)TALL * 2 * 4);
constexpr size_t OFF_SLOTW = OFF_TOKSL + al((size_t)TALL * 2 * 4);
constexpr size_t OFF_SLOTTOK = OFF_SLOTW + al((size_t)(NSLOT + 256) * 4);
constexpr size_t OFF_STATS = OFF_SLOTTOK + al((size_t)(NSLOT + 256) * 4);
constexpr size_t OFF_H     = OFF_STATS + al((size_t)2 * TG * 4 * 8);
constexpr size_t OFF_REG   = OFF_H     + al((size_t)TALL * 1024 * 2);
constexpr size_t SZ_T1K = (size_t)TG * 1024 * 2;
constexpr size_t R_GQK  = 0;
constexpr size_t R_GIN  = R_GQK + SZ_T1K;
constexpr size_t R_GDEC = R_GIN + 2 * SZ_T1K;
constexpr size_t R_GVT  = R_GDEC + al((size_t)2 * BG * NCH * 512 * 4);
constexpr size_t R_GLR  = R_GVT + SZ_T1K;
constexpr size_t R_AK   = R_GLR + al((size_t)TG * 32 * 4);
constexpr size_t R_AVT  = R_AK + SZ_T1K / 4;
constexpr size_t R_RQK  = R_AVT + SZ_T1K / 4;
constexpr size_t R_RVT  = R_RQK + SZ_T1K;
constexpr size_t R_OGF  = R_RVT + SZ_T1K;
constexpr size_t R_AQ   = R_OGF + SZ_T1K;
constexpr size_t R_ORF  = R_AQ + SZ_T1K;
constexpr size_t R_OGB  = R_ORF + SZ_T1K;
constexpr size_t R_ORB  = R_OGB + SZ_T1K;
constexpr size_t R_ZG0  = R_ORB + SZ_T1K;
constexpr size_t R_MIX_END = R_ZG0 + 3 * SZ_T1K;
constexpr size_t M_W13T = 0;
constexpr size_t M_W2T  = M_W13T + (size_t)32 * 2048 * 1024 * 2;
constexpr size_t M_XG   = M_W2T + (size_t)32 * 1024 * 1024 * 2;
constexpr size_t M_HMID = M_XG + al((size_t)(NSLOT + 256) * 1024 * 2);
constexpr size_t M_END  = M_HMID + al((size_t)(NSLOT + 256) * 1024 * 2);
constexpr size_t REG_BYTES = R_MIX_END > M_END ? R_MIX_END : M_END;
constexpr size_t WS_NEED = OFF_REG + REG_BYTES;

constexpr int LDS_BYTES = 155648;

struct Params {
    const float* in[26];
    float* out;
    unsigned char* ws;
    int ph0, ph1;
};
typedef const __attribute__((address_space(4))) Params KPS;
typedef KPS& KP;

__device__ __forceinline__ bf16_t f2bf(float f) { unsigned u = __float_as_uint(f); u += 0x7FFFu + ((u >> 16) & 1u); return (bf16_t)(u >> 16); }
__device__ __forceinline__ float bf2f(unsigned b) { return __uint_as_float(b << 16); }
__device__ __forceinline__ float bflo(unsigned w) { return __uint_as_float(w << 16); }
__device__ __forceinline__ float bfhi(unsigned w) { return __uint_as_float(w & 0xFFFF0000u); }
typedef __bf16 bf16x2_t __attribute__((ext_vector_type(2)));
__device__ __forceinline__ unsigned cvt_pk_bf16(float lo, float hi) { const f32x2 v = (f32x2){lo, hi}; const bf16x2_t b = __builtin_convertvector(v, bf16x2_t); return __builtin_bit_cast(unsigned, b); }
__device__ __forceinline__ float sx(float v, int m, int lane) { return __int_as_float(__builtin_amdgcn_ds_bpermute((lane ^ m) << 2, __float_as_int(v))); }
__device__ __forceinline__ float wave_sum(float v, int lane) {
#pragma unroll
    for (int o = 32; o; o >>= 1) v += sx(v, o, lane);
    return v;
}
__device__ __forceinline__ float wave_max(float v, int lane) {
#pragma unroll
    for (int o = 32; o; o >>= 1) v = fmaxf(v, sx(v, o, lane));
    return v;
}
__device__ __forceinline__ int tid_fresh() { int t = threadIdx.x; asm volatile("" : "+v"(t)); return t; }
__device__ __forceinline__ int bid_fresh() { int t = blockIdx.x; asm volatile("" : "+s"(t)); return t; }
__device__ __forceinline__ float sigmoid_f(float x) { return __builtin_amdgcn_rcpf(1.0f + __builtin_amdgcn_exp2f(x * -LOG2E)); }
__device__ __forceinline__ float silu_f(float x) { return x * sigmoid_f(x); }

#define XB_TMO      128
#define XB_XCNT(j)  (256  + 64 * (j))
#define XB_XSUB(j)  (1280 + 64 * (j))
#define XB_XGEN(j)  (2304 + 64 * (j))
#define XB_TOP      3328
#define XB_TOPGEN   3392
#define XCD_BAR_WORDS 3456
#define XB_SPIN_CAP (1u << 18)

__device__ __forceinline__ unsigned xb_ld(unsigned* p)              { return __hip_atomic_load(p, __ATOMIC_RELAXED, __HIP_MEMORY_SCOPE_AGENT); }
__device__ __forceinline__ unsigned xb_add(unsigned* p, unsigned v) { return __hip_atomic_fetch_add(p, v, __ATOMIC_RELAXED, __HIP_MEMORY_SCOPE_AGENT); }
__device__ __forceinline__ unsigned xb_xcc_id() { return (unsigned)__builtin_amdgcn_s_getreg((3 << 11) | 20) & 0xFu; }
#define XB_SPIN(cond, bar) do { unsigned _sp = 0; while (cond) { __builtin_amdgcn_s_sleep(1); \
    if ((++_sp & 255u) == 0u) { if (xb_ld(&(bar)[XB_TMO])) break; if (_sp > XB_SPIN_CAP) { atomicAdd(&(bar)[XB_TMO], 1u); break; } } } } while (0)

struct XcdBarrier { unsigned* bar; unsigned x; volatile LAS unsigned* st; };

__device__ __forceinline__ XcdBarrier xcd_barrier_post(unsigned* bar, volatile LAS unsigned* st) {
    XcdBarrier b; b.bar = bar; b.x = xb_xcc_id(); b.st = st;
    if (threadIdx.x == 0) (void)xb_add(&bar[XB_XCNT(b.x)], 1u);
    return b;
}
__device__ __forceinline__ void xcd_barrier_complete(unsigned* bar, unsigned x, unsigned& nloc, unsigned& nx) {
    const unsigned G = gridDim.x * gridDim.y * gridDim.z;
    unsigned sum, cnt, mine, sp = 0u;
    for (;;) {
        sum = 0u; cnt = 0u; mine = 0u;
#pragma unroll
        for (unsigned j = 0; j < 16; ++j) { const unsigned c = xb_ld(&bar[XB_XCNT(j)]); sum += c; cnt += (c > 0u) ? 1u : 0u; mine = (j == x) ? c : mine; }
        if (sum == G) break;
        __builtin_amdgcn_s_sleep(1);
        if ((++sp & 255u) == 0u) { if (xb_ld(&bar[XB_TMO])) break; if (sp > XB_SPIN_CAP) { atomicAdd(&bar[XB_TMO], 1u); break; } }
    }
    nloc = mine > 0u ? mine : 1u; nx = cnt > 0u ? cnt : 1u;
}
__device__ __forceinline__ void xcd_barrier(const XcdBarrier& b) {
    asm volatile("s_waitcnt vmcnt(0)" ::: "memory");
    __syncthreads();
    if (threadIdx.x == 0) {
        unsigned* bar = b.bar;
        __builtin_amdgcn_s_waitcnt(0);
        unsigned nloc = b.st[0], nx = b.st[1];
        if (nloc == 0u) { xcd_barrier_complete(bar, b.x, nloc, nx); b.st[0] = nloc; b.st[1] = nx; }
        const unsigned old = xb_add(&bar[XB_XSUB(b.x)], 1u);
        const unsigned gen = old / nloc;
        if (old + 1u == (gen + 1u) * nloc) {
            __builtin_amdgcn_fence(__ATOMIC_RELEASE, "agent");
            asm volatile("s_waitcnt vmcnt(0)" ::: "memory");
            const unsigned og = xb_add(&bar[XB_TOP], 1u);
            const unsigned tg = og / nx;
            if (og + 1u == (tg + 1u) * nx) xb_add(&bar[XB_TOPGEN], 1u);
            else XB_SPIN(xb_ld(&bar[XB_TOPGEN]) == tg, bar);
            __builtin_amdgcn_fence(__ATOMIC_ACQUIRE, "agent");
            xb_add(&bar[XB_XGEN(b.x)], 1u);
            asm volatile("s_waitcnt vmcnt(0)" ::: "memory");
        } else {
            XB_SPIN(xb_ld(&bar[XB_XGEN(b.x)]) == gen, bar);
            __builtin_amdgcn_fence(__ATOMIC_ACQUIRE, "agent");
            asm volatile("s_waitcnt vmcnt(0)" ::: "memory");
        }
    }
    __syncthreads();
}

__device__ __forceinline__ size_t lat_off(int b, int t) { return ((size_t)b * LSEQ + (t - NCTX)) * D; }
__device__ __forceinline__ size_t ctx_off(int b, int t) { return ((size_t)b * NCTX + t) * D; }

namespace g8 {
constexpr int BM = 256, BK = 64, HALF = 128, HTB = HALF * BK * 2, STAGE_BYTES = 8 * HTB, NXCD = 8, WGM = 8;
__device__ __forceinline__ int lds_byte(int r, int c) { const int st = (r >> 4) * 2 + (c >> 5), rr = r & 15, cc = c & 31, ob = rr * 64 + cc * 2; return st * 1024 + (ob ^ (((ob >> 9) & 1) << 5)); }
__device__ __forceinline__ void stage_rc(int b, int& R, int& C) { const int st = b / 1024, sb = b % 1024, swz = sb ^ (((sb >> 9) & 1) << 5); R = (st >> 1) * 16 + swz / 64; C = (st & 1) * 32 + (swz % 64) / 2; }
__device__ __forceinline__ int perm32(int rho) { const int n = rho >> 4, i = rho & 15; return 8 * (i >> 2) + 4 * n + (i & 3); }

struct GUnit { const char* a; const char* b; int pm, pn, x0, x1, xi; };

__device__ __forceinline__ bool static_tile(int i, int G, int c, int nM, int nN, int& pm, int& pn) {
    const int nwg = nM * nN; const long L = (long)i * G + c; if (L >= nwg) return false;
    int wgid = (int)L; { const int q = nwg / NXCD, r = nwg % NXCD, xcd = wgid % NXCD, off = wgid / NXCD; wgid = (xcd < r ? xcd * (q + 1) : r * (q + 1) + (xcd - r) * q) + off; }
    const int nig = WGM * nN, gid = wgid / nig, fm = gid * WGM, gsz = (nM - fm) < WGM ? (nM - fm) : WGM;
    pm = fm + ((wgid % nig) % gsz); pn = (wgid % nig) / gsz; return true;
}

template <class Epi, class Sched>
__device__ __forceinline__ void gemm_phase(LAS unsigned char* lds, const Sched& S, const Epi& E) {
    const int tid = tid_fresh(), wid = __builtin_amdgcn_readfirstlane(tid >> 6), lane = tid & 63, wr = wid >> 2, wc = wid & 3, fr = lane & 15, fq = lane >> 4;
    const int K = S.K, nt = K / BK;
    const int lda = S.lda;
    unsigned voffA[2], voffB[2]; int Rr[2], Cc[2];
#pragma unroll
    for (int i = 0; i < 2; ++i) { int R, C; stage_rc(tid * 16 + i * 8192, R, C); const int Rb = Epi::PERM ? ((R & ~31) + perm32(R & 31)) : R; Rr[i] = R; Cc[i] = C;
        voffA[i] = (unsigned)(R * lda + C) * 2u; voffB[i] = (unsigned)(Rb * K + C) * 2u; }
    unsigned vAc[2][2], vAn[2][2];
    const size_t kstep = (size_t)(BK * 2);
    const size_t hstepA = (size_t)HALF * lda * 2, hstepB = (size_t)HALF * K * 2;
    const unsigned ldsw = (unsigned)wid * 1024u;
    const int aoff = lds_byte(wr * 64 + fr, fq * 8), boff = lds_byte(wc * 32 + fr, fq * 8);
#define G8_SA(b, h) (((b) * 2 + (h)) * HTB)
#define G8_SB(b, h) ((4 + (b) * 2 + (h)) * HTB)
#define G8_STAGE(bufoff, gbase, voff) do { _Pragma("unroll") for (int _i = 0; _i < 2; ++_i) \
        __builtin_amdgcn_global_load_lds((const unsigned*)((const char*)(gbase) + (voff)[_i]), (LAS unsigned*)(lds + (bufoff) + ldsw + _i * 8192), 16, 0, 0); } while (0)
#define G8_STAGE_A(bufoff, basep, h, usenext) do { if constexpr (Sched::GATHER) { unsigned _v[2]; _v[0] = (usenext) ? vAn[h][0] : vAc[h][0]; _v[1] = (usenext) ? vAn[h][1] : vAc[h][1]; G8_STAGE(bufoff, basep, _v); } \
        else { G8_STAGE(bufoff, (basep) + (h) * hstepA, voffA); } } while (0)
#define G8_LDA(dst, b, h) do { _Pragma("unroll") for (int m = 0; m < 4; ++m) _Pragma("unroll") for (int k = 0; k < 2; ++k) dst[m][k] = *(const LAS bf16x8*)(lds + G8_SA(b, h) + aoff + m * 2048 + k * 1024); } while (0)
#define G8_LDB(dst, b, h) do { _Pragma("unroll") for (int n = 0; n < 2; ++n) _Pragma("unroll") for (int k = 0; k < 2; ++k) dst[n][k] = *(const LAS bf16x8*)(lds + G8_SB(b, h) + boff + n * 2048 + k * 1024); } while (0)
#define G8_MMA(ai, bj, At, Bt) do { __builtin_amdgcn_s_setprio(1); _Pragma("unroll") for (int m = 0; m < 4; ++m) _Pragma("unroll") for (int n = 0; n < 2; ++n) _Pragma("unroll") for (int k = 0; k < 2; ++k) \
        acc[ai][bj][m][n] = __builtin_amdgcn_mfma_f32_16x16x32_bf16(Bt[n][k], At[m][k], acc[ai][bj][m][n], 0, 0, 0); __builtin_amdgcn_s_setprio(0); } while (0)
#define G8_WAIT_V(n) asm volatile("s_waitcnt vmcnt(" #n ")" ::: "memory")
#define G8_WAIT_L(n) asm volatile("s_waitcnt lgkmcnt(" #n ")" ::: "memory")
#define G8_BAR __builtin_amdgcn_s_barrier()
#define G8_SCHED __builtin_amdgcn_sched_barrier(0)
    GUnit cur, nxt; int ui = 0;
    if (!S.next(0, cur)) return;
    f32x4 acc[2][2][4][2];
#pragma unroll
    for (int a = 0; a < 2; ++a)
#pragma unroll
        for (int b = 0; b < 2; ++b)
#pragma unroll
            for (int m = 0; m < 4; ++m)
#pragma unroll
                for (int n = 0; n < 2; ++n) acc[a][b][m][n] = (f32x4){0.f, 0.f, 0.f, 0.f};
    bf16x8 At[4][2], B0[2][2], B1[2][2];
    const char* cA = cur.a; const char* cB = cur.b;
    if constexpr (Sched::GATHER) { S.aoff(cur, Rr, Cc, vAc); asm volatile("s_waitcnt lgkmcnt(0)" ::: "memory"); }
    G8_STAGE(G8_SB(0, 0), cB, voffB); G8_STAGE_A(G8_SA(0, 0), cA, 0, false); G8_STAGE(G8_SB(0, 1), cB + hstepB, voffB); G8_STAGE_A(G8_SA(0, 1), cA, 1, false);
    if (wr == 1) G8_BAR;
    G8_WAIT_V(4); G8_BAR;
    G8_STAGE(G8_SB(1, 0), cB + kstep, voffB); G8_STAGE_A(G8_SA(1, 0), cA + kstep, 0, false); G8_STAGE(G8_SB(1, 1), cB + hstepB + kstep, voffB);
    G8_WAIT_V(6); G8_BAR;
    for (;;) {
        const bool has_next = S.next(ui + 1, nxt);
        const char* nA = has_next ? nxt.a : cA; const char* nB = has_next ? nxt.b : cB;
        if constexpr (Sched::GATHER) {
            if (has_next) S.aoff(nxt, Rr, Cc, vAn); else { vAn[0][0] = vAc[0][0]; vAn[0][1] = vAc[0][1]; vAn[1][0] = vAc[1][0]; vAn[1][1] = vAc[1][1]; }
            asm volatile("s_waitcnt lgkmcnt(0)" : "+v"(vAn[0][0]), "+v"(vAn[0][1]), "+v"(vAn[1][0]), "+v"(vAn[1][1]) :: "memory");
        }
        for (int t = 0; t < nt; t += 2) {
            const bool last = (t == nt - 2);
            const char* a1 = cA + (size_t)(t + 1) * kstep;
            const char* a2 = last ? nA : cA + (size_t)(t + 2) * kstep; const char* b2 = last ? nB : cB + (size_t)(t + 2) * kstep;
            const char* a3 = a2 + kstep; const char* b3 = b2 + kstep;
            G8_LDB(B0, 0, 0); G8_SCHED; G8_LDA(At, 0, 0); G8_STAGE_A(G8_SA(1, 1), a1, 1, false);
            G8_WAIT_L(8); G8_BAR; G8_WAIT_L(0); G8_MMA(0, 0, At, B0); G8_BAR; G8_SCHED;
            G8_LDB(B1, 0, 1); G8_STAGE(G8_SB(0, 0), b2, voffB);
            G8_BAR; G8_WAIT_L(0); G8_MMA(0, 1, At, B1); G8_BAR;
            G8_LDA(At, 0, 1); G8_STAGE_A(G8_SA(0, 0), a2, 0, last);
            G8_BAR; G8_WAIT_L(0); G8_MMA(1, 0, At, B0); G8_BAR; G8_SCHED;
            G8_STAGE(G8_SB(0, 1), b2 + hstepB, voffB);
            G8_WAIT_V(6); G8_BAR; G8_MMA(1, 1, At, B1); G8_BAR;
            G8_LDB(B0, 1, 0); G8_SCHED; G8_LDA(At, 1, 0); G8_STAGE_A(G8_SA(0, 1), a2, 1, last);
            G8_WAIT_L(8); G8_BAR; G8_WAIT_L(0); G8_MMA(0, 0, At, B0); G8_BAR; G8_SCHED;
            G8_LDB(B1, 1, 1); G8_STAGE(G8_SB(1, 0), b3, voffB);
            G8_BAR; G8_WAIT_L(0); G8_MMA(0, 1, At, B1); G8_BAR;
            G8_LDA(At, 1, 1); G8_STAGE_A(G8_SA(1, 0), a3, 0, last);
            G8_BAR; G8_WAIT_L(0); G8_MMA(1, 0, At, B0); G8_BAR; G8_SCHED;
            G8_STAGE(G8_SB(1, 1), b3 + hstepB, voffB);
            G8_WAIT_V(6); G8_BAR; G8_MMA(1, 1, At, B1); G8_BAR;
        }
        E(acc, cur, wr, wc, fr, fq);
        if (!has_next) break;
#pragma unroll
        for (int a = 0; a < 2; ++a)
#pragma unroll
            for (int b = 0; b < 2; ++b)
#pragma unroll
                for (int m = 0; m < 4; ++m)
#pragma unroll
                    for (int n = 0; n < 2; ++n) acc[a][b][m][n] = (f32x4){0.f, 0.f, 0.f, 0.f};
        cur = nxt; cA = nA; cB = nB; ++ui;
        if constexpr (Sched::GATHER) { vAc[0][0] = vAn[0][0]; vAc[0][1] = vAn[0][1]; vAc[1][0] = vAn[1][0]; vAc[1][1] = vAn[1][1]; }
    }
    G8_WAIT_V(0);
    if (wr == 0) G8_BAR;
    G8_BAR;
#undef G8_SA
#undef G8_SB
#undef G8_STAGE
#undef G8_STAGE_A
#undef G8_LDA
#undef G8_LDB
#undef G8_MMA
#undef G8_WAIT_V
#undef G8_WAIT_L
#undef G8_BAR
#undef G8_SCHED
}
template <class Epi, class Sched>
__device__ __forceinline__ void gemm_call(LAS unsigned char* lds, Sched S, Epi E) { gemm_phase(lds, S, E); }
}
using g8::GUnit;

__device__ __forceinline__ int skipctx_pm(int pmc) { return (pmc >> 5) * 33 + 1 + (pmc & 31); }
struct SchedDense {       static constexpr bool GATHER = false;
    const bf16_t* A; const bf16_t* B; size_t strideA, strideB; int lda, K, nM, nN, nNb; bool skipctx; bool qkvswap;
    __device__ __forceinline__ bool next(int i, GUnit& u) const {
        int pm, pn; if (!g8::static_tile(i, gridDim.x, blockIdx.x, nM, nN, pm, pn)) return false;
        if (skipctx) pm = skipctx_pm(pm);
        const int br = pn / nNb, pl = pn - br * nNb;
        u.pm = pm; u.pn = pn; u.x0 = br; u.x1 = pl;
        u.a = (const char*)(A + (size_t)br * strideA + (size_t)pm * 256 * lda);
        u.b = (const char*)(B + (size_t)br * strideB + (size_t)pl * 256 * K);
        { const bool vt_ = qkvswap && ((0x3C20F0u >> pn) & 1u); const unsigned long long x_ = ((unsigned long long)u.a ^ (unsigned long long)u.b) & (vt_ ? ~0ull : 0ull); u.a = (const char*)((unsigned long long)u.a ^ x_); u.b = (const char*)((unsigned long long)u.b ^ x_); }
        return true;
    }
};
struct SchedZG {
    static constexpr bool GATHER = false;
    const bf16_t* Y; const bf16_t* WB; const bf16_t* Hm; const bf16_t* WG; int nM; bool skipctx; bool ctxonly;
    static constexpr int lda = 1024, K = 1024;
    __device__ __forceinline__ bool next(int i, GUnit& u) const {
        int pm, pn; if (!g8::static_tile(i >> 1, gridDim.x, blockIdx.x, nM, 12, pm, pn)) return false;
        if (skipctx) pm = skipctx_pm(pm);
        if (ctxonly) pm = pm * 33;
        const int sub = i & 1, br = pn >> 2, pl = pn & 3;
        u.pm = pm; u.pn = pn; u.x0 = sub; u.x1 = 0;
        if (sub == 0) { u.a = (const char*)(Y + (size_t)br * TG * 1024 + (size_t)pm * 256 * 1024); u.b = (const char*)(WB + (size_t)br * 1024 * 1024 + (size_t)pl * 256 * 1024); }
        else { u.a = (const char*)(Hm + (size_t)pm * 256 * 1024); u.b = (const char*)(WG + (size_t)pn * 256 * 1024); }
        return true;
    }
};
struct SchedZGc {
    static constexpr bool GATHER = false;
    const bf16_t* Y; const bf16_t* WB; const bf16_t* Hm; const bf16_t* WG; int nM; bool skipctx;
    static constexpr int lda = 1024, K = 1024;
    __device__ __forceinline__ bool next(int i, GUnit& u) const {
        const int q = i / 6, st = i - q * 6;
        int pm, pc; if (!g8::static_tile(q, gridDim.x, blockIdx.x, nM, 4, pm, pc)) return false;
        if (skipctx) pm = skipctx_pm(pm);
        const int sub = st & 1, br = st >> 1, pn = br * 4 + pc;
        u.pm = pm; u.pn = pn; u.x0 = sub; u.x1 = br;
        if (sub == 0) { u.a = (const char*)(Y + (size_t)br * TG * 1024 + (size_t)pm * 256 * 1024); u.b = (const char*)(WB + (size_t)br * 1024 * 1024 + (size_t)pc * 256 * 1024); }
        else { u.a = (const char*)(Hm + (size_t)pm * 256 * 1024); u.b = (const char*)(WG + (size_t)pn * 256 * 1024); }
        return true;
    }
};
struct SchedOut2 {
    static constexpr bool GATHER = false;
    const bf16_t* Z0; const bf16_t* Z1; const bf16_t* B; bool skipctx; int K; bool ctxonly; bool skew;
    static constexpr int lda = 3072;
    __device__ __forceinline__ bool next(int i, GUnit& u) const {
        int pm, pn;
        if (skew && gridDim.x == 256) {
            int L; const int b = (int)blockIdx.x;
            if (b < 32) { if (i >= 2) return false; L = b + 32 * i; } else { L = 64 + i * 224 + (b - 32); if (L >= 1024) return false; }
            g8::static_tile(0, 1, L, 256, 4, pm, pn);
        } else if (!g8::static_tile(i, gridDim.x, blockIdx.x, ctxonly ? 8 : (skipctx ? 256 : 2 * (TG / 256)), 4, pm, pn)) return false;
        if (skipctx) pm = skipctx_pm(pm);
        if (ctxonly) pm = pm * 33;
        u.pm = pm; u.pn = pn; u.x0 = 0; u.x1 = 0;
        const bf16_t* z1adj = Z1 - (size_t)(TG / 256) * 256 * 3072; const long long d = (pm < TG / 256) ? (long long)(Z0 - z1adj) : 0ll;
        u.a = (const char*)(z1adj + d + (size_t)pm * 256 * 3072);
        u.b = (const char*)(B + (size_t)pn * 256 * K);
        return true;
    }
};
struct SchedMoe {
    static constexpr bool GATHER = false;
    const bf16_t* A; const bf16_t* B; int lda, K, npn, brows;
    const LAS int* tab;
    const LAS int* uinf;
    __device__ __forceinline__ bool next(int i, GUnit& u) const {
        if (i >= 22) return false;
        const int slot0 = uinf[4 * i]; if (slot0 < 0) return false;
        const int L = i * (int)gridDim.x + (int)blockIdx.x; const int pn = L % npn; const int e = uinf[4 * i + 2];
        u.pm = slot0; u.pn = pn; u.x0 = e; u.x1 = uinf[4 * i + 1];
        u.a = (const char*)(A + (size_t)slot0 * lda);
        u.b = (const char*)(B + ((size_t)e * brows + (size_t)pn * 256) * K);
        return true;
    }
};

struct SchedMoeG {
    static constexpr bool GATHER = true;
    const bf16_t* Hm; const bf16_t* B; const LAS int* tab; const LAS int* tok;
    static constexpr int lda = 1024, K = 1024;
    __device__ __forceinline__ bool next(int i, GUnit& u) const {
        if (i >= 22) return false;
        const LAS int* uinf = tok + 22 * 256;
        const int slot0 = uinf[4 * i]; if (slot0 < 0) return false;
        const int L = i * (int)gridDim.x + (int)blockIdx.x; const int pn = L & 7; const int e = uinf[4 * i + 2];
        u.pm = slot0; u.pn = pn; u.x0 = e; u.x1 = uinf[4 * i + 1]; u.xi = i;
        u.a = (const char*)Hm;
        u.b = (const char*)(B + ((size_t)e * 2048 + (size_t)pn * 256) * 1024);
        return true;
    }
    __device__ __forceinline__ void aoff(const GUnit& u, const int (&R)[2], const int (&C)[2], unsigned (&vo)[2][2]) const {
        const LAS int* tk = tok + u.xi * 256;
#pragma unroll
        for (int h = 0; h < 2; ++h)
#pragma unroll
            for (int q = 0; q < 2; ++q) vo[h][q] = (unsigned)(tk[h * 128 + R[q]] * 1024 + C[q]) * 2u;
    }
};

struct EpiQKV {
    static constexpr bool PERM = true;
    unsigned char* reg; int g;
    const f32x2* atab; const f32x2* rtab; bool dry;
    __device__ __forceinline__ void operator()(const f32x4 (&acc)[2][2][4][2], const GUnit& u, int wr, int wc, int fr, int fq) const {
        const int pn = u.pn;
        if (dry) { if (acc[0][0][0][0][0] == 1234.5678f) reg[0] = 1; return; }
        const int rg0 = u.pm * 256;
        const int bl = rg0 / TB, t0 = rg0 - bl * TB;
        bf16_t* GQK = (bf16_t*)(reg + R_GQK); bf16_t* GVT = (bf16_t*)(reg + R_GVT); float* GLR = (float*)(reg + R_GLR);
        bf16_t* AQ = (bf16_t*)(reg + R_AQ); bf16_t* AK = (bf16_t*)(reg + R_AK); bf16_t* AVT = (bf16_t*)(reg + R_AVT);
        bf16_t* RQK = (bf16_t*)(reg + R_RQK); bf16_t* RVT = (bf16_t*)(reg + R_RVT);
        if (pn < 4) {
            const float sc = pn < 2 ? 0.08838834764831845f : 1.0f;
#pragma unroll
            for (int ai = 0; ai < 2; ++ai)
#pragma unroll
                for (int m = 0; m < 4; ++m) { const int r = rg0 + ai * 128 + wr * 64 + m * 16 + fr; bf16_t* rowp = GQK + (size_t)r * 1024 + pn * 256 + wc * 32 + 8 * fq;
#pragma unroll
                    for (int bj = 0; bj < 2; ++bj) { const f32x4 v0 = acc[ai][bj][m][0] * sc, v1 = acc[ai][bj][m][1] * sc; u32x4 w; w.x = cvt_pk_bf16(v0[0], v0[1]); w.y = cvt_pk_bf16(v0[2], v0[3]); w.z = cvt_pk_bf16(v1[0], v1[1]); w.w = cvt_pk_bf16(v1[2], v1[3]);
                        *(u32x4*)(rowp + bj * 128) = w; } }
        } else if ((0x3C20F0u >> pn) & 1u) {
            bf16_t* VT; int dim0, nd;
            if (pn < 8) { VT = GVT; dim0 = (pn - 4) * 256; nd = 1024; } else if (pn == 13) { VT = AVT; dim0 = 0; nd = 256; } else { VT = RVT; dim0 = (pn - 18) * 256; nd = 1024; }
#pragma unroll
            for (int ai = 0; ai < 2; ++ai)
#pragma unroll
                for (int m = 0; m < 4; ++m) { const int dimr = ai * 128 + wr * 64 + m * 16 + fr; bf16_t* rowp = VT + ((size_t)bl * nd + dim0 + dimr) * TB + t0 + wc * 32 + 8 * fq;
#pragma unroll
                    for (int bj = 0; bj < 2; ++bj) { const f32x4 v0 = acc[ai][bj][m][0], v1 = acc[ai][bj][m][1]; u32x4 w; w.x = cvt_pk_bf16(v0[0], v0[1]); w.y = cvt_pk_bf16(v0[2], v0[3]); w.z = cvt_pk_bf16(v1[0], v1[1]); w.w = cvt_pk_bf16(v1[2], v1[3]);
                        *(u32x4*)(rowp + bj * 128) = w; } }
        } else if (pn == 22) {
            if (wc == 0) {
#pragma unroll
                for (int ai = 0; ai < 2; ++ai)
#pragma unroll
                    for (int m = 0; m < 4; ++m) { const int r = rg0 + ai * 128 + wr * 64 + m * 16 + fr;
#pragma unroll
                        for (int n = 0; n < 2; ++n) *(f32x4*)(GLR + (size_t)r * 32 + 8 * fq + 4 * n) = acc[ai][0][m][n]; }
            }
        } else {
            const bool isatt = pn <= 12;
            bf16_t* O; int ld, colbase; float sc;
            if (pn < 12)       { O = AQ;  ld = 1024; colbase = (pn - 8) * 256;  sc = 0.08838834764831845f * LOG2E; }
            else if (pn == 12) { O = AK;  ld = 256;  colbase = 0;               sc = 1.0f; }
            else if (pn < 16)  { O = RQK; ld = 1024; colbase = (pn - 14) * 256; sc = 1.0f; }
            else               { O = RQK; ld = 1024; colbase = 512 + (pn - 16) * 256; sc = 0.08838834764831845f; }
            const int hb = isatt ? ((wc & 1) * 16 + (wc >> 1) * 64) : 16 * wc;
            const int pstep = isatt ? 32 : 64;
            const int fi = isatt ? ((wc & 1) * 16 + 4 * fq) : (16 * wc + 4 * fq);
#pragma unroll
            for (int ai = 0; ai < 2; ++ai) {
                f32x4 tb[4][2];
#pragma unroll
                for (int m = 0; m < 4; ++m) { const int t = t0 + ai * 128 + wr * 64 + m * 16 + fr;
                    const f32x4* tp;
                    if (isatt) { const int lt = t - NCTX; const int pos = (t < NCTX) ? 0 : ((wc < 2) ? (lt >> 6) : (lt & 63)); tp = (const f32x4*)(atab + pos * 32 + fi); }
                    else tp = (const f32x4*)(rtab + (size_t)t * 64 + fi);
                    tb[m][0] = tp[0]; tb[m][1] = tp[1]; }
#pragma unroll
                for (int m = 0; m < 4; ++m) {
                    const int rl = ai * 128 + wr * 64 + m * 16 + fr; const int r = rg0 + rl;
                    f32x2 cs[4]; { const f32x4 a = tb[m][0], b = tb[m][1]; cs[0] = (f32x2){a[0], a[1]}; cs[1] = (f32x2){a[2], a[3]}; cs[2] = (f32x2){b[0], b[1]}; cs[3] = (f32x2){b[2], b[3]}; }
#pragma unroll
                    for (int bj = 0; bj < 2; ++bj) {
                        const f32x4 x1 = acc[ai][bj][m][0], x2 = acc[ai][bj][m][1];
                        float o1[4], o2[4];
#pragma unroll
                        for (int j = 0; j < 4; ++j) { o1[j] = (x1[j] * cs[j].x - x2[j] * cs[j].y) * sc; o2[j] = (x2[j] * cs[j].x + x1[j] * cs[j].y) * sc; }
                        bf16_t* p = O + (size_t)r * ld + colbase + bj * 128 + hb + 4 * fq;
                        u32x2 w1, w2; w1.x = cvt_pk_bf16(o1[0], o1[1]); w1.y = cvt_pk_bf16(o1[2], o1[3]); w2.x = cvt_pk_bf16(o2[0], o2[1]); w2.y = cvt_pk_bf16(o2[2], o2[3]);
                        *(u32x2*)p = w1; *(u32x2*)(p + pstep) = w2;
                    }
                }
            }
        }
    }
};

struct EpiGateR {
    static constexpr bool PERM = true;
    unsigned char* reg; const f32x2* stats; const float* gng; const float* rng; bool dry;
    __device__ __forceinline__ void operator()(const f32x4 (&acc)[2][2][4][2], const GUnit& u, int wr, int wc, int fr, int fq) const {
        const int mix = u.pn >> 2, head = u.pn & 3;
        bf16_t* O = (bf16_t*)(reg + (mix ? R_ORF : R_OGF));
        const float* gn = (mix ? rng : gng) + head * 256;
        const f32x2* st = stats + (size_t)mix * TG * 4;
        f32x4 ga[2], gb[2];
#pragma unroll
        for (int bj = 0; bj < 2; ++bj) { const int c0 = bj * 128 + wc * 32 + 8 * fq; ga[bj] = *(const f32x4*)(gn + c0); gb[bj] = *(const f32x4*)(gn + c0 + 4); }
#pragma unroll
        for (int ai = 0; ai < 2; ++ai) {
            u32x4 ov[4][2]; f32x2 sv[4];
#pragma unroll
            for (int m = 0; m < 4; ++m) { const int r = u.pm * 256 + ai * 128 + wr * 64 + m * 16 + fr; sv[m] = st[(size_t)r * 4 + head];
#pragma unroll
                for (int bj = 0; bj < 2; ++bj) ov[m][bj] = *(const u32x4*)(O + (size_t)r * 1024 + head * 256 + bj * 128 + wc * 32 + 8 * fq); }
#pragma unroll
            for (int m = 0; m < 4; ++m) { const int r = u.pm * 256 + ai * 128 + wr * 64 + m * 16 + fr; const float mu = sv[m].x, rs = sv[m].y;
#pragma unroll
                for (int bj = 0; bj < 2; ++bj) {
                    const u32x4 o4 = ov[m][bj]; const f32x4 a0 = acc[ai][bj][m][0], a1 = acc[ai][bj][m][1]; const f32x4 g0 = ga[bj], g1 = gb[bj];
                    float y[8];
                    y[0] = (bflo(o4.x) - mu) * rs * g0[0] * silu_f(a0[0]); y[1] = (bfhi(o4.x) - mu) * rs * g0[1] * silu_f(a0[1]);
                    y[2] = (bflo(o4.y) - mu) * rs * g0[2] * silu_f(a0[2]); y[3] = (bfhi(o4.y) - mu) * rs * g0[3] * silu_f(a0[3]);
                    y[4] = (bflo(o4.z) - mu) * rs * g1[0] * silu_f(a1[0]); y[5] = (bfhi(o4.z) - mu) * rs * g1[1] * silu_f(a1[1]);
                    y[6] = (bflo(o4.w) - mu) * rs * g1[2] * silu_f(a1[2]); y[7] = (bfhi(o4.w) - mu) * rs * g1[3] * silu_f(a1[3]);
                    u32x4 w; w.x = cvt_pk_bf16(y[0], y[1]); w.y = cvt_pk_bf16(y[2], y[3]); w.z = cvt_pk_bf16(y[4], y[5]); w.w = cvt_pk_bf16(y[6], y[7]);
                    if (!dry) *(u32x4*)(O + (size_t)r * 1024 + head * 256 + bj * 128 + wc * 32 + 8 * fq) = w;
                } }
        }
    }
};

struct EpiBf16 {
    static constexpr bool PERM = true;
    bf16_t* O; int ld;
    __device__ __forceinline__ void operator()(const f32x4 (&acc)[2][2][4][2], const GUnit& u, int wr, int wc, int fr, int fq) const {
#pragma unroll
        for (int ai = 0; ai < 2; ++ai)
#pragma unroll
            for (int m = 0; m < 4; ++m) { bf16_t* rowp = O + (size_t)(u.pm * 256 + ai * 128 + wr * 64 + m * 16 + fr) * ld + u.pn * 256 + wc * 32 + 8 * fq;
#pragma unroll
                for (int bj = 0; bj < 2; ++bj) { const f32x4 v0 = acc[ai][bj][m][0], v1 = acc[ai][bj][m][1]; u32x4 w; w.x = cvt_pk_bf16(v0[0], v0[1]); w.y = cvt_pk_bf16(v0[2], v0[3]); w.z = cvt_pk_bf16(v1[0], v1[1]); w.w = cvt_pk_bf16(v1[2], v1[3]);
                    *(u32x4*)(rowp + bj * 128) = w; } }
    }
};
struct EpiGZ {
    static constexpr bool PERM = true;
    bf16_t* Z; bool dry;
    __device__ __forceinline__ void operator()(const f32x4 (&acc)[2][2][4][2], const GUnit& u, int wr, int wc, int fr, int fq) const {
#pragma unroll
        for (int ai = 0; ai < 2; ++ai) {
            u32x4 zv[4][2];
#pragma unroll
            for (int m = 0; m < 4; ++m)
#pragma unroll
                for (int bj = 0; bj < 2; ++bj) zv[m][bj] = *(const u32x4*)(Z + (size_t)(u.pm * 256 + ai * 128 + wr * 64 + m * 16 + fr) * 3072 + u.pn * 256 + wc * 32 + 8 * fq + bj * 128);
#pragma unroll
            for (int m = 0; m < 4; ++m) { bf16_t* rowp = Z + (size_t)(u.pm * 256 + ai * 128 + wr * 64 + m * 16 + fr) * 3072 + u.pn * 256 + wc * 32 + 8 * fq;
#pragma unroll
                for (int bj = 0; bj < 2; ++bj) { const f32x4 v0 = acc[ai][bj][m][0], v1 = acc[ai][bj][m][1]; const u32x4 z = zv[m][bj]; u32x4 w;
                    w.x = cvt_pk_bf16(sigmoid_f(v0[0]) * bflo(z.x), sigmoid_f(v0[1]) * bfhi(z.x)); w.y = cvt_pk_bf16(sigmoid_f(v0[2]) * bflo(z.y), sigmoid_f(v0[3]) * bfhi(z.y));
                    w.z = cvt_pk_bf16(sigmoid_f(v1[0]) * bflo(z.z), sigmoid_f(v1[1]) * bfhi(z.z)); w.w = cvt_pk_bf16(sigmoid_f(v1[2]) * bflo(z.w), sigmoid_f(v1[3]) * bfhi(z.w));
                    if (!dry) *(u32x4*)(rowp + bj * 128) = w; } }
        }
    }
};
struct EpiZG {
    static constexpr bool PERM = true;
    bf16_t* Z; bool dry;
    __device__ __forceinline__ void operator()(const f32x4 (&acc)[2][2][4][2], const GUnit& u, int wr, int wc, int fr, int fq) const {
        if (dry) { if (acc[0][0][0][0][0] == 1234.5678f) Z[0] = 1; return; }
        if (u.x0 == 0) { EpiBf16 e{Z, 3072}; e(acc, u, wr, wc, fr, fq); } else { EpiGZ e{Z, false}; e(acc, u, wr, wc, fr, fq); }
    }
};
struct EpiZGc {
    static constexpr bool PERM = true;
    bf16_t* Z;
    __device__ __forceinline__ void operator()(const f32x4 (&acc)[2][2][4][2], const GUnit& u, int wr, int wc, int fr, int fq) const {
        if (u.x0 == 0) { EpiBf16 e{Z, 3072}; e(acc, u, wr, wc, fr, fq); return; }
        const int br = u.x1, pc = u.pn - br * 4;
#pragma unroll
        for (int ai = 0; ai < 2; ++ai) {
            u32x4 zv[4][2], mv[4][2];
#pragma unroll
            for (int m = 0; m < 4; ++m)
#pragma unroll
                for (int bj = 0; bj < 2; ++bj) { const bf16_t* rp = Z + (size_t)(u.pm * 256 + ai * 128 + wr * 64 + m * 16 + fr) * 3072 + wc * 32 + 8 * fq + bj * 128;
                    zv[m][bj] = *(const u32x4*)(rp + u.pn * 256); mv[m][bj] = (br > 0) ? *(const u32x4*)(rp + pc * 256) : (u32x4){0u, 0u, 0u, 0u}; }
#pragma unroll
            for (int m = 0; m < 4; ++m) { bf16_t* rowp = Z + (size_t)(u.pm * 256 + ai * 128 + wr * 64 + m * 16 + fr) * 3072 + pc * 256 + wc * 32 + 8 * fq;
#pragma unroll
                for (int bj = 0; bj < 2; ++bj) { const f32x4 v0 = acc[ai][bj][m][0], v1 = acc[ai][bj][m][1]; const u32x4 z = zv[m][bj], mm = mv[m][bj]; u32x4 w;
                    w.x = cvt_pk_bf16(bflo(mm.x) + sigmoid_f(v0[0]) * bflo(z.x), bfhi(mm.x) + sigmoid_f(v0[1]) * bfhi(z.x)); w.y = cvt_pk_bf16(bflo(mm.y) + sigmoid_f(v0[2]) * bflo(z.y), bfhi(mm.y) + sigmoid_f(v0[3]) * bfhi(z.y));
                    w.z = cvt_pk_bf16(bflo(mm.z) + sigmoid_f(v1[0]) * bflo(z.z), bfhi(mm.z) + sigmoid_f(v1[1]) * bfhi(z.z)); w.w = cvt_pk_bf16(bflo(mm.w) + sigmoid_f(v1[2]) * bflo(z.w), bfhi(mm.w) + sigmoid_f(v1[3]) * bfhi(z.w));
                    *(u32x4*)(rowp + bj * 128) = w; } }
        }
    }
};
struct EpiOut {
    static constexpr bool PERM = false;
    const float* xin_lat; const float* xin_ctx; float* xout_lat; float* xout_ctx; const float* mod; int g; bool dry;
    __device__ __forceinline__ void operator()(const f32x4 (&acc)[2][2][4][2], const GUnit& u, int wr, int wc, int fr, int fq) const {
        const int rg0 = u.pm * 256; const int bl = rg0 / TB, t0 = rg0 - bl * TB; const int b = g * BG + bl;
        const bool isctx = t0 < NCTX;
        const float* g1 = mod + (size_t)(isctx ? 8 : b) * 6144 + 2048 + u.pn * 256 + wc * 32 + 4 * fq;
        f32x4 gv[2][2];
#pragma unroll
        for (int bj = 0; bj < 2; ++bj)
#pragma unroll
            for (int n = 0; n < 2; ++n) gv[bj][n] = *(const f32x4*)(g1 + bj * 128 + n * 16);
#pragma unroll
        for (int ai = 0; ai < 2; ++ai) {
            f32x4 xv[4][2][2];
#pragma unroll
            for (int m = 0; m < 4; ++m) { const int t = t0 + ai * 128 + wr * 64 + m * 16 + fr;
                const float* ip = (isctx ? xin_ctx : xin_lat) + (isctx ? ctx_off(b, t) : lat_off(b, t)) + u.pn * 256 + wc * 32 + 4 * fq;
#pragma unroll
                for (int bj = 0; bj < 2; ++bj)
#pragma unroll
                    for (int n = 0; n < 2; ++n) xv[m][bj][n] = *(const f32x4*)(ip + bj * 128 + n * 16); }
#pragma unroll
            for (int m = 0; m < 4; ++m) { const int t = t0 + ai * 128 + wr * 64 + m * 16 + fr;
                float* op = (isctx ? xout_ctx : xout_lat) + (isctx ? ctx_off(b, t) : lat_off(b, t)) + u.pn * 256 + wc * 32 + 4 * fq;
#pragma unroll
                for (int bj = 0; bj < 2; ++bj)
#pragma unroll
                    for (int n = 0; n < 2; ++n) { if (!dry) *(f32x4*)(op + bj * 128 + n * 16) = xv[m][bj][n] + gv[bj][n] * acc[ai][bj][m][n]; } }
        }
    }
};
struct EpiMoe1 {
    static constexpr bool PERM = true;
    bf16_t* Hm;
    __device__ __forceinline__ void operator()(const f32x4 (&acc)[2][2][4][2], const GUnit& u, int wr, int wc, int fr, int fq) const {
#pragma unroll
        for (int ai = 0; ai < 2; ++ai)
#pragma unroll
            for (int m = 0; m < 4; ++m) { const int rl = ai * 128 + wr * 64 + m * 16 + fr;
                if (rl < u.x1) { bf16_t* p = Hm + (size_t)(u.pm + rl) * 1024 + u.pn * 128 + wc * 32 + 8 * fq;
                    const f32x4 a0 = acc[ai][0][m][0], a1 = acc[ai][0][m][1], b0 = acc[ai][1][m][0], b1 = acc[ai][1][m][1]; u32x4 w;
                    w.x = cvt_pk_bf16(silu_f(a0[0]) * b0[0], silu_f(a0[1]) * b0[1]); w.y = cvt_pk_bf16(silu_f(a0[2]) * b0[2], silu_f(a0[3]) * b0[3]);
                    w.z = cvt_pk_bf16(silu_f(a1[0]) * b1[0], silu_f(a1[1]) * b1[1]); w.w = cvt_pk_bf16(silu_f(a1[2]) * b1[2], silu_f(a1[3]) * b1[3]);
                    *(u32x4*)p = w; } }
    }
};
struct EpiMoe2 {
    static constexpr bool PERM = true;
    bf16_t* Y; const float* slotw;
    __device__ __forceinline__ void operator()(const f32x4 (&acc)[2][2][4][2], const GUnit& u, int wr, int wc, int fr, int fq) const {
        float sw[2][4];
#pragma unroll
        for (int ai = 0; ai < 2; ++ai)
#pragma unroll
            for (int m = 0; m < 4; ++m) sw[ai][m] = slotw[u.pm + ai * 128 + wr * 64 + m * 16 + fr];
#pragma unroll
        for (int ai = 0; ai < 2; ++ai)
#pragma unroll
            for (int m = 0; m < 4; ++m) { const int rl = ai * 128 + wr * 64 + m * 16 + fr;
                if (rl < u.x1) { const float w8 = sw[ai][m]; bf16_t* rowp = Y + (size_t)(u.pm + rl) * 1024 + u.pn * 256 + wc * 32 + 8 * fq;
#pragma unroll
                    for (int bj = 0; bj < 2; ++bj) { const f32x4 v0 = acc[ai][bj][m][0] * w8, v1 = acc[ai][bj][m][1] * w8; u32x4 w; w.x = cvt_pk_bf16(v0[0], v0[1]); w.y = cvt_pk_bf16(v0[2], v0[3]); w.z = cvt_pk_bf16(v1[0], v1[1]); w.w = cvt_pk_bf16(v1[2], v1[3]);
                        *(u32x4*)(rowp + bj * 128) = w; } } }
    }
};

template <class F>
__device__ __forceinline__ void conv_tile(LAS float* tile, F f, int n0, int k0src, size_t ldsrc, bf16_t* dst, size_t dst_ld, int k0dst) {
    const int tid = tid_fresh(), c4 = tid & 31, kb = tid >> 5;
    const float* colp = f(n0 + 4 * c4);
#pragma unroll
    for (int i = 0; i < 4; ++i) { const int kl = kb + 16 * i; const f32x4 v = colp ? *(const f32x4*)(colp + (size_t)(k0src + kl) * ldsrc) : (f32x4){0.f, 0.f, 0.f, 0.f}; *(LAS f32x4*)(tile + kl * 132 + 4 * c4) = v; }
    __syncthreads();
    const int n2 = tid >> 2, k16 = (tid & 3) * 16;
    u32x4 w0, w1;
    w0.x = cvt_pk_bf16(tile[(k16 + 0) * 132 + n2], tile[(k16 + 1) * 132 + n2]); w0.y = cvt_pk_bf16(tile[(k16 + 2) * 132 + n2], tile[(k16 + 3) * 132 + n2]);
    w0.z = cvt_pk_bf16(tile[(k16 + 4) * 132 + n2], tile[(k16 + 5) * 132 + n2]); w0.w = cvt_pk_bf16(tile[(k16 + 6) * 132 + n2], tile[(k16 + 7) * 132 + n2]);
    w1.x = cvt_pk_bf16(tile[(k16 + 8) * 132 + n2], tile[(k16 + 9) * 132 + n2]); w1.y = cvt_pk_bf16(tile[(k16 + 10) * 132 + n2], tile[(k16 + 11) * 132 + n2]);
    w1.z = cvt_pk_bf16(tile[(k16 + 12) * 132 + n2], tile[(k16 + 13) * 132 + n2]); w1.w = cvt_pk_bf16(tile[(k16 + 14) * 132 + n2], tile[(k16 + 15) * 132 + n2]);
    bf16_t* dp = dst + (size_t)(n0 + n2) * dst_ld + k0dst + k16;
    *(u32x4*)dp = w0; *(u32x4*)(dp + 8) = w1;
    __syncthreads();
}
__device__ __forceinline__ int win_col(int np) {
    if (np < 5888) {
        const int tile = np >> 8, p = np & 255, hh = p >> 7, pp = p & 127, wc = pp >> 5, n = (pp >> 2) & 1, q = 4 * ((pp >> 3) & 3) + (pp & 3);
        const int fatt = (wc & 1) * 16 + (wc >> 1) * 64 + q + 32 * n, fret = 16 * wc + q + 64 * n;
        if (tile < 8) return np;
        if (tile < 12) return 3104 + (2 * (tile - 8) + hh) * 128 + fatt;
        if (tile == 12) return 4128 + hh * 128 + fatt;
        if (tile == 13) return 4384 + p;
        if (tile < 16) return 4640 + (2 * (tile - 14) + hh) * 128 + fret;
        if (tile < 18) return 5152 + (2 * (tile - 16) + hh) * 128 + fret;
        if (tile < 22) return 5664 + (np - 18 * 256);
        return p < 32 ? 3072 + p : -1;
    }
    if (np < 7936) { const int m = np - 5888; return m < 1024 ? 2048 + m : 6688 + (m - 1024); }
    return 7712 + (np - 7936);
}
struct FWin { const float* w; __device__ __forceinline__ const float* operator()(int np) const { const int c = win_col(np); return c < 0 ? nullptr : w + c; } };
struct FPlain { const float* w; __device__ __forceinline__ const float* operator()(int n) const { return w + n; } };
struct FW13 { const float* w1; const float* w3; __device__ __forceinline__ const float* operator()(int np) const { const int tile = np >> 8, r = np & 255; return r < 128 ? w1 + tile * 128 + r : w3 + tile * 128 + (r - 128); } };

constexpr int PRO_MOD = 384, PRO_TAB = 8 + 1056, PRO_WR = 192, PRO_WIN = 2 * 86 * 16, PRO_WBR = 2 * 3 * 8 * 16, PRO_WO3 = 2 * 8 * 48, PRO_WO1 = 2 * 8 * 16;
constexpr int PRO_UNITS = PRO_MOD + PRO_TAB + PRO_WR + PRO_WIN + PRO_WBR + PRO_WO3 + PRO_WO1;

__device__ __forceinline__ void prologue1(KP p, LAS unsigned char* lds) {
    unsigned char* ws = p.ws; const int tid = tid_fresh();
    LAS float* tile = (LAS float*)lds;
    for (int u = blockIdx.x; u < PRO_UNITS; u += gridDim.x) {
        int idx = u;
        if (idx < PRO_MOD) {
            const int l = idx / 192, rem = idx % 192, cb = rem / 16, ks = rem % 16, k0 = ks * 64;
            LAS float* sv = tile;
            for (int e = tid; e < 9 * 64; e += 512) { const int r = e >> 6, kk = e & 63; const float cv = (r < 8) ? p.in[1][r * 1024 + k0 + kk] : p.in[3][k0 + kk]; sv[e] = cv / (1.0f + expf(-cv)); }
            __syncthreads();
            const int n = cb * 512 + tid; const float* w = p.in[4] + ((size_t)l * 1024 + k0) * 6144 + n;
            float a[9];
#pragma unroll
            for (int r = 0; r < 9; ++r) a[r] = 0.f;
            for (int kk = 0; kk < 64; ++kk) { const float wv = w[(size_t)kk * 6144];
#pragma unroll
                for (int r = 0; r < 9; ++r) a[r] += sv[r * 64 + kk] * wv; }
            float* mp = (float*)(ws + OFF_MODP);
#pragma unroll
            for (int r = 0; r < 9; ++r) mp[((size_t)(ks * 2 + l) * 9 + r) * 6144 + n] = a[r];
            __syncthreads();
            continue;
        }
        idx -= PRO_MOD;
        if (idx < PRO_TAB) {
            const int e = idx * 512 + tid;
            if (e < 4096) { const int pos = e >> 5, i = e & 31; const float inv = powf(10000.0f, -(float)i / 32.0f); const float ang = (float)pos * inv; float s, c; sincosf(ang, &s, &c); ((f32x2*)(ws + OFF_ATAB))[e] = (f32x2){c, s}; }
            else { const int e2 = e - 4096; if (e2 < TB * 64) { const int pos = e2 >> 6, i = e2 & 63; const float inv = powf(10000.0f, -(float)i / 64.0f); const float ang = (float)pos * inv; float s, c; sincosf(ang, &s, &c); ((f32x2*)(ws + OFF_RTAB))[e2] = (f32x2){c, s}; } }
            continue;
        }
        idx -= PRO_TAB;
        if (idx < PRO_WR) {
            const int e = idx * 512 + tid; const int k = e & 1023, n = (e >> 10) % 48, l = e / (48 * 1024);
            const float v = n < 4 ? p.in[18][((size_t)l * 1024 + k) * 4 + n] : (n < 36 ? p.in[20][((size_t)l * 1024 + k) * 32 + (n - 4)] : 0.f);
            const bf16_t hi = f2bf(v); const bf16_t lo = f2bf(v - bf2f(hi));
            bf16_t* W = (bf16_t*)(ws + OFF_WR) + (size_t)l * 2 * 48 * 1024;
            W[(size_t)n * 1024 + k] = hi; W[(size_t)(48 + n) * 1024 + k] = lo;
            continue;
        }
        idx -= PRO_WR;
        if (idx < PRO_WIN) {
            const int l = idx / (86 * 16), rem = idx % (86 * 16), nt = rem / 16, kt = rem % 16;
            FWin f{p.in[8] + (size_t)l * 1024 * NIN};
            conv_tile(tile, f, nt * 128, kt * 64, NIN, (bf16_t*)(ws + OFF_WINT) + (size_t)l * WIN_ROWS * 1024, 1024, kt * 64);
            continue;
        }
        idx -= PRO_WIN;
        if (idx < PRO_WBR) {
            const int lb = idx / 128, rem = idx % 128, nt = rem / 16, kt = rem % 16; const int l = lb / 3, br = lb % 3;
            FPlain f{p.in[14 + br] + (size_t)l * 1024 * 1024};
            conv_tile(tile, f, nt * 128, kt * 64, 1024, (bf16_t*)(ws + OFF_WBRT) + (size_t)lb * 1024 * 1024, 1024, kt * 64);
            continue;
        }
        idx -= PRO_WBR;
        if (idx < PRO_WO3) {
            const int l = idx / (8 * 48), rem = idx % (8 * 48), nt = rem / 48, kt = rem % 48;
            FPlain f{p.in[17] + (size_t)l * 1024 * 1024};
            conv_tile(tile, f, nt * 128, (kt % 16) * 64, 1024, (bf16_t*)(ws + OFF_WO3T) + (size_t)l * 1024 * 3072, 3072, kt * 64);
            continue;
        }
        idx -= PRO_WO3;
        {
            const int l = idx / 128, rem = idx % 128, nt = rem / 16, kt = rem % 16;
            FPlain f{p.in[17] + (size_t)l * 1024 * 1024};
            conv_tile(tile, f, nt * 128, kt * 64, 1024, (bf16_t*)(ws + OFF_WO1T) + (size_t)l * 1024 * 1024, 1024, kt * 64);
        }
    }
}
__device__ __forceinline__ void prologue2(KP p) {

    const float* mp = (const float*)(p.ws + OFF_MODP); float* mo = (float*)(p.ws + OFF_MOD);
    for (int e = blockIdx.x * 512 + tid_fresh(); e < 2 * 9 * 6144; e += gridDim.x * 512) {
        const int l = e / (9 * 6144), n = e % 6144;
        float s = p.in[5][l * 6144 + n];
#pragma unroll
        for (int ks = 0; ks < 16; ++ks) s += mp[(size_t)ks * 2 * 9 * 6144 + e];
        mo[e] = s;
    }
}
__device__ __forceinline__ void moe_convert(KP p, int layer, LAS unsigned char* lds) {
    bf16_t* W13T = (bf16_t*)(p.ws + OFF_REG + M_W13T); bf16_t* W2T = (bf16_t*)(p.ws + OFF_REG + M_W2T);
    const int tid = tid_fresh(), n2 = tid >> 2, k16 = (tid & 3) * 16;
    const float* w1 = p.in[22] + (size_t)layer * 32 * 1024 * 1024; const float* w3 = p.in[23] + (size_t)layer * 32 * 1024 * 1024; const float* w2 = p.in[24] + (size_t)layer * 32 * 1024 * 1024;
    constexpr int NT = 32 * 16 * 16 + 32 * 8 * 16;
#pragma unroll 2
    for (int u = blockIdx.x; u < NT; u += gridDim.x) {
        const float* sp; bf16_t* dp;
        if (u < 32 * 16 * 16) { const int e = u >> 8, rem = u & 255, nt = rem >> 4, kt = rem & 15; const int np = nt * 128 + n2, tl = np >> 8, r = np & 255;
            sp = (r < 128 ? w1 + tl * 128 + r : w3 + tl * 128 + (r - 128)) + (size_t)e * 1024 * 1024 + (size_t)(kt * 64 + k16) * 1024;
            dp = W13T + ((size_t)e * 2048 + np) * 1024 + kt * 64 + k16; }
        else { const int v = u - 32 * 16 * 16; const int e = v >> 7, rem = v & 127, nt = rem >> 4, kt = rem & 15;
            sp = w2 + (size_t)e * 1024 * 1024 + (size_t)(kt * 64 + k16) * 1024 + nt * 128 + n2;
            dp = W2T + ((size_t)e * 1024 + nt * 128 + n2) * 1024 + kt * 64 + k16; }
        float v[16];
#pragma unroll
        for (int i = 0; i < 16; ++i) v[i] = sp[(size_t)i * 1024];
        u32x4 w0, w1v;
        w0.x = cvt_pk_bf16(v[0], v[1]); w0.y = cvt_pk_bf16(v[2], v[3]); w0.z = cvt_pk_bf16(v[4], v[5]); w0.w = cvt_pk_bf16(v[6], v[7]);
        w1v.x = cvt_pk_bf16(v[8], v[9]); w1v.y = cvt_pk_bf16(v[10], v[11]); w1v.z = cvt_pk_bf16(v[12], v[13]); w1v.w = cvt_pk_bf16(v[14], v[15]);
        *(u32x4*)dp = w0; *(u32x4*)(dp + 8) = w1v;
    }
}

template <int MODE>
__device__ __forceinline__ void norm_phase(KP p, int layer, bool dry) {
    unsigned char* ws = p.ws; const int tid_ = tid_fresh(); const int lane = tid_ & 63, wid = tid_ >> 6;
    const float* MOD = (const float*)(ws + OFF_MOD); float* CTXS = (float*)(ws + OFF_CTXS); bf16_t* H = (bf16_t*)(ws + OFF_H);
    const int* TOKSL = (const int*)(ws + OFF_TOKSL); const bf16_t* YS = (const bf16_t*)(ws + OFF_REG + M_XG);
    for (int R = blockIdx.x * 8 + wid; R < TALL; R += gridDim.x * 8) {
        const int b = R / TB, t = R - b * TB; const bool isctx = t < NCTX; const int r9 = isctx ? 8 : b;
        if ((MODE == 3 || (MODE == 2 && layer == 1)) && isctx) continue;
        const float* src; float* dstx;
        if (MODE == 0) { src = isctx ? p.in[2] + ctx_off(b, t) : p.in[0] + lat_off(b, t); dstx = nullptr; }
        else { dstx = isctx ? CTXS + ctx_off(b, t) : p.out + lat_off(b, t); src = dstx; }
        f32x4 x[4];
#pragma unroll
        for (int i = 0; i < 4; ++i) x[i] = *(const f32x4*)(src + 256 * i + 4 * lane);
        if (MODE == 1 || MODE == 3) {
            const int pl = (MODE == 1) ? layer - 1 : 1;
            const float* g2 = MOD + ((size_t)pl * 9 + r9) * 6144 + 5120;
            const int sa = TOKSL[R * 2], sb = TOKSL[R * 2 + 1];
#pragma unroll
            for (int i = 0; i < 4; ++i) { const int c = 256 * i + 4 * lane; const u32x2 ya = *(const u32x2*)(YS + (size_t)sa * 1024 + c), yb = *(const u32x2*)(YS + (size_t)sb * 1024 + c); const f32x4 gv = *(const f32x4*)(g2 + c);
                x[i][0] += gv[0] * (bflo(ya.x) + bflo(yb.x)); x[i][1] += gv[1] * (bfhi(ya.x) + bfhi(yb.x)); x[i][2] += gv[2] * (bflo(ya.y) + bflo(yb.y)); x[i][3] += gv[3] * (bfhi(ya.y) + bfhi(yb.y)); }
            if (MODE == 1 && !dry) {
#pragma unroll
                for (int i = 0; i < 4; ++i) *(f32x4*)(dstx + 256 * i + 4 * lane) = x[i];
            }
        }
        float ss = 0.f;
#pragma unroll
        for (int i = 0; i < 4; ++i) ss += x[i][0] * x[i][0] + x[i][1] * x[i][1] + x[i][2] * x[i][2] + x[i][3] * x[i][3];
        ss = wave_sum(ss, lane);
        const float rstd = rsqrtf(ss * (1.0f / 1024.0f) + 1e-6f);
        if (MODE == 3) {
#pragma unroll
            for (int i = 0; i < 4; ++i) { const int c = 256 * i + 4 * lane; const f32x4 g = *(const f32x4*)(p.in[25] + c);
                if (!dry) *(f32x4*)(p.out + lat_off(b, t) + c) = x[i] * rstd * g; }
            continue;
        }
        const float* gain = (MODE == 2 ? p.in[7] : p.in[6]) + layer * 1024;
        const float* mrow = MOD + ((size_t)layer * 9 + r9) * 6144 + (MODE == 2 ? 3072 : 0);
        f32x4 h[4];
#pragma unroll
        for (int i = 0; i < 4; ++i) { const int c = 256 * i + 4 * lane; const f32x4 g = *(const f32x4*)(gain + c), sh = *(const f32x4*)(mrow + c), sc = *(const f32x4*)(mrow + 1024 + c);
            h[i] = (x[i] * rstd * g) * (sc + 1.0f) + sh;
            u32x2 w; w.x = cvt_pk_bf16(h[i][0], h[i][1]); w.y = cvt_pk_bf16(h[i][2], h[i][3]); *(u32x2*)(H + (size_t)R * 1024 + c) = w; }
        if (MODE == 2) {
            const float* WR = (const float*)(ws + OFF_WR) + (size_t)layer * 1024 * 36;
            float a[36];
#pragma unroll
            for (int o = 0; o < 36; ++o) a[o] = 0.f;
#pragma unroll
            for (int i = 0; i < 4; ++i)
#pragma unroll
                for (int jj = 0; jj < 4; ++jj) { const float hv = h[i][jj]; const f32x4* wrow = (const f32x4*)(WR + (size_t)(256 * i + 4 * lane + jj) * 36);
#pragma unroll
                    for (int o4 = 0; o4 < 9; ++o4) { const f32x4 w = wrow[o4]; a[4 * o4] += hv * w[0]; a[4 * o4 + 1] += hv * w[1]; a[4 * o4 + 2] += hv * w[2]; a[4 * o4 + 3] += hv * w[3]; } }
#pragma unroll
            for (int o = 0; o < 36; ++o) a[o] = wave_sum(a[o], lane);
            if (lane == 0) {
                const float* bg = p.in[19] + layer * 4; const float* be = p.in[21] + layer * 32;
                float gl[4];
#pragma unroll
                for (int j = 0; j < 4; ++j) gl[j] = a[j] + bg[j];
                int grp = 0; float gm = gl[0];
#pragma unroll
                for (int j = 1; j < 4; ++j) if (gl[j] > gm) { gm = gl[j]; grp = j; }
                float den = 0.f;
#pragma unroll
                for (int j = 0; j < 4; ++j) den += expf(gl[j] - gm);
                const float gp = 1.0f / den;
                float v1 = -3.0e38f, v2 = -3.0e38f; int i1 = 0, i2 = 0;
#pragma unroll
                for (int j = 0; j < 8; ++j) {
                    const float lv = (grp == 0 ? a[4 + j] : grp == 1 ? a[12 + j] : grp == 2 ? a[20 + j] : a[28 + j]) + be[grp * 8 + j];
                    if (lv > v1) { v2 = v1; i2 = i1; v1 = lv; i1 = j; } else if (lv > v2) { v2 = lv; i2 = j; }
                }
                const float e2 = expf(v2 - v1); const float w1 = gp / (1.0f + e2), w2 = gp * e2 / (1.0f + e2);
                const int ex1 = grp * 8 + i1, ex2 = grp * 8 + i2;
                unsigned* cnt = (unsigned*)(ws + OFF_CNT) + layer * 32;
                const unsigned r1 = atomicAdd(cnt + ex1, 1u), r2 = atomicAdd(cnt + ex2, 1u);
                int* EX = (int*)(ws + OFF_EXPID); float* GW = (float*)(ws + OFF_GATEW); int* RK = (int*)(ws + OFF_RANK);
                EX[R * 2] = ex1; EX[R * 2 + 1] = ex2; GW[R * 2] = w1; GW[R * 2 + 1] = w2; RK[R * 2] = (int)r1; RK[R * 2 + 1] = (int)r2;
            }
        }
    }
}

template <int MODE>
__device__ __forceinline__ void norm_phase2(KP p, int layer, bool dry) {
    unsigned char* ws = p.ws; const int tid_ = tid_fresh(); const int lane = tid_ & 63, wid = tid_ >> 6;
    const float* MOD = (const float*)(ws + OFF_MOD); float* CTXS = (float*)(ws + OFF_CTXS); bf16_t* H = (bf16_t*)(ws + OFF_H);
    const int* TOKSL = (const int*)(ws + OFF_TOKSL); const bf16_t* YS = (const bf16_t*)(ws + OFF_REG + M_XG);
    const int stride = gridDim.x * 8;
    for (int R0 = blockIdx.x * 8 + wid; R0 < TALL; R0 += 2 * stride) {
        int Rr[2], bb[2], tt[2]; bool ok[2], ic[2];
#pragma unroll
        for (int rr = 0; rr < 2; ++rr) { const int R = R0 + rr * stride; ok[rr] = R < TALL; Rr[rr] = ok[rr] ? R : R0; bb[rr] = Rr[rr] / TB; tt[rr] = Rr[rr] - bb[rr] * TB; ic[rr] = tt[rr] < NCTX; if (MODE == 3 && ic[rr]) ok[rr] = false; }
        f32x4 x[2][4]; int sa[2], sb[2];
#pragma unroll
        for (int rr = 0; rr < 2; ++rr) {
            const float* src;
            if (MODE == 0) src = ic[rr] ? p.in[2] + ctx_off(bb[rr], tt[rr]) : p.in[0] + lat_off(bb[rr], tt[rr]);
            else src = ic[rr] ? CTXS + ctx_off(bb[rr], tt[rr]) : p.out + lat_off(bb[rr], tt[rr]);
#pragma unroll
            for (int i = 0; i < 4; ++i) x[rr][i] = *(const f32x4*)(src + 256 * i + 4 * lane);
            if (MODE == 1 || MODE == 3) { sa[rr] = TOKSL[Rr[rr] * 2]; sb[rr] = TOKSL[Rr[rr] * 2 + 1]; }
        }
        u32x2 ya[2][4], yb[2][4];
        if (MODE == 1 || MODE == 3) {
#pragma unroll
            for (int rr = 0; rr < 2; ++rr)
#pragma unroll
                for (int i = 0; i < 4; ++i) { const int c = 256 * i + 4 * lane; ya[rr][i] = *(const u32x2*)(YS + (size_t)sa[rr] * 1024 + c); yb[rr][i] = *(const u32x2*)(YS + (size_t)sb[rr] * 1024 + c); }
        }
#pragma unroll
        for (int rr = 0; rr < 2; ++rr) {
            if (!ok[rr]) continue;
            const int R = Rr[rr], b = bb[rr], t = tt[rr]; const int r9 = ic[rr] ? 8 : b;
            if (MODE == 1 || MODE == 3) {
                const int pl = (MODE == 1) ? layer - 1 : 1;
                const float* g2 = MOD + ((size_t)pl * 9 + r9) * 6144 + 5120;
#pragma unroll
                for (int i = 0; i < 4; ++i) { const int c = 256 * i + 4 * lane; const f32x4 gv = *(const f32x4*)(g2 + c); const u32x2 a = ya[rr][i], b2 = yb[rr][i];
                    x[rr][i][0] += gv[0] * (bflo(a.x) + bflo(b2.x)); x[rr][i][1] += gv[1] * (bfhi(a.x) + bfhi(b2.x)); x[rr][i][2] += gv[2] * (bflo(a.y) + bflo(b2.y)); x[rr][i][3] += gv[3] * (bfhi(a.y) + bfhi(b2.y)); }
                if (MODE == 1 && !dry) { float* dstx = ic[rr] ? CTXS + ctx_off(b, t) : p.out + lat_off(b, t);
#pragma unroll
                    for (int i = 0; i < 4; ++i) *(f32x4*)(dstx + 256 * i + 4 * lane) = x[rr][i]; }
            }
            float ss = 0.f;
#pragma unroll
            for (int i = 0; i < 4; ++i) ss += x[rr][i][0] * x[rr][i][0] + x[rr][i][1] * x[rr][i][1] + x[rr][i][2] * x[rr][i][2] + x[rr][i][3] * x[rr][i][3];
            ss = wave_sum(ss, lane);
            const float rstd = rsqrtf(ss * (1.0f / 1024.0f) + 1e-6f);
            if (MODE == 3) {
#pragma unroll
                for (int i = 0; i < 4; ++i) { const int c = 256 * i + 4 * lane; const f32x4 g = *(const f32x4*)(p.in[25] + c);
                    if (!dry) *(f32x4*)(p.out + lat_off(b, t) + c) = x[rr][i] * rstd * g; }
            } else {
                const float* gain = p.in[6] + layer * 1024;
                const float* mrow = MOD + ((size_t)layer * 9 + r9) * 6144;
#pragma unroll
                for (int i = 0; i < 4; ++i) { const int c = 256 * i + 4 * lane; const f32x4 g = *(const f32x4*)(gain + c), sh = *(const f32x4*)(mrow + c), sc = *(const f32x4*)(mrow + 1024 + c);
                    const f32x4 h = (x[rr][i] * rstd * g) * (sc + 1.0f) + sh;
                    u32x2 w; w.x = cvt_pk_bf16(h[0], h[1]); w.y = cvt_pk_bf16(h[2], h[3]); *(u32x2*)(H + (size_t)R * 1024 + c) = w; }
            }
        }
    }
}

__device__ __forceinline__ void norm2_router(KP p, int layer, LAS unsigned char* lds, bool dry) {
    (void)dry;
    unsigned char* ws = p.ws; const int tid_ = tid_fresh(); const int lane = tid_ & 63, wid = tid_ >> 6, fr = lane & 15, fq = lane >> 4;
    const float* MOD = (const float*)(ws + OFF_MOD); const float* CTXS = (const float*)(ws + OFF_CTXS); bf16_t* H = (bf16_t*)(ws + OFF_H);
    const bf16_t* WH = (const bf16_t*)(ws + OFF_WR) + (size_t)layer * 2 * 48 * 1024; const bf16_t* WL = WH + 48 * 1024;
    LAS float* ssp = (LAS float*)lds;
    LAS float* part = (LAS float*)(lds + 512);
    LAS float* lgf = (LAS float*)(lds + 512 + 8 * 16 * 48 * 4);
    LAS unsigned* lcnt = (LAS unsigned*)(lds + 512 + 8 * 16 * 48 * 4 + 16 * 48 * 4);
    __syncthreads();
    if (tid_ < 64) lcnt[tid_] = 0u;
    __syncthreads();
    const float* gain = p.in[7] + layer * 1024;
    const int cw = 128 * wid + 8 * fq;
    const int ntask = TALL / 16;
    auto xrow = [&](int task) -> const float* { const int R0 = task * 16; const int b = R0 / TB, t = R0 - b * TB; return (t < NCTX ? CTXS + ctx_off(b, t + fr) : p.out + lat_off(b, t + fr)) + cw; };
    auto skip = [&](int task) -> bool { return layer == 1 && ((task * 16) % TB) < NCTX; };
    f32x4 xn[4][2];
    int task = blockIdx.x; while (task < ntask && skip(task)) task += gridDim.x;
    if (task < ntask) { const float* src = xrow(task);
#pragma unroll
        for (int s2 = 0; s2 < 4; ++s2) { xn[s2][0] = *(const f32x4*)(src + 32 * s2); xn[s2][1] = *(const f32x4*)(src + 32 * s2 + 4); } }
    while (task < ntask) {
        const int R0 = task * 16; const int b = R0 / TB, t = R0 - b * TB; const bool isctx = t < NCTX; const int r9 = isctx ? 8 : b;
        f32x4 x[4][2];
#pragma unroll
        for (int s2 = 0; s2 < 4; ++s2) { x[s2][0] = xn[s2][0]; x[s2][1] = xn[s2][1]; }
        int nxt = task + gridDim.x; while (nxt < ntask && skip(nxt)) nxt += gridDim.x;
        if (nxt < ntask) { const float* src = xrow(nxt);
#pragma unroll
            for (int s2 = 0; s2 < 4; ++s2) { xn[s2][0] = *(const f32x4*)(src + 32 * s2); xn[s2][1] = *(const f32x4*)(src + 32 * s2 + 4); } }
        float ss = 0.f;
#pragma unroll
        for (int s2 = 0; s2 < 4; ++s2) { const f32x4 a = x[s2][0], c = x[s2][1]; ss += a[0] * a[0] + a[1] * a[1] + a[2] * a[2] + a[3] * a[3] + c[0] * c[0] + c[1] * c[1] + c[2] * c[2] + c[3] * c[3]; }
        ss += sx(ss, 16, lane); ss += sx(ss, 32, lane);
        if (fq == 0) ssp[wid * 16 + fr] = ss;
        __syncthreads();
        float tot = 0.f;
#pragma unroll
        for (int w2 = 0; w2 < 8; ++w2) tot += ssp[w2 * 16 + fr];
        const float rstd = rsqrtf(tot * (1.0f / 1024.0f) + 1e-6f);
        const float* mrow = MOD + ((size_t)layer * 9 + r9) * 6144 + 3072 + cw;
        const float* grow = gain + cw;
        bf16_t* hrow = H + (size_t)(R0 + fr) * 1024 + cw;
        f32x4 acc[3];
#pragma unroll
        for (int nb = 0; nb < 3; ++nb) acc[nb] = (f32x4){0.f, 0.f, 0.f, 0.f};
#pragma unroll
        for (int s2 = 0; s2 < 4; ++s2) {
            const int c = 32 * s2;
            const f32x4 g0 = *(const f32x4*)(grow + c), g1 = *(const f32x4*)(grow + c + 4);
            const f32x4 sh0 = *(const f32x4*)(mrow + c), sh1 = *(const f32x4*)(mrow + c + 4), sc0 = *(const f32x4*)(mrow + 1024 + c), sc1 = *(const f32x4*)(mrow + 1024 + c + 4);
            const f32x4 h0 = (x[s2][0] * rstd * g0) * (sc0 + 1.0f) + sh0, h1 = (x[s2][1] * rstd * g1) * (sc1 + 1.0f) + sh1;
            u32x4 hw; hw.x = cvt_pk_bf16(h0[0], h0[1]); hw.y = cvt_pk_bf16(h0[2], h0[3]); hw.z = cvt_pk_bf16(h1[0], h1[1]); hw.w = cvt_pk_bf16(h1[2], h1[3]);
            *(u32x4*)(hrow + c) = hw;
            u32x4 lw; lw.x = cvt_pk_bf16(h0[0] - bflo(hw.x), h0[1] - bfhi(hw.x)); lw.y = cvt_pk_bf16(h0[2] - bflo(hw.y), h0[3] - bfhi(hw.y));
            lw.z = cvt_pk_bf16(h1[0] - bflo(hw.z), h1[1] - bfhi(hw.z)); lw.w = cvt_pk_bf16(h1[2] - bflo(hw.w), h1[3] - bfhi(hw.w));
            const bf16x8 ahi = __builtin_bit_cast(bf16x8, hw), alo = __builtin_bit_cast(bf16x8, lw);
#pragma unroll
            for (int nb = 0; nb < 3; ++nb) {
                const bf16x8 bhi = *(const bf16x8*)(WH + (size_t)(16 * nb + fr) * 1024 + cw + c), blo = *(const bf16x8*)(WL + (size_t)(16 * nb + fr) * 1024 + cw + c);
                acc[nb] = __builtin_amdgcn_mfma_f32_16x16x32_bf16(ahi, bhi, acc[nb], 0, 0, 0);
                acc[nb] = __builtin_amdgcn_mfma_f32_16x16x32_bf16(alo, bhi, acc[nb], 0, 0, 0);
                acc[nb] = __builtin_amdgcn_mfma_f32_16x16x32_bf16(ahi, blo, acc[nb], 0, 0, 0);
            }
        }
#pragma unroll
        for (int nb = 0; nb < 3; ++nb)
#pragma unroll
            for (int jj = 0; jj < 4; ++jj) part[(wid * 16 + 4 * fq + jj) * 48 + 16 * nb + fr] = acc[nb][jj];
        __syncthreads();
        for (int e = tid_; e < 16 * 48; e += 512) { float sm = 0.f;
#pragma unroll
            for (int w2 = 0; w2 < 8; ++w2) sm += part[w2 * 16 * 48 + e];
            lgf[e] = sm; }
        __syncthreads();
        if (tid_ < 16) {
            const LAS float* a = lgf + tid_ * 48; const int R = R0 + tid_;
            const float* bg = p.in[19] + layer * 4; const float* be = p.in[21] + layer * 32;
            float gl[4];
#pragma unroll
            for (int j = 0; j < 4; ++j) gl[j] = a[j] + bg[j];
            int grp = 0; float gm = gl[0];
#pragma unroll
            for (int j = 1; j < 4; ++j) if (gl[j] > gm) { gm = gl[j]; grp = j; }
            float den = 0.f;
#pragma unroll
            for (int j = 0; j < 4; ++j) den += expf(gl[j] - gm);
            const float gp = 1.0f / den;
            float v1 = -3.0e38f, v2 = -3.0e38f; int i1 = 0, i2 = 0;
#pragma unroll
            for (int j = 0; j < 8; ++j) { const float lv = a[4 + grp * 8 + j] + be[grp * 8 + j];
                if (lv > v1) { v2 = v1; i2 = i1; v1 = lv; i1 = j; } else if (lv > v2) { v2 = lv; i2 = j; } }
            const float e2 = expf(v2 - v1); const float w1 = gp / (1.0f + e2), w2 = gp * e2 / (1.0f + e2);
            const int ex1 = grp * 8 + i1, ex2 = grp * 8 + i2;
            const unsigned r1 = __hip_atomic_fetch_add(lcnt + ex1, 1u, __ATOMIC_RELAXED, __HIP_MEMORY_SCOPE_WORKGROUP), r2 = __hip_atomic_fetch_add(lcnt + ex2, 1u, __ATOMIC_RELAXED, __HIP_MEMORY_SCOPE_WORKGROUP);
            int* EX = (int*)(ws + OFF_EXPID); float* GW = (float*)(ws + OFF_GATEW); int* RK = (int*)(ws + OFF_RANK);
            EX[R * 2] = ex1; EX[R * 2 + 1] = ex2; GW[R * 2] = w1; GW[R * 2 + 1] = w2; RK[R * 2] = (int)r1; RK[R * 2 + 1] = (int)r2;
        }
        task = nxt;
    }
    __syncthreads();
    if (tid_ < 32) { unsigned* cnt = (unsigned*)(ws + OFF_CNT) + layer * 32; const unsigned c = lcnt[tid_]; lcnt[32 + tid_] = c ? atomicAdd(cnt + tid_, c) : 0u; }
    __syncthreads();
    if (tid_ < 16) {
        int* EX = (int*)(ws + OFF_EXPID); int* RK = (int*)(ws + OFF_RANK);
        for (int tk = blockIdx.x; tk < ntask; tk += gridDim.x) {
            if (skip(tk)) continue;
            const int R = tk * 16 + tid_;
            RK[R * 2] += (int)lcnt[32 + EX[R * 2]]; RK[R * 2 + 1] += (int)lcnt[32 + EX[R * 2 + 1]];
        }
    }
}

__device__ __forceinline__ void moe_table(KP p, int layer, LAS int* tab) {
    if (tid_fresh() == 0) {
        const unsigned* cnt = (const unsigned*)(p.ws + OFF_CNT) + layer * 32; int s = 0, tl = 0;
        for (int e = 0; e < 32; ++e) { const int c = (int)__hip_atomic_load(cnt + e, __ATOMIC_RELAXED, __HIP_MEMORY_SCOPE_AGENT); tab[e] = c; tab[32 + e] = s; tab[64 + e] = tl; s += c; tl += (c + 255) >> 8; }
        tab[96] = tl;
    }
    __syncthreads();
}
__device__ __forceinline__ void dispatch_phase(KP p, int layer, LAS int* tab) {
    unsigned char* ws = p.ws; const int tid_ = tid_fresh();
    moe_table(p, layer, tab);
    const int* EX = (const int*)(ws + OFF_EXPID); const float* GW = (const float*)(ws + OFF_GATEW); const int* RK = (const int*)(ws + OFF_RANK);
    int* TOKSL = (int*)(ws + OFF_TOKSL); float* SLOTW = (float*)(ws + OFF_SLOTW); int* SLOTTOK = (int*)(ws + OFF_SLOTTOK);
    for (int idx = blockIdx.x * 512 + tid_; idx < TALL * 2; idx += gridDim.x * 512) {
        const int R = idx >> 1;
        if (layer == 1 && (R % TB) < NCTX) continue;
        const int slot = tab[32 + EX[idx]] + RK[idx];
        TOKSL[idx] = slot; SLOTW[slot] = GW[idx]; SLOTTOK[slot] = R;
    }
}
__device__ __forceinline__ void moe_unit_table(const LAS int* tab, LAS int* uinf, int npn) {
    const int tid_ = tid_fresh();
    const int ntile = tab[96];
    if (tid_ < 22) {
        const int L = tid_ * (int)gridDim.x + (int)blockIdx.x; int s0 = -1, vl = 0, e = 0;
        if (L < ntile * npn) { const int tg = L / npn;
#pragma unroll 1
            for (int j = 1; j < 32; ++j) e = (tab[64 + j] <= tg) ? j : e;
            const int mt = tg - tab[64 + e]; s0 = tab[32 + e] + 256 * mt; vl = tab[e] - 256 * mt; }
        uinf[4 * tid_] = s0; uinf[4 * tid_ + 1] = vl; uinf[4 * tid_ + 2] = e; uinf[4 * tid_ + 3] = 0;
    }
    __syncthreads();
}
__device__ __forceinline__ void moe_tok_table(KP p, const LAS int* tab, LAS int* tok) {
    const int tid_ = tid_fresh(); const int* SLOTTOK = (const int*)(p.ws + OFF_SLOTTOK);
    LAS int* uinf = tok + 22 * 256;
    moe_unit_table(tab, uinf, 8);
    int tv[11];
#pragma unroll
    for (int k = 0; k < 11; ++k) { const int j = tid_ + 512 * k; const int i = j >> 8, r = j & 255; const int s0 = uinf[4 * i], vl = uinf[4 * i + 1];
        tv[k] = SLOTTOK[s0 >= 0 ? s0 + (r < vl ? r : 0) : 0]; }
#pragma unroll
    for (int k = 0; k < 11; ++k) { const int j = tid_ + 512 * k; if (uinf[4 * (j >> 8)] >= 0) tok[j] = tv[k]; }
    __syncthreads();
}

__device__ __forceinline__ void gate_phase(KP p, int layer, int g, LAS unsigned char* lds) {
    unsigned char* reg = p.ws + OFF_REG; const int tid = tid_fresh();
    const bf16_t* GQK = (const bf16_t*)(reg + R_GQK); bf16_t* GIN = (bf16_t*)(reg + R_GIN); float* GDEC = (float*)(reg + R_GDEC); const float* GLR = (const float*)(reg + R_GLR);
    LAS float* lr = (LAS float*)lds;
    const float* wa = p.in[9] + (size_t)layer * 2 * 16 * 512; const float* ba = p.in[10] + layer * 2 * 512;
    for (int u = blockIdx.x; u < BG * NCH * 2; u += gridDim.x) {
        const int dir = u & 1, rest = u >> 1, bl = rest / NCH, ch = rest - bl * NCH; const int r0 = bl * TB + ch * CH;
        float w[16];
#pragma unroll
        for (int r = 0; r < 16; ++r) w[r] = wa[(dir * 16 + r) * 512 + tid] * LOG2E;
        const float bav = ba[dir * 512 + tid] * LOG2E;
        __syncthreads();
        for (int e = tid; e < 64 * 16; e += 512) lr[e] = GLR[(size_t)(r0 + (e >> 4)) * 32 + dir * 16 + (e & 15)];
        __syncthreads();
        bf16_t* GO = GIN + (size_t)dir * TG * 1024;
        float cum = 0.f;
#pragma unroll 1
        for (int hh = 0; hh < 2; ++hh) {
            unsigned short qv[32], kv[32];
#pragma unroll
            for (int s2 = 0; s2 < 32; ++s2) { const int st = hh * 32 + s2; const int j = dir ? CH - 1 - st : st; const size_t ro = (size_t)(r0 + j) * 1024; qv[s2] = GQK[ro + tid]; kv[s2] = GQK[ro + 512 + tid]; }
#pragma unroll
            for (int s2 = 0; s2 < 32; ++s2) {
                const int st = hh * 32 + s2; const int j = dir ? CH - 1 - st : st;
                const LAS f32x4* l4 = (const LAS f32x4*)(lr + j * 16);
                const f32x4 a0 = l4[0], a1 = l4[1], a2 = l4[2], a3 = l4[3];
                float z = bav;
                z += a0[0] * w[0] + a0[1] * w[1] + a0[2] * w[2] + a0[3] * w[3] + a1[0] * w[4] + a1[1] * w[5] + a1[2] * w[6] + a1[3] * w[7]
                   + a2[0] * w[8] + a2[1] * w[9] + a2[2] * w[10] + a2[3] * w[11] + a3[0] * w[12] + a3[1] * w[13] + a3[2] * w[14] + a3[3] * w[15];
                const float la = -(fmaxf(-z, 0.f) + __builtin_amdgcn_logf(1.0f + __builtin_amdgcn_exp2f(-fabsf(z)))) * (1.0f / 16.0f);
                cum += la; const float e = __builtin_amdgcn_exp2f(cum), ei = __builtin_amdgcn_exp2f(-cum);
                const size_t ro = (size_t)(r0 + j) * 1024;
                GO[ro + tid] = f2bf(bf2f(qv[s2]) * e); GO[ro + 512 + tid] = f2bf(bf2f(kv[s2]) * ei);
            }
        }
        GDEC[((size_t)(dir * BG + bl) * NCH + ch) * 512 + tid] = __builtin_amdgcn_exp2f(cum);
    }
}
__device__ __forceinline__ void stats_phase(KP p, int g, bool dry) {
    unsigned char* reg = p.ws + OFF_REG; const int tid_ = tid_fresh(); const int lane = tid_ & 63, wid = tid_ >> 6;
    f32x2* ST = (f32x2*)(p.ws + OFF_STATS);
    const int stride = gridDim.x * 8;
    for (int R0 = blockIdx.x * 8 + wid; R0 < TG; R0 += 2 * stride) {
        const int R1 = R0 + stride; const bool two = R1 < TG; const int R1c = two ? R1 : R0;
        u32x2 av[2][2][4], bv[2][2][4];
#pragma unroll
        for (int rr = 0; rr < 2; ++rr)
#pragma unroll
            for (int mix = 0; mix < 2; ++mix) {
                const bf16_t* of = (const bf16_t*)(reg + (mix ? R_ORF : R_OGF)) + (size_t)(rr ? R1c : R0) * 1024; const bf16_t* ob = (const bf16_t*)(reg + (mix ? R_ORB : R_OGB)) + (size_t)(rr ? R1c : R0) * 1024;
#pragma unroll
                for (int i = 0; i < 4; ++i) { av[rr][mix][i] = *(const u32x2*)(of + 256 * i + 4 * lane); bv[rr][mix][i] = *(const u32x2*)(ob + 256 * i + 4 * lane); }
            }
#pragma unroll
        for (int rr = 0; rr < 2; ++rr) {
            if (rr == 1 && !two) break;
            const int R = rr ? R1 : R0;
#pragma unroll
            for (int mix = 0; mix < 2; ++mix) {
                bf16_t* of = (bf16_t*)(reg + (mix ? R_ORF : R_OGF)) + (size_t)R * 1024;
#pragma unroll
                for (int i = 0; i < 4; ++i) {
                    const int c = 256 * i + 4 * lane; const u32x2 a = av[rr][mix][i], b2 = bv[rr][mix][i];
                    const float o0 = bflo(a.x) + bflo(b2.x), o1 = bfhi(a.x) + bfhi(b2.x), o2 = bflo(a.y) + bflo(b2.y), o3 = bfhi(a.y) + bfhi(b2.y);
                    const float mean = wave_sum(o0 + o1 + o2 + o3, lane) * (1.0f / 256.0f);
                    const float d0 = o0 - mean, d1 = o1 - mean, d2 = o2 - mean, d3 = o3 - mean;
                    const float var = wave_sum(d0 * d0 + d1 * d1 + d2 * d2 + d3 * d3, lane) * (1.0f / 256.0f);
                    u32x2 w; w.x = cvt_pk_bf16(o0, o1); w.y = cvt_pk_bf16(o2, o3); if (!dry) *(u32x2*)(of + c) = w;
                    if (lane == 0) ST[((size_t)mix * TG + R) * 4 + i] = (f32x2){mean, rsqrtf(var + 1e-6f)};
                }
            }
        }
    }
}

#if 1
__device__ __forceinline__ void scan_naive(KP p, int layer, int g, LAS unsigned char* lds) {
    unsigned char* reg = p.ws + OFF_REG; const int tid = tid_fresh(), sub = tid >> 8, e = tid & 255;
    LAS float* sh = (LAS float*)lds + sub * 512;
    for (int u = blockIdx.x; u < 32; u += gridDim.x) {
        const int chain = u * 2 + sub; const int dir = chain & 1, h = (chain >> 1) & 3, bl = (chain >> 3) & 3, mix = chain >> 5;
        if (!SCAN_E1 && ((SCAN_MASK >> (mix * 2 + dir)) & 1)) continue;
        const bf16_t* QK = (const bf16_t*)(reg + (mix ? R_RQK : R_GQK)); const bf16_t* VT = (const bf16_t*)(reg + (mix ? R_RVT : R_GVT));
        bf16_t* O = (bf16_t*)(reg + (mix ? (dir ? R_ORB : R_ORF) : (dir ? R_OGB : R_OGF)));
        const float* GLR = (const float*)(reg + R_GLR);
        float wa[16]; float bav = 0.f;
        if (e < 128) {
#pragma unroll
            for (int r = 0; r < 16; ++r) wa[r] = p.in[9][(((size_t)layer * 2 + dir) * 16 + r) * 512 + h * 128 + e];
            bav = p.in[10][((size_t)layer * 2 + dir) * 512 + h * 128 + e];
        }
        const float gam = 1.0f - exp2f(-5.0f - (float)h);
        float S[128];
#pragma unroll
        for (int d = 0; d < 128; ++d) S[d] = 0.f;
        const bf16_t* vrow = VT + ((size_t)bl * 1024 + h * 256 + e) * TB;
        for (int s = 0; s < TB; ++s) {
            const int t = dir == 0 ? s : (s < NCTX ? NCTX - 1 - s : TB - 1 - (s - NCTX));
            const size_t ro = (size_t)(bl * TB + t);
            __syncthreads();
            if (e < 128) {
                sh[e] = bf2f(QK[ro * 1024 + h * 128 + e]); sh[128 + e] = bf2f(QK[ro * 1024 + 512 + h * 128 + e]);
                float a;
                if (mix == 0) { float z = bav;
#pragma unroll
                    for (int r = 0; r < 16; ++r) z += GLR[ro * 32 + dir * 16 + r] * wa[r];
                    a = expf(-(fmaxf(-z, 0.f) + log1pf(expf(-fabsf(z)))) * (1.0f / 16.0f)); }
                else a = gam;
                sh[256 + e] = a;
            }
            __syncthreads();
            const float v = bf2f(vrow[t]);
            float o = 0.f;
            if (dir == 0) {
#pragma unroll
                for (int d = 0; d < 128; ++d) { S[d] = sh[256 + d] * S[d] + sh[128 + d] * v; o += sh[d] * S[d]; }
            } else {
#pragma unroll
                for (int d = 0; d < 128; ++d) { const float sd = sh[256 + d] * S[d]; o += sh[d] * sd; S[d] = sd + sh[128 + d] * v; }
            }
            O[ro * 1024 + h * 256 + e] = f2bf(o);
        }
    }
}
#endif


#if 1
constexpr int SC_QS = 272, SC_VS = 144;
constexpr int SC_QB = 0, SC_KB = SC_QB + 2 * 64 * SC_QS, SC_VB = SC_KB + 2 * 64 * SC_QS, SC_ST = SC_VB + 2 * 64 * SC_VS,
              SC_DEC = SC_ST + 2 * 64 * SC_QS, SC_SCL = SC_DEC + 2 * 128 * 4, SC_END = SC_SCL + 128 * 4, SC_PB = 132096, SC_OB = SC_PB + 64 * SC_VS;
static_assert(SC_OB + 64 * SC_VS <= LDS_BYTES, "scan LDS tail");
static_assert(SC_END <= 131072, "scan LDS");
__device__ __forceinline__ u32x4 scale8(u32x4 v, float s) {
    u32x4 r; r.x = cvt_pk_bf16(bflo(v.x) * s, bfhi(v.x) * s); r.y = cvt_pk_bf16(bflo(v.y) * s, bfhi(v.y) * s); r.z = cvt_pk_bf16(bflo(v.z) * s, bfhi(v.z) * s); r.w = cvt_pk_bf16(bflo(v.w) * s, bfhi(v.w) * s); return r;
}
__device__ __forceinline__ void scan_mfma(KP p, int layer, int g, LAS unsigned char* lds, bool cmp_mode) {
    unsigned char* reg = p.ws + OFF_REG; const int tid = tid_fresh(), wid = tid >> 6, lane = tid & 63, fr = lane & 15, fq = lane >> 4;
#if SCAN_DELAY
    { const long long t0_ = clock64(); while (clock64() - t0_ < 4000000ll) __builtin_amdgcn_s_sleep(8); }
#endif
    for (int u = blockIdx.x; u < 256; u += gridDim.x) {
        const int dvq = (u >> 3) & 3, chain = (u & 7) + 8 * (u >> 5); const int dir = chain & 1, h = (chain >> 1) & 3, bl = (chain >> 3) & 3, mix = chain >> 5;
        if (!((SCAN_MASK >> (mix * 2 + dir)) & 1)) continue;
        const bf16_t* QI; const bf16_t* KI;
        if (mix == 0) { QI = (const bf16_t*)(reg + R_GIN) + (size_t)dir * TG * 1024; KI = QI + 512; } else { QI = (const bf16_t*)(reg + R_RQK); KI = QI + 512; }
        const bf16_t* VT = (const bf16_t*)(reg + (mix ? R_RVT : R_GVT)) + ((size_t)bl * 1024 + h * 256 + dvq * 64) * TB;
        bf16_t* O = (bf16_t*)(reg + (mix ? (dir ? R_ORB : R_ORF) : (dir ? R_OGB : R_OGF)));
        const float* GDEC = (const float*)(reg + R_GDEC) + ((size_t)(dir * BG + bl) * NCH) * 512 + h * 128;
        const float lam = logf(1.0f - exp2f(-5.0f - (float)h));
        __syncthreads();
        for (int e = tid; e < 2 * 64 * SC_QS / 16; e += 512) *(LAS u32x4*)(lds + SC_ST + e * 16) = (u32x4){0u, 0u, 0u, 0u};
        __syncthreads();
        const bool po = wid < 4; const int wq = wid & 3, t2_ = tid & 255;
        const int jb2 = 2 * (wq & 1), ib2 = 2 * (wq >> 1);
        const int db2 = 2 * wq;
        f32x4 R[8];
#pragma unroll
        for (int x = 0; x < 8; ++x) R[x] = (f32x4){0.f, 0.f, 0.f, 0.f};
        const int qrow0 = t2_ >> 4, qc8 = t2_ & 15;
        const int ve = t2_ >> 3, vj8 = t2_ & 7;
        u32x4 rq[4], rk[4], rv[2]; float rdec = 0.f;
        const float rdecay = expf(64.0f * lam);
        auto chunk_of = [&](int s) { return dir == 0 ? s : (s < 4 ? 3 - s : 131 - (s - 4)); };
        auto gload = [&](int ch) {
            const size_t r0 = (size_t)bl * TB + (size_t)ch * CH;
#pragma unroll
            for (int x = 0; x < 4; ++x) { const size_t ro = (r0 + qrow0 + 16 * x) * 1024 + h * 128 + qc8 * 8; rq[x] = *(const u32x4*)(QI + ro); rk[x] = *(const u32x4*)(KI + ro); }
#pragma unroll
            for (int x = 0; x < 2; ++x) rv[x] = *(const u32x4*)(VT + (size_t)(ve + 32 * x) * TB + ch * CH + vj8 * 8);
            const float gd = GDEC[(size_t)ch * 512 + (t2_ & 127)];
            rdec = mix ? rdecay : gd;
        };
        const float vs0 = mix ? expf(-(dir == 0 ? (float)(vj8 * 8 + 1) : (float)(64 - vj8 * 8)) * lam) : 1.0f;
        const float rr = mix ? expf(dir == 0 ? -lam : lam) : 1.0f; const float vs1 = vs0 * rr, rr2 = rr * rr;
        auto lstore = [&](int buf) {
#pragma unroll
            for (int x = 0; x < 4; ++x) {
                *(LAS u32x4*)(lds + SC_QB + buf * 64 * SC_QS + (qrow0 + 16 * x) * SC_QS + qc8 * 16) = rq[x];
                *(LAS u32x4*)(lds + SC_KB + buf * 64 * SC_QS + (qrow0 + 16 * x) * SC_QS + qc8 * 16) = rk[x]; }
#pragma unroll
            for (int x = 0; x < 2; ++x) { const u32x4 r = rv[x];
                float fa = vs0, fb = vs1; u32x4 v2; v2.x = cvt_pk_bf16(bflo(r.x) * fa, bfhi(r.x) * fb); fa *= rr2; fb *= rr2; v2.y = cvt_pk_bf16(bflo(r.y) * fa, bfhi(r.y) * fb); fa *= rr2; fb *= rr2;
                v2.z = cvt_pk_bf16(bflo(r.z) * fa, bfhi(r.z) * fb); fa *= rr2; fb *= rr2; v2.w = cvt_pk_bf16(bflo(r.w) * fa, bfhi(r.w) * fb);
                *(LAS u32x4*)(lds + SC_VB + buf * 64 * SC_VS + (ve + 32 * x) * SC_VS + vj8 * 16) = v2; }
            if (t2_ < 128) ((LAS float*)(lds + SC_DEC))[buf * 128 + t2_] = rdec;
        };
        if (!po) { gload(chunk_of(0)); lstore(0); gload(chunk_of(1)); }
        __syncthreads();
        float fo[2];
#pragma unroll
        for (int x = 0; x < 2; ++x) { const int i = 16 * (ib2 + x) + fr; fo[x] = mix ? expf((dir == 0 ? (float)(i + 1) : (float)(64 - i)) * lam) : 1.0f; }
        auto ostore = [&](int chp, int ob) {
            const size_t r0 = (size_t)bl * TB + (size_t)chp * CH;
#pragma unroll
            for (int k = 0; k < 2; ++k) { const int i = 32 * k + (t2_ >> 3);
                const u32x4 v = *(const LAS u32x4*)(lds + SC_PB + ob * 64 * SC_VS + i * SC_VS + (t2_ & 7) * 16);
                *(u32x4*)(O + (r0 + i) * 1024 + h * 256 + dvq * 64 + (t2_ & 7) * 8) = v; }
        };
        const int ebp = 2 * (wq & 1);
        for (int s = 0; s < NCH; ++s) {
            const int cur = s & 1, stb = s & 1;
            const LAS unsigned char* Qc = lds + SC_QB + cur * 64 * SC_QS; const LAS unsigned char* Kc = lds + SC_KB + cur * 64 * SC_QS; const LAS unsigned char* Vc = lds + SC_VB + cur * 64 * SC_VS;
            if (po) {
#pragma unroll
                for (int x = 0; x < 2; ++x)
#pragma unroll
                    for (int ks = 0; ks < 4; ++ks) R[4 * x + ks] = __builtin_bit_cast(f32x4, *(const LAS bf16x8*)(Qc + (16 * (ib2 + x) + fr) * SC_QS + ks * 64 + fq * 16));
                bf16x8 pb[2][2];
#pragma unroll
                for (int s2 = 0; s2 < 2; ++s2) {
                    bf16x8 kfr[2][4];
#pragma unroll
                    for (int y = 0; y < 2; ++y)
#pragma unroll
                        for (int ks = 0; ks < 4; ++ks) kfr[y][ks] = *(const LAS bf16x8*)(Kc + (16 * (2 * s2 + y) + fr) * SC_QS + ks * 64 + fq * 16);
                    __builtin_amdgcn_sched_barrier(0);
                    f32x4 c[2][2];
#pragma unroll
                    for (int y = 0; y < 2; ++y)
#pragma unroll
                        for (int x = 0; x < 2; ++x) c[y][x] = (f32x4){0.f, 0.f, 0.f, 0.f};
#pragma unroll
                    for (int ks = 0; ks < 4; ++ks)
#pragma unroll
                        for (int y = 0; y < 2; ++y)
#pragma unroll
                            for (int x = 0; x < 2; ++x) c[y][x] = __builtin_amdgcn_mfma_f32_16x16x32_bf16(kfr[y][ks], __builtin_bit_cast(bf16x8, R[4 * x + ks]), c[y][x], 0, 0, 0);
#pragma unroll
                    for (int x = 0; x < 2; ++x) { const int i = 16 * (ib2 + x) + fr; u32x4 w4;
#pragma unroll
                        for (int y = 0; y < 2; ++y) { const int j0 = 16 * (2 * s2 + y) + 4 * fq; float v[4];
#pragma unroll
                            for (int jj = 0; jj < 4; ++jj) { const int j = j0 + jj; const bool keep = dir == 0 ? (j <= i) : (j > i); v[jj] = keep ? c[y][x][jj] : 0.f; }
                            if (y == 0) { w4.x = cvt_pk_bf16(v[0], v[1]); w4.y = cvt_pk_bf16(v[2], v[3]); } else { w4.z = cvt_pk_bf16(v[0], v[1]); w4.w = cvt_pk_bf16(v[2], v[3]); } }
                        pb[x][s2] = __builtin_bit_cast(bf16x8, w4); }
                }
                bf16x8 va[2][2], st[2][4];
#pragma unroll
                for (int y = 0; y < 2; ++y)
#pragma unroll
                    for (int s2 = 0; s2 < 2; ++s2) {
                        const u32x2 lo = *(const LAS u32x2*)(Vc + (16 * (ebp + y) + fr) * SC_VS + (32 * s2 + 4 * fq) * 2), hi = *(const LAS u32x2*)(Vc + (16 * (ebp + y) + fr) * SC_VS + (32 * s2 + 16 + 4 * fq) * 2);
                        va[y][s2] = __builtin_bit_cast(bf16x8, (u32x4){lo.x, lo.y, hi.x, hi.y}); }
#pragma unroll
                for (int y = 0; y < 2; ++y)
#pragma unroll
                    for (int ks = 0; ks < 4; ++ks) st[y][ks] = *(const LAS bf16x8*)(lds + SC_ST + stb * 64 * SC_QS + (16 * (ebp + y) + fr) * SC_QS + ks * 64 + fq * 16);
                __builtin_amdgcn_sched_barrier(0);
                f32x4 co[2][2];
#pragma unroll
                for (int y = 0; y < 2; ++y)
#pragma unroll
                    for (int x = 0; x < 2; ++x) co[y][x] = (f32x4){0.f, 0.f, 0.f, 0.f};
#pragma unroll
                for (int ks = 0; ks < 4; ++ks)
#pragma unroll
                    for (int y = 0; y < 2; ++y)
#pragma unroll
                        for (int x = 0; x < 2; ++x) co[y][x] = __builtin_amdgcn_mfma_f32_16x16x32_bf16(st[y][ks], __builtin_bit_cast(bf16x8, R[4 * x + ks]), co[y][x], 0, 0, 0);
#pragma unroll
                for (int s2 = 0; s2 < 2; ++s2)
#pragma unroll
                    for (int y = 0; y < 2; ++y)
#pragma unroll
                        for (int x = 0; x < 2; ++x) co[y][x] = __builtin_amdgcn_mfma_f32_16x16x32_bf16(va[y][s2], pb[x][s2], co[y][x], 0, 0, 0);
#pragma unroll
                for (int y = 0; y < 2; ++y)
#pragma unroll
                    for (int x = 0; x < 2; ++x) { const f32x4 cc = co[y][x] * fo[x]; const int i = 16 * (ib2 + x) + fr;
                        u32x2 w; w.x = cvt_pk_bf16(cc[0], cc[1]); w.y = cvt_pk_bf16(cc[2], cc[3]);
                        *(LAS u32x2*)(lds + SC_PB + (s & 1) * 64 * SC_VS + i * SC_VS + (16 * (ebp + y) + 4 * fq) * 2) = w; }
            } else {
                if (s > 0) ostore(chunk_of(s - 1), (s - 1) & 1);
                bf16x8 ka[2][2], vb[2][4];
#pragma unroll
                for (int x = 0; x < 2; ++x)
#pragma unroll
                    for (int ks = 0; ks < 2; ++ks) {
                        typedef short s16x4_t __attribute__((ext_vector_type(4)));
                        const LAS unsigned char* tp = Kc + (32 * ks + 8 * fq + (fr >> 2)) * SC_QS + (16 * (db2 + x) + 4 * (fr & 3)) * 2;
                        const s16x4_t t0 = __builtin_amdgcn_ds_read_tr16_b64_v4i16((LAS s16x4_t*)tp), t1 = __builtin_amdgcn_ds_read_tr16_b64_v4i16((LAS s16x4_t*)(tp + 4 * SC_QS));
                        ka[x][ks] = (bf16x8){t0[0], t0[1], t0[2], t0[3], t1[0], t1[1], t1[2], t1[3]};
                    }
#pragma unroll
                for (int ks = 0; ks < 2; ++ks)
#pragma unroll
                    for (int eb = 0; eb < 4; ++eb) vb[ks][eb] = *(const LAS bf16x8*)(Vc + (16 * eb + fr) * SC_VS + ks * 64 + fq * 16);
                f32x4 dv[2];
#pragma unroll
                for (int x = 0; x < 2; ++x) dv[x] = *(const LAS f32x4*)(lds + SC_DEC + (cur * 128 + 16 * (db2 + x) + 4 * fq) * 4);
                __builtin_amdgcn_sched_barrier(0);
#pragma unroll
                for (int ks = 0; ks < 2; ++ks)
#pragma unroll
                    for (int x = 0; x < 2; ++x)
#pragma unroll
                        for (int eb = 0; eb < 4; ++eb) R[4 * x + eb] = __builtin_amdgcn_mfma_f32_16x16x32_bf16(ka[x][ks], vb[ks][eb], R[4 * x + eb], 0, 0, 0);
#pragma unroll
                for (int x = 0; x < 2; ++x)
#pragma unroll
                    for (int eb = 0; eb < 4; ++eb) { const f32x4 sv = R[4 * x + eb] * dv[x]; R[4 * x + eb] = sv;
                        u32x2 w; w.x = cvt_pk_bf16(sv[0], sv[1]); w.y = cvt_pk_bf16(sv[2], sv[3]);
                        *(LAS u32x2*)(lds + SC_ST + (stb ^ 1) * 64 * SC_QS + (16 * eb + fr) * SC_QS + (16 * (db2 + x) + 4 * fq) * 2) = w; }
                lstore(cur ^ 1);
                gload(chunk_of(s + 2 < NCH ? s + 2 : NCH - 1));
            }
            __syncthreads();
        }
        if (!po) ostore(chunk_of(NCH - 1), (NCH - 1) & 1);
    }
}
#endif

#if NAIVE_ATTN
__device__ __forceinline__ void attn_naive(KP p, int layer, int g, LAS unsigned char* lds) {
    unsigned char* reg = p.ws + OFF_REG; const int tid_ = tid_fresh(); const int lane = tid_ & 63, wid = tid_ >> 6;
    bf16_t* AQ = (bf16_t*)(reg + R_AQ); const bf16_t* AK = (const bf16_t*)(reg + R_AK); const bf16_t* AVT = (const bf16_t*)(reg + R_AVT);
    LAS float* qs = (LAS float*)lds + wid * 1024; LAS float* ps = qs + 128;
    for (int u = blockIdx.x; u < TG / 64; u += gridDim.x) {
#pragma unroll 1
        for (int pr = wid; pr < 512; pr += 8) {
            const int R = u * 64 + (pr >> 3), hq = pr & 7, hkv = hq >> 2; const int bl = R / TB, t = R - bl * TB;
            { const unsigned w = *(const unsigned*)(AQ + (size_t)R * 1024 + hq * 128 + 2 * lane); qs[2 * lane] = bflo(w); qs[2 * lane + 1] = bfhi(w); }
            const bool lat = t >= NCTX; const int i = t - NCTX;
            const int jlo = lat ? (i - 128 < 0 ? 0 : i - 128) : 0, jhi = lat ? (i + 128 > LSEQ - 1 ? LSEQ - 1 : i + 128) : -1;
            const float sink2 = p.in[12][layer * 8 + hq] * LOG2E;
            float mx = sink2;
#pragma unroll 1
            for (int rd = 0; rd < 9; ++rd) {
                int key; bool valid;
                if (rd < 4) { key = rd * 64 + lane; valid = true; } else { const int j = jlo + (rd - 4) * 64 + lane; key = NCTX + j; valid = j <= jhi; }
                float s = -3.0e38f;
                if (valid) { const bf16_t* kr = AK + (size_t)(bl * TB + key) * 256 + hkv * 128; s = 0.f;
#pragma unroll 4
                    for (int d8 = 0; d8 < 16; ++d8) { const u32x4 kv = *(const u32x4*)(kr + d8 * 8); const LAS float* q = qs + d8 * 8;
                        s += q[0] * bflo(kv.x) + q[1] * bfhi(kv.x) + q[2] * bflo(kv.y) + q[3] * bfhi(kv.y) + q[4] * bflo(kv.z) + q[5] * bfhi(kv.z) + q[6] * bflo(kv.w) + q[7] * bfhi(kv.w); } }
                ps[rd * 64 + lane] = s; mx = fmaxf(mx, s);
            }
            mx = wave_max(mx, lane);
            float sum = 0.f;
#pragma unroll 1
            for (int rd = 0; rd < 9; ++rd) { const float sv = ps[rd * 64 + lane]; const float pv = sv > -1.0e38f ? exp2f(sv - mx) : 0.f; ps[rd * 64 + lane] = pv; sum += pv; }
            sum = wave_sum(sum, lane) + exp2f(sink2 - mx);
            const float inv = 1.0f / sum;
            float o0 = 0.f, o1 = 0.f;
            const bf16_t* v0 = AVT + ((size_t)bl * 256 + hkv * 128 + 2 * lane) * TB; const bf16_t* v1 = v0 + TB;
#pragma unroll 4
            for (int k = 0; k < NCTX; ++k) { const float pv = ps[k]; o0 += pv * bf2f(v0[k]); o1 += pv * bf2f(v1[k]); }
#pragma unroll 4
            for (int j = jlo; j <= jhi; ++j) { const float pv = ps[256 + (j - jlo)]; o0 += pv * bf2f(v0[NCTX + j]); o1 += pv * bf2f(v1[NCTX + j]); }
            *(unsigned*)(AQ + (size_t)R * 1024 + hq * 128 + 2 * lane) = cvt_pk_bf16(o0 * inv, o1 * inv);
        }
    }
}
#endif


#if !NAIVE_ATTN
constexpr int AT_KS = 272, AT_VS = 144;
constexpr int AT_KB = 0, AT_VB = AT_KB + 2 * 64 * AT_KS, AT_END = AT_VB + 2 * 128 * AT_VS;
static_assert(AT_END <= 131072, "attn LDS");
__device__ __forceinline__ void attn_mfma(KP p, int layer, int g, LAS unsigned char* lds, bool to_spare) {
    unsigned char* reg = p.ws + OFF_REG; const int tid = tid_fresh(), wid = tid >> 6, lane = tid & 63, fr = lane & 15, fq = lane >> 4;
    bf16_t* AQ = (bf16_t*)(reg + R_AQ); const bf16_t* AK = (const bf16_t*)(reg + R_AK); const bf16_t* AVT = (const bf16_t*)(reg + R_AVT);
    const int nqb = layer == 1 ? NCH - 4 : NCH;
    const int nunits = BG * 2 * nqb;
    for (int it = 0;; ++it) {
        const int u = gridDim.x == 256 ? (it * 8 + (int)(blockIdx.x & 7)) * 32 + (int)(blockIdx.x >> 3) : it * (int)gridDim.x + (int)blockIdx.x;
        if (gridDim.x == 256 ? (it * 256 >= nunits) : (u >= nunits)) break;
        if (u >= nunits) continue;
        const int qblk = u < 1024 ? 4 + (u & 127) : (u & 3), hkv = u < 1024 ? (u >> 7) & 1 : (u >> 2) & 1, bl = u < 1024 ? u >> 8 : (u - 1024) >> 3;
        const int t0 = qblk * 64; const bool isctx = t0 < NCTX;
        const int hq = hkv * 4 + (wid >> 1); const int qoff = (wid & 1) * 32;
        const size_t qrow0 = (size_t)bl * TB + t0 + qoff;
        bf16x8 qf[2][4];
#pragma unroll
        for (int qb = 0; qb < 2; ++qb)
#pragma unroll
            for (int ks = 0; ks < 4; ++ks) qf[qb][ks] = *(const bf16x8*)(AQ + (qrow0 + 16 * qb + fr) * 1024 + hq * 128 + 32 * ks + 8 * fq);
        int mlo = 0, nloc = 0;
        if (!isctx) { mlo = (384 - t0) > 0 ? (384 - t0) / 64 : 0; int mhi = (TB + 64 - t0) / 64; mhi = mhi > 4 ? 4 : mhi; nloc = mhi - mlo + 1; }
        const int ntile = 4 + nloc;
        const float sink2 = p.in[12][layer * 8 + hq] * LOG2E;
        float mrun[2], lrun[2];
        mrun[0] = mrun[1] = sink2; lrun[0] = lrun[1] = (fq == 0) ? 1.0f : 0.0f;
        f32x4 oT[8][2];
#pragma unroll
        for (int db = 0; db < 8; ++db) { oT[db][0] = (f32x4){0.f, 0.f, 0.f, 0.f}; oT[db][1] = oT[db][0]; }
        const int krow = tid >> 4, kc = tid & 15;
        const int vrow = tid >> 3, vc = tid & 7;
        u32x4 rk[2], rv[2];
        auto tile_tok = [&](int ti) { return ti < 4 ? ti * 64 : t0 - 128 + 64 * (mlo + ti - 4); };
        auto gload = [&](int ti) {
            const int k0 = tile_tok(ti);
#pragma unroll
            for (int x = 0; x < 2; ++x) {
                rk[x] = *(const u32x4*)(AK + ((size_t)bl * TB + k0 + krow + 32 * x) * 256 + hkv * 128 + kc * 8);
                rv[x] = *(const u32x4*)(AVT + ((size_t)bl * 256 + hkv * 128 + vrow + 64 * x) * TB + k0 + vc * 8);
            }
        };
        auto lstore = [&](int buf) {
#pragma unroll
            for (int x = 0; x < 2; ++x) {
                *(LAS u32x4*)(lds + AT_KB + buf * 64 * AT_KS + (krow + 32 * x) * AT_KS + kc * 16) = rk[x];
                *(LAS u32x4*)(lds + AT_VB + buf * 128 * AT_VS + (vrow + 64 * x) * AT_VS + vc * 16) = rv[x];
            }
        };
        __syncthreads();
        gload(0); lstore(0);
        __syncthreads();
        for (int ti = 0; ti < ntile; ++ti) {
            const int cur = ti & 1;
            if (ti + 1 < ntile) gload(ti + 1);
            const LAS unsigned char* Kc = lds + AT_KB + cur * 64 * AT_KS; const LAS unsigned char* Vc = lds + AT_VB + cur * 128 * AT_VS;
            f32x4 sT[4][2];
#pragma unroll
            for (int kb = 0; kb < 4; ++kb) { sT[kb][0] = (f32x4){0.f, 0.f, 0.f, 0.f}; sT[kb][1] = sT[kb][0]; }
#pragma unroll
            for (int ks = 0; ks < 4; ++ks)
#pragma unroll
                for (int kb = 0; kb < 4; ++kb) { const bf16x8 a = *(const LAS bf16x8*)(Kc + (16 * kb + fr) * AT_KS + ks * 64 + fq * 16);
                    sT[kb][0] = __builtin_amdgcn_mfma_f32_16x16x32_bf16(a, qf[0][ks], sT[kb][0], 0, 0, 0);
                    sT[kb][1] = __builtin_amdgcn_mfma_f32_16x16x32_bf16(a, qf[1][ks], sT[kb][1], 0, 0, 0);
                    if (kb & 1) __builtin_amdgcn_sched_barrier(0); }
            if (ti >= 4) { const int m = mlo + ti - 4;
                if (m == 0 || m == 4) { const int k0 = tile_tok(ti);
#pragma unroll
                    for (int kb = 0; kb < 4; ++kb)
#pragma unroll
                        for (int qb = 0; qb < 2; ++qb)
#pragma unroll
                            for (int jj = 0; jj < 4; ++jj) { const int dt = (t0 + qoff + 16 * qb + fr) - (k0 + 16 * kb + 4 * fq + jj); if (dt > 128 || dt < -128) sT[kb][qb][jj] = -1.0e30f; } } }
            bf16x8 pb[2][2];
#pragma unroll
            for (int qb = 0; qb < 2; ++qb) {
                float tmax = -1.0e30f;
#pragma unroll
                for (int kb = 0; kb < 4; ++kb) tmax = fmaxf(tmax, fmaxf(fmaxf(sT[kb][qb][0], sT[kb][qb][1]), fmaxf(sT[kb][qb][2], sT[kb][qb][3])));
                tmax = fmaxf(tmax, sx(tmax, 16, lane)); tmax = fmaxf(tmax, sx(tmax, 32, lane));
                if (__any(tmax > mrun[qb] + 8.0f)) {
                    const float mnew_ = fmaxf(mrun[qb], tmax); const float alpha = __builtin_amdgcn_exp2f(mrun[qb] - mnew_); mrun[qb] = mnew_;
                    lrun[qb] = lrun[qb] * alpha;
#pragma unroll
                    for (int db = 0; db < 8; ++db) oT[db][qb] = oT[db][qb] * alpha;
                }
                const float mnew = mrun[qb];
                float psum = 0.f;
#pragma unroll
                for (int kb = 0; kb < 4; ++kb)
#pragma unroll
                    for (int jj = 0; jj < 4; ++jj) { const float pv = __builtin_amdgcn_exp2f(sT[kb][qb][jj] - mnew); psum += pv; sT[kb][qb][jj] = pv; }
                lrun[qb] = lrun[qb] + psum;
#pragma unroll
                for (int s2 = 0; s2 < 2; ++s2) { u32x4 w;
                    w.x = cvt_pk_bf16(sT[2 * s2][qb][0], sT[2 * s2][qb][1]); w.y = cvt_pk_bf16(sT[2 * s2][qb][2], sT[2 * s2][qb][3]);
                    w.z = cvt_pk_bf16(sT[2 * s2 + 1][qb][0], sT[2 * s2 + 1][qb][1]); w.w = cvt_pk_bf16(sT[2 * s2 + 1][qb][2], sT[2 * s2 + 1][qb][3]);
                    pb[qb][s2] = __builtin_bit_cast(bf16x8, w); }
            }
#pragma unroll
            for (int s2 = 0; s2 < 2; ++s2)
#pragma unroll
                for (int db = 0; db < 8; ++db) {
                    const u32x2 lo = *(const LAS u32x2*)(Vc + (16 * db + fr) * AT_VS + (32 * s2 + 4 * fq) * 2), hi = *(const LAS u32x2*)(Vc + (16 * db + fr) * AT_VS + (32 * s2 + 16 + 4 * fq) * 2);
                    const bf16x8 a = __builtin_bit_cast(bf16x8, (u32x4){lo.x, lo.y, hi.x, hi.y});
                    oT[db][0] = __builtin_amdgcn_mfma_f32_16x16x32_bf16(a, pb[0][s2], oT[db][0], 0, 0, 0);
                    oT[db][1] = __builtin_amdgcn_mfma_f32_16x16x32_bf16(a, pb[1][s2], oT[db][1], 0, 0, 0);
                    if (db & 1) __builtin_amdgcn_sched_barrier(0);
                }
            __syncthreads();
            if (ti + 1 < ntile) lstore(cur ^ 1);
            __syncthreads();
        }
#pragma unroll
        for (int qb = 0; qb < 2; ++qb) {
            float l = lrun[qb]; l += sx(l, 16, lane); l += sx(l, 32, lane);
            const float inv = 1.0f / l;
            bf16_t* orow = (to_spare ? (bf16_t*)(p.ws + WS_NEED) : AQ) + (qrow0 + 16 * qb + fr) * 1024 + hq * 128 + 4 * fq;
#pragma unroll
            for (int db = 0; db < 8; ++db) { const f32x4 v = oT[db][qb] * inv; u32x2 w; w.x = cvt_pk_bf16(v[0], v[1]); w.y = cvt_pk_bf16(v[2], v[3]); *(u32x2*)(orow + 16 * db) = w; }
        }
    }
}
#endif

__global__ void __launch_bounds__(512, 2) mega(Params pv) {
    extern __shared__ __attribute__((aligned(16))) unsigned char smem_raw[];
    LAS unsigned char* lds = (LAS unsigned char*)smem_raw;
    LAS unsigned* xbw = (LAS unsigned*)(lds + 131072);
    LAS int* tab = (LAS int*)(lds + 131072 + 256);
#if LDS_POISON
    for (int e = threadIdx.x; e < LDS_BYTES / 4; e += 512) ((LAS unsigned*)lds)[e] = 0x447A447Au;
    __syncthreads();
#endif
    if (threadIdx.x == 0) { xbw[0] = 0u; xbw[1] = 0u; xbw[2] = 0u; xbw[3] = 0u; }
    __syncthreads();
    KPS* kp = (KPS*)__builtin_amdgcn_kernarg_segment_ptr();
    const int ph0 = pv.ph0, ph1 = pv.ph1;
    XcdBarrier bar = xcd_barrier_post((unsigned*)(pv.ws + OFF_BAR), (volatile LAS unsigned*)xbw);
    int ph = 0;
#define PH_RUN(tag, ...) do { if (ph >= ph0 && ph < ph1 && PSEL_OK(tag)) { for (int rep_ = 0; rep_ < (((REP_MASK >> (tag)) & 1) ? REP_N : 1); ++rep_) { KPS* q_ = kp; asm volatile("" : "+s"(q_)); KP p = *q_; __VA_ARGS__ } } \
        if (ph >= ph0 && ph + 1 < ph1) xcd_barrier(bar); ++ph; } while (0)
    PH_RUN(0, prologue1(p, lds););
    PH_RUN(1, prologue2(p););
    for (int layer = 0; layer < 2; ++layer) {
        PH_RUN(2, const bool dry_ = rep_ + 1 < (((REP_MASK >> 2) & 1) ? REP_N : 1); if (layer == 0) norm_phase2<0>(p, 0, dry_); else norm_phase2<1>(p, 1, dry_););
        for (int g = 0; g < NGRP; ++g) {
            PH_RUN(3,
                unsigned char* ws = p.ws; const bf16_t* Hg = (const bf16_t*)(ws + OFF_H) + (size_t)g * TG * 1024; const bf16_t* WIN = (const bf16_t*)(ws + OFF_WINT) + (size_t)layer * WIN_ROWS * 1024;
                SchedDense S{}; S.A = Hg; S.B = WIN; S.lda = 1024; S.K = 1024; S.nM = TG / 256; S.nN = 23; S.nNb = 23; S.qkvswap = true;
                EpiQKV E{ws + OFF_REG, g, (const f32x2*)(ws + OFF_ATAB), (const f32x2*)(ws + OFF_RTAB), rep_ + 1 < (((REP_MASK >> 3) & 1) ? REP_N : 1)};
                g8::gemm_call(lds, S, E););
            PH_RUN(4, gate_phase(p, layer, g, lds););
                        PH_RUN(5, scan_mfma(p, layer, g, lds, false); __syncthreads(); attn_mfma(p, layer, g, lds, false););
            PH_RUN(7, stats_phase(p, g, false););
            PH_RUN(8,
                unsigned char* ws = p.ws; const bf16_t* Hg = (const bf16_t*)(ws + OFF_H) + (size_t)g * TG * 1024; const bf16_t* WIN = (const bf16_t*)(ws + OFF_WINT) + (size_t)layer * WIN_ROWS * 1024;
                SchedDense S{}; S.A = Hg; S.B = WIN + (size_t)5888 * 1024; S.lda = 1024; S.K = 1024; S.nM = layer == 1 ? 128 : TG / 256; S.nN = 8; S.nNb = 8; S.skipctx = layer == 1;
                EpiGateR E{ws + OFF_REG, (const f32x2*)(ws + OFF_STATS), p.in[11] + layer * 1024, p.in[13] + layer * 1024, rep_ + 1 < (((REP_MASK >> 8) & 1) ? REP_N : 1)};
                g8::gemm_call(lds, S, E););
            PH_RUN(9,
                unsigned char* ws = p.ws; unsigned char* reg = ws + OFF_REG;
                const bf16_t* Yb = (const bf16_t*)(reg + R_OGF); const bf16_t* WBb = (const bf16_t*)(ws + OFF_WBRT) + (size_t)layer * 3 * 1024 * 1024; const bf16_t* Hb = (const bf16_t*)(ws + OFF_H) + (size_t)g * TG * 1024;
                const bf16_t* WGb = (const bf16_t*)(ws + OFF_WINT) + (size_t)layer * WIN_ROWS * 1024 + (size_t)7936 * 1024; bf16_t* Zb = (bf16_t*)(reg + (g == 0 ? R_ZG0 : R_GQK));
                { SchedZGc S{Yb, WBb, Hb, WGb, 128, true}; EpiZGc E{Zb}; g8::gemm_call(lds, S, E); }
                if (layer == 0) { SchedZG S{Yb, WBb, Hb, WGb, BG, false, true}; EpiZG E{Zb, false}; g8::gemm_call(lds, S, E); });
        }
        PH_RUN(11,
            unsigned char* ws = p.ws;
            EpiOut E{layer == 0 ? p.in[0] : p.out, layer == 0 ? p.in[2] : (const float*)(ws + OFF_CTXS), p.out, (float*)(ws + OFF_CTXS), (const float*)(ws + OFF_MOD) + (size_t)layer * 9 * 6144, 0, false};
            for (int d_ = 0; d_ < (int)(blockIdx.x & 7); ++d_) __builtin_amdgcn_s_sleep(64);
            if (layer == 0) { SchedOut2 S{(const bf16_t*)(ws + OFF_REG + R_ZG0), (const bf16_t*)(ws + OFF_REG + R_GQK), (const bf16_t*)(ws + OFF_WO3T), false, 3072, true, false}; g8::gemm_call(lds, S, E); }
            { SchedOut2 S{(const bf16_t*)(ws + OFF_REG + R_ZG0), (const bf16_t*)(ws + OFF_REG + R_GQK), (const bf16_t*)(ws + OFF_WO1T) + (size_t)layer * 1024 * 1024, true, 1024, false, layer == 0}; g8::gemm_call(lds, S, E); });
        PH_RUN(13, moe_convert(p, layer, lds); __syncthreads(); norm2_router(p, layer, lds, false););
        PH_RUN(14, dispatch_phase(p, layer, tab););
        PH_RUN(15,
            unsigned char* ws = p.ws;
            moe_table(p, layer, tab);
            LAS int* tok = (LAS int*)(lds + 131072 + 1024);
            moe_tok_table(p, tab, tok);
            SchedMoeG S{(const bf16_t*)(ws + OFF_H), (const bf16_t*)(ws + OFF_REG + M_W13T), tab, tok};
            EpiMoe1 E{(bf16_t*)(ws + OFF_REG + M_HMID)};
            g8::gemm_call(lds, S, E););
        PH_RUN(16,
            unsigned char* ws = p.ws;
            moe_table(p, layer, tab);
            LAS int* uinf2 = (LAS int*)(lds + 131072 + 1024);
            moe_unit_table(tab, uinf2, 4);
            SchedMoe S{(const bf16_t*)(ws + OFF_REG + M_HMID), (const bf16_t*)(ws + OFF_REG + M_W2T), 1024, 1024, 4, 1024, tab, uinf2};
            EpiMoe2 E{(bf16_t*)(ws + OFF_REG + M_XG), (const float*)(ws + OFF_SLOTW)};
            g8::gemm_call(lds, S, E););
    }
    PH_RUN(17, norm_phase2<3>(p, 1, rep_ + 1 < (((REP_MASK >> 17) & 1) ? REP_N : 1)););
#if BAR_PROBE
    if (ph1 - ph0 > 1) for (int i_ = 0; i_ < 100; ++i_) xcd_barrier(bar);
#endif
}
constexpr int N_PHASES = 2 + 2 * (1 + NGRP * 6 + 1 + 4) + 1;

extern "C" void kernel_launch(void* const* d_in, const int* in_sizes, int n_in, void* d_out, int out_size, void* d_ws, size_t ws_size, hipStream_t stream) {
    static int grid = 0;
    if (!grid) {
        int dev = 0, cus = 0, per_cu = 0;
        hipGetDevice(&dev);
        hipDeviceGetAttribute(&cus, hipDeviceAttributeMultiprocessorCount, dev);
        hipFuncSetAttribute((const void*)mega, hipFuncAttributeMaxDynamicSharedMemorySize, LDS_BYTES);
        hipOccupancyMaxActiveBlocksPerMultiprocessor(&per_cu, mega, 512, LDS_BYTES);
        grid = per_cu >= 1 ? cus : 0;
    }
    if (!grid || ws_size < WS_NEED || n_in < 26) { fprintf(stderr, "kernel_launch: cannot run (grid %d, ws %zu need %zu)\n", grid, ws_size, (size_t)WS_NEED); return; }
    hipMemsetAsync(d_ws, 0, ZERO_BYTES, stream);
    Params p{};
    for (int i = 0; i < 26; ++i) p.in[i] = (const float*)d_in[i];
    p.out = (float*)d_out; p.ws = (unsigned char*)d_ws;
#if MK_MULTI
    for (int ph = 0; ph < N_PHASES; ++ph) { p.ph0 = ph; p.ph1 = ph + 1; hipLaunchKernelGGL(mega, dim3(grid), dim3(512), LDS_BYTES, stream, p); }
#else
    p.ph0 = 0; p.ph1 = N_PHASES;
    hipLaunchKernelGGL(mega, dim3(grid), dim3(512), LDS_BYTES, stream, p);
#endif
}
```

```cpp
#include <hip/hip_runtime.h>
#include <stdint.h>
#include <stdio.h>

#ifndef MK_MULTI
#define MK_MULTI 0
#endif
#ifndef NAIVE_SCAN
#define NAIVE_SCAN 1
#endif
#ifndef SCAN_MASK
#define SCAN_MASK 15
#endif
#ifndef SCAN_E1
#define SCAN_E1 0
#endif
#ifndef E2_SEL
#define E2_SEL (layer == 1 && g == 0 && mix == 1 && ch == 126 && (u & 7) == 2)
#endif
#ifndef LDS_POISON
#define LDS_POISON 0
#endif
#ifndef SCAN_DELAY
#define SCAN_DELAY 0
#endif
#ifndef E2_KEY
#define E2_KEY (fminf(60000.0f, 100.0f * fmaxf(fmaxf(fabsf(c[0] - r0_), fabsf(c[1] - r1_)), fmaxf(fabsf(c[2] - r2_), fabsf(c[3] - r3_)))))
#endif
#ifndef REP_MASK
#define REP_MASK 0u
#define REP_N 3
#endif
#ifndef BAR_PROBE
#define BAR_PROBE 0
#endif
#ifndef NAIVE_ATTN
#define NAIVE_ATTN 0
#endif

#define LAS __attribute__((address_space(3)))
#ifndef PSEL
#define PSEL -1
#endif
#ifndef PMASK
#define PMASK 0xFFFFFFFFu
#endif
#define PSEL_OK(t) ((PSEL < 0 || PSEL == (t)) && ((PMASK >> (t)) & 1u))
typedef unsigned short bf16_t;
typedef short bf16x8 __attribute__((ext_vector_type(8)));
typedef float f32x4 __attribute__((ext_vector_type(4)));
typedef float f32x2 __attribute__((ext_vector_type(2)));
typedef unsigned u32x4 __attribute__((ext_vector_type(4)));
typedef unsigned u32x2 __attribute__((ext_vector_type(2)));

constexpr int D = 1024, NBATCH = 8, LSEQ = 8192, NCTX = 256, TB = 8448, TALL = 67584;
constexpr int NGRP = 2, BG = 4, TG = 33792;
constexpr int NIN = 10784, NE = 32;
constexpr int NSLOT = 2 * TALL;
constexpr int WIN_ROWS = 11008;
constexpr int CH = 64, NCH = TB / CH;
constexpr float LOG2E = 1.4426950408889634f;

constexpr size_t al(size_t x) { return (x + 4095) & ~(size_t)4095; }
constexpr size_t OFF_BAR   = 0;
constexpr size_t OFF_CNT   = 16384;
constexpr size_t ZERO_BYTES = 32768;
constexpr size_t OFF_MOD   = ZERO_BYTES;
constexpr size_t OFF_MODP  = OFF_MOD   + al((size_t)2 * 9 * 6144 * 4);
constexpr size_t OFF_ATAB  = OFF_MODP  + al((size_t)16 * 2 * 9 * 6144 * 4);
constexpr size_t OFF_RTAB  = OFF_ATAB  + al((size_t)128 * 32 * 8);
constexpr size_t OFF_WR    = OFF_RTAB  + al((size_t)TB * 64 * 8);
constexpr size_t OFF_CTXS  = OFF_WR    + al((size_t)2 * 2 * 48 * 1024 * 2);
constexpr size_t OFF_WINT  = OFF_CTXS  + al((size_t)8 * 256 * 1024 * 4);
constexpr size_t OFF_WBRT  = OFF_WINT  + al((size_t)2 * WIN_ROWS * 1024 * 2);
constexpr size_t OFF_WO3T  = OFF_WBRT  + al((size_t)2 * 3 * 1024 * 1024 * 2);
constexpr size_t OFF_WO1T  = OFF_WO3T  + al((size_t)2 * 1024 * 3072 * 2);
constexpr size_t OFF_EXPID = OFF_WO1T  + al((size_t)2 * 1024 * 1024 * 2);
constexpr size_t OFF_GATEW = OFF_EXPID + al((size_t)TALL * 2 * 4);
constexpr size_t OFF_RANK  = OFF_GATEW + al((size_t)TALL * 2 * 4);
constexpr size_t OFF_TOKSL = OFF_RANK  + al((size_t)TALL * 2 * 4);
constexpr size_t OFF_SLOTW = OFF_TOKSL + al((size_t)TALL * 2 * 4);
constexpr size_t OFF_SLOTTOK = OFF_SLOTW + al((size_t)(NSLOT + 256) * 4);
constexpr size_t OFF_STATS = OFF_SLOTTOK + al((size_t)(NSLOT + 256) * 4);
constexpr size_t OFF_H     = OFF_STATS + al((size_t)2 * TG * 4 * 8);
constexpr size_t OFF_REG   = OFF_H     + al((size_t)TALL * 1024 * 2);
constexpr size_t SZ_T1K = (size_t)TG * 1024 * 2;
constexpr size_t R_GQK  = 0;
constexpr size_t R_GIN  = R_GQK + SZ_T1K;
constexpr size_t R_GDEC = R_GIN + 2 * SZ_T1K;
constexpr size_t R_GVT  = R_GDEC + al((size_t)2 * BG * NCH * 512 * 4);
constexpr size_t R_GLR  = R_GVT + SZ_T1K;
constexpr size_t R_AK   = R_GLR + al((size_t)TG * 32 * 4);
constexpr size_t R_AVT  = R_AK + SZ_T1K / 4;
constexpr size_t R_RQK  = R_AVT + SZ_T1K / 4;
constexpr size_t R_RVT  = R_RQK + SZ_T1K;
constexpr size_t R_OGF  = R_RVT + SZ_T1K;
constexpr size_t R_AQ   = R_OGF + SZ_T1K;
constexpr size_t R_ORF  = R_AQ + SZ_T1K;
constexpr size_t R_OGB  = R_ORF + SZ_T1K;
constexpr size_t R_ORB  = R_OGB + SZ_T1K;
constexpr size_t R_ZG0  = R_ORB + SZ_T1K;
constexpr size_t R_MIX_END = R_ZG0 + 3 * SZ_T1K;
constexpr size_t M_W13T = 0;
constexpr size_t M_W2T  = M_W13T + (size_t)32 * 2048 * 1024 * 2;
constexpr size_t M_XG   = M_W2T + (size_t)32 * 1024 * 1024 * 2;
constexpr size_t M_HMID = M_XG + al((size_t)(NSLOT + 256) * 1024 * 2);
constexpr size_t M_END  = M_HMID + al((size_t)(NSLOT + 256) * 1024 * 2);
constexpr size_t REG_BYTES = R_MIX_END > M_END ? R_MIX_END : M_END;
constexpr size_t WS_NEED = OFF_REG + REG_BYTES;

constexpr int LDS_BYTES = 155648;

struct Params {
    const float* in[26];
    float* out;
    unsigned char* ws;
    int ph0, ph1;
};
typedef const __attribute__((address_space(4))) Params KPS;
typedef KPS& KP;

__device__ __forceinline__ bf16_t f2bf(float f) { unsigned u = __float_as_uint(f); u += 0x7FFFu + ((u >> 16) & 1u); return (bf16_t)(u >> 16); }
__device__ __forceinline__ float bf2f(unsigned b) { return __uint_as_float(b << 16); }
__device__ __forceinline__ float bflo(unsigned w) { return __uint_as_float(w << 16); }
__device__ __forceinline__ float bfhi(unsigned w) { return __uint_as_float(w & 0xFFFF0000u); }
typedef __bf16 bf16x2_t __attribute__((ext_vector_type(2)));
__device__ __forceinline__ unsigned cvt_pk_bf16(float lo, float hi) { const f32x2 v = (f32x2){lo, hi}; const bf16x2_t b = __builtin_convertvector(v, bf16x2_t); return __builtin_bit_cast(unsigned, b); }
__device__ __forceinline__ float sx(float v, int m, int lane) { return __int_as_float(__builtin_amdgcn_ds_bpermute((lane ^ m) << 2, __float_as_int(v))); }
__device__ __forceinline__ float wave_sum(float v, int lane) {
#pragma unroll
    for (int o = 32; o; o >>= 1) v += sx(v, o, lane);
    return v;
}
__device__ __forceinline__ float wave_max(float v, int lane) {
#pragma unroll
    for (int o = 32; o; o >>= 1) v = fmaxf(v, sx(v, o, lane));
    return v;
}
__device__ __forceinline__ int tid_fresh() { int t = threadIdx.x; asm volatile("" : "+v"(t)); return t; }
__device__ __forceinline__ int bid_fresh() { int t = blockIdx.x; asm volatile("" : "+s"(t)); return t; }
__device__ __forceinline__ float sigmoid_f(float x) { return __builtin_amdgcn_rcpf(1.0f + __builtin_amdgcn_exp2f(x * -LOG2E)); }
__device__ __forceinline__ float silu_f(float x) { return x * sigmoid_f(x); }

#define XB_TMO      128
#define XB_XCNT(j)  (256  + 64 * (j))
#define XB_XSUB(j)  (1280 + 64 * (j))
#define XB_XGEN(j)  (2304 + 64 * (j))
#define XB_TOP      3328
#define XB_TOPGEN   3392
#define XCD_BAR_WORDS 3456
#define XB_SPIN_CAP (1u << 18)

__device__ __forceinline__ unsigned xb_ld(unsigned* p)              { return __hip_atomic_load(p, __ATOMIC_RELAXED, __HIP_MEMORY_SCOPE_AGENT); }
__device__ __forceinline__ unsigned xb_add(unsigned* p, unsigned v) { return __hip_atomic_fetch_add(p, v, __ATOMIC_RELAXED, __HIP_MEMORY_SCOPE_AGENT); }
__device__ __forceinline__ unsigned xb_xcc_id() { return (unsigned)__builtin_amdgcn_s_getreg((3 << 11) | 20) & 0xFu; }
#define XB_SPIN(cond, bar) do { unsigned _sp = 0; while (cond) { __builtin_amdgcn_s_sleep(1); \
    if ((++_sp & 255u) == 0u) { if (xb_ld(&(bar)[XB_TMO])) break; if (_sp > XB_SPIN_CAP) { atomicAdd(&(bar)[XB_TMO], 1u); break; } } } } while (0)

struct XcdBarrier { unsigned* bar; unsigned x; volatile LAS unsigned* st; };

__device__ __forceinline__ XcdBarrier xcd_barrier_post(unsigned* bar, volatile LAS unsigned* st) {
    XcdBarrier b; b.bar = bar; b.x = xb_xcc_id(); b.st = st;
    if (threadIdx.x == 0) (void)xb_add(&bar[XB_XCNT(b.x)], 1u);
    return b;
}
__device__ __forceinline__ void xcd_barrier_complete(unsigned* bar, unsigned x, unsigned& nloc, unsigned& nx) {
    const unsigned G = gridDim.x * gridDim.y * gridDim.z;
    unsigned sum, cnt, mine, sp = 0u;
    for (;;) {
        sum = 0u; cnt = 0u; mine = 0u;
#pragma unroll
        for (unsigned j = 0; j < 16; ++j) { const unsigned c = xb_ld(&bar[XB_XCNT(j)]); sum += c; cnt += (c > 0u) ? 1u : 0u; mine = (j == x) ? c : mine; }
        if (sum == G) break;
        __builtin_amdgcn_s_sleep(1);
        if ((++sp & 255u) == 0u) { if (xb_ld(&bar[XB_TMO])) break; if (sp > XB_SPIN_CAP) { atomicAdd(&bar[XB_TMO], 1u); break; } }
    }
    nloc = mine > 0u ? mine : 1u; nx = cnt > 0u ? cnt : 1u;
}
__device__ __forceinline__ void xcd_barrier(const XcdBarrier& b) {
    asm volatile("s_waitcnt vmcnt(0)" ::: "memory");
    __syncthreads();
    if (threadIdx.x == 0) {
        unsigned* bar = b.bar;
        __builtin_amdgcn_s_waitcnt(0);
        unsigned nloc = b.st[0], nx = b.st[1];
        if (nloc == 0u) { xcd_barrier_complete(bar, b.x, nloc, nx); b.st[0] = nloc; b.st[1] = nx; }
        const unsigned old = xb_add(&bar[XB_XSUB(b.x)], 1u);
        const unsigned gen = old / nloc;
        if (old + 1u == (gen + 1u) * nloc) {
            __builtin_amdgcn_fence(__ATOMIC_RELEASE, "agent");
            asm volatile("s_waitcnt vmcnt(0)" ::: "memory");
            const unsigned og = xb_add(&bar[XB_TOP], 1u);
            const unsigned tg = og / nx;
            if (og + 1u == (tg + 1u) * nx) xb_add(&bar[XB_TOPGEN], 1u);
            else XB_SPIN(xb_ld(&bar[XB_TOPGEN]) == tg, bar);
            __builtin_amdgcn_fence(__ATOMIC_ACQUIRE, "agent");
            xb_add(&bar[XB_XGEN(b.x)], 1u);
            asm volatile("s_waitcnt vmcnt(0)" ::: "memory");
        } else {
            XB_SPIN(xb_ld(&bar[XB_XGEN(b.x)]) == gen, bar);
            __builtin_amdgcn_fence(__ATOMIC_ACQUIRE, "agent");
            asm volatile("s_waitcnt vmcnt(0)" ::: "memory");
        }
    }
    __syncthreads();
}

__device__ __forceinline__ size_t lat_off(int b, int t) { return ((size_t)b * LSEQ + (t - NCTX)) * D; }
__device__ __forceinline__ size_t ctx_off(int b, int t) { return ((size_t)b * NCTX + t) * D; }

namespace g8 {
constexpr int BM = 256, BK = 64, HALF = 128, HTB = HALF * BK * 2, STAGE_BYTES = 8 * HTB, NXCD = 8, WGM = 8;
__device__ __forceinline__ int lds_byte(int r, int c) { const int st = (r >> 4) * 2 + (c >> 5), rr = r & 15, cc = c & 31, ob = rr * 64 + cc * 2; return st * 1024 + (ob ^ (((ob >> 9) & 1) << 5)); }
__device__ __forceinline__ void stage_rc(int b, int& R, int& C) { const int st = b / 1024, sb = b % 1024, swz = sb ^ (((sb >> 9) & 1) << 5); R = (st >> 1) * 16 + swz / 64; C = (st & 1) * 32 + (swz % 64) / 2; }
__device__ __forceinline__ int perm32(int rho) { const int n = rho >> 4, i = rho & 15; return 8 * (i >> 2) + 4 * n + (i & 3); }

struct GUnit { const char* a; const char* b; int pm, pn, x0, x1, xi; };

__device__ __forceinline__ bool static_tile(int i, int G, int c, int nM, int nN, int& pm, int& pn) {
    const int nwg = nM * nN; const long L = (long)i * G + c; if (L >= nwg) return false;
    int wgid = (int)L; { const int q = nwg / NXCD, r = nwg % NXCD, xcd = wgid % NXCD, off = wgid / NXCD; wgid = (xcd < r ? xcd * (q + 1) : r * (q + 1) + (xcd - r) * q) + off; }
    const int nig = WGM * nN, gid = wgid / nig, fm = gid * WGM, gsz = (nM - fm) < WGM ? (nM - fm) : WGM;
    pm = fm + ((wgid % nig) % gsz); pn = (wgid % nig) / gsz; return true;
}

template <class Epi, class Sched>
__device__ __forceinline__ void gemm_phase(LAS unsigned char* lds, const Sched& S, const Epi& E) {
    const int tid = tid_fresh(), wid = __builtin_amdgcn_readfirstlane(tid >> 6), lane = tid & 63, wr = wid >> 2, wc = wid & 3, fr = lane & 15, fq = lane >> 4;
    const int K = S.K, nt = K / BK;
    const int lda = S.lda;
    unsigned voffA[2], voffB[2]; int Rr[2], Cc[2];
#pragma unroll
    for (int i = 0; i < 2; ++i) { int R, C; stage_rc(tid * 16 + i * 8192, R, C); const int Rb = Epi::PERM ? ((R & ~31) + perm32(R & 31)) : R; Rr[i] = R; Cc[i] = C;
        voffA[i] = (unsigned)(R * lda + C) * 2u; voffB[i] = (unsigned)(Rb * K + C) * 2u; }
    unsigned vAc[2][2], vAn[2][2];
    const size_t kstep = (size_t)(BK * 2);
    const size_t hstepA = (size_t)HALF * lda * 2, hstepB = (size_t)HALF * K * 2;
    const unsigned ldsw = (unsigned)wid * 1024u;
    const int aoff = lds_byte(wr * 64 + fr, fq * 8), boff = lds_byte(wc * 32 + fr, fq * 8);
#define G8_SA(b, h) (((b) * 2 + (h)) * HTB)
#define G8_SB(b, h) ((4 + (b) * 2 + (h)) * HTB)
#define G8_STAGE(bufoff, gbase, voff) do { _Pragma("unroll") for (int _i = 0; _i < 2; ++_i) \
        __builtin_amdgcn_global_load_lds((const unsigned*)((const char*)(gbase) + (voff)[_i]), (LAS unsigned*)(lds + (bufoff) + ldsw + _i * 8192), 16, 0, 0); } while (0)
#define G8_STAGE_A(bufoff, basep, h, usenext) do { if constexpr (Sched::GATHER) { unsigned _v[2]; _v[0] = (usenext) ? vAn[h][0] : vAc[h][0]; _v[1] = (usenext) ? vAn[h][1] : vAc[h][1]; G8_STAGE(bufoff, basep, _v); } \
        else { G8_STAGE(bufoff, (basep) + (h) * hstepA, voffA); } } while (0)
#define G8_LDA(dst, b, h) do { _Pragma("unroll") for (int m = 0; m < 4; ++m) _Pragma("unroll") for (int k = 0; k < 2; ++k) dst[m][k] = *(const LAS bf16x8*)(lds + G8_SA(b, h) + aoff + m * 2048 + k * 1024); } while (0)
#define G8_LDB(dst, b, h) do { _Pragma("unroll") for (int n = 0; n < 2; ++n) _Pragma("unroll") for (int k = 0; k < 2; ++k) dst[n][k] = *(const LAS bf16x8*)(lds + G8_SB(b, h) + boff + n * 2048 + k * 1024); } while (0)
#define G8_MMA(ai, bj, At, Bt) do { __builtin_amdgcn_s_setprio(1); _Pragma("unroll") for (int m = 0; m < 4; ++m) _Pragma("unroll") for (int n = 0; n < 2; ++n) _Pragma("unroll") for (int k = 0; k < 2; ++k) \
        acc[ai][bj][m][n] = __builtin_amdgcn_mfma_f32_16x16x32_bf16(Bt[n][k], At[m][k], acc[ai][bj][m][n], 0, 0, 0); __builtin_amdgcn_s_setprio(0); } while (0)
#define G8_WAIT_V(n) asm volatile("s_waitcnt vmcnt(" #n ")" ::: "memory")
#define G8_WAIT_L(n) asm volatile("s_waitcnt lgkmcnt(" #n ")" ::: "memory")
#define G8_BAR __builtin_amdgcn_s_barrier()
#define G8_SCHED __builtin_amdgcn_sched_barrier(0)
    GUnit cur, nxt; int ui = 0;
    if (!S.next(0, cur)) return;
    f32x4 acc[2][2][4][2];
#pragma unroll
    for (int a = 0; a < 2; ++a)
#pragma unroll
        for (int b = 0; b < 2; ++b)
#pragma unroll
            for (int m = 0; m < 4; ++m)
#pragma unroll
                for (int n = 0; n < 2; ++n) acc[a][b][m][n] = (f32x4){0.f, 0.f, 0.f, 0.f};
    bf16x8 At[4][2], B0[2][2], B1[2][2];
    const char* cA = cur.a; const char* cB = cur.b;
    if constexpr (Sched::GATHER) { S.aoff(cur, Rr, Cc, vAc); asm volatile("s_waitcnt lgkmcnt(0)" ::: "memory"); }
    G8_STAGE(G8_SB(0, 0), cB, voffB); G8_STAGE_A(G8_SA(0, 0), cA, 0, false); G8_STAGE(G8_SB(0, 1), cB + hstepB, voffB); G8_STAGE_A(G8_SA(0, 1), cA, 1, false);
    if (wr == 1) G8_BAR;
    G8_WAIT_V(4); G8_BAR;
    G8_STAGE(G8_SB(1, 0), cB + kstep, voffB); G8_STAGE_A(G8_SA(1, 0), cA + kstep, 0, false); G8_STAGE(G8_SB(1, 1), cB + hstepB + kstep, voffB);
    G8_WAIT_V(6); G8_BAR;
    for (;;) {
        const bool has_next = S.next(ui + 1, nxt);
        const char* nA = has_next ? nxt.a : cA; const char* nB = has_next ? nxt.b : cB;
        if constexpr (Sched::GATHER) {
            if (has_next) S.aoff(nxt, Rr, Cc, vAn); else { vAn[0][0] = vAc[0][0]; vAn[0][1] = vAc[0][1]; vAn[1][0] = vAc[1][0]; vAn[1][1] = vAc[1][1]; }
            asm volatile("s_waitcnt lgkmcnt(0)" : "+v"(vAn[0][0]), "+v"(vAn[0][1]), "+v"(vAn[1][0]), "+v"(vAn[1][1]) :: "memory");
        }
        for (int t = 0; t < nt; t += 2) {
            const bool last = (t == nt - 2);
            const char* a1 = cA + (size_t)(t + 1) * kstep;
            const char* a2 = last ? nA : cA + (size_t)(t + 2) * kstep; const char* b2 = last ? nB : cB + (size_t)(t + 2) * kstep;
            const char* a3 = a2 + kstep; const char* b3 = b2 + kstep;
            G8_LDB(B0, 0, 0); G8_SCHED; G8_LDA(At, 0, 0); G8_STAGE_A(G8_SA(1, 1), a1, 1, false);
            G8_WAIT_L(8); G8_BAR; G8_WAIT_L(0); G8_MMA(0, 0, At, B0); G8_BAR; G8_SCHED;
            G8_LDB(B1, 0, 1); G8_STAGE(G8_SB(0, 0), b2, voffB);
            G8_BAR; G8_WAIT_L(0); G8_MMA(0, 1, At, B1); G8_BAR;
            G8_LDA(At, 0, 1); G8_STAGE_A(G8_SA(0, 0), a2, 0, last);
            G8_BAR; G8_WAIT_L(0); G8_MMA(1, 0, At, B0); G8_BAR; G8_SCHED;
            G8_STAGE(G8_SB(0, 1), b2 + hstepB, voffB);
            G8_WAIT_V(6); G8_BAR; G8_MMA(1, 1, At, B1); G8_BAR;
            G8_LDB(B0, 1, 0); G8_SCHED; G8_LDA(At, 1, 0); G8_STAGE_A(G8_SA(0, 1), a2, 1, last);
            G8_WAIT_L(8); G8_BAR; G8_WAIT_L(0); G8_MMA(0, 0, At, B0); G8_BAR; G8_SCHED;
            G8_LDB(B1, 1, 1); G8_STAGE(G8_SB(1, 0), b3, voffB);
            G8_BAR; G8_WAIT_L(0); G8_MMA(0, 1, At, B1); G8_BAR;
            G8_LDA(At, 1, 1); G8_STAGE_A(G8_SA(1, 0), a3, 0, last);
            G8_BAR; G8_WAIT_L(0); G8_MMA(1, 0, At, B0); G8_BAR; G8_SCHED;
            G8_STAGE(G8_SB(1, 1), b3 + hstepB, voffB);
            G8_WAIT_V(6); G8_BAR; G8_MMA(1, 1, At, B1); G8_BAR;
        }
        E(acc, cur, wr, wc, fr, fq);
        if (!has_next) break;
#pragma unroll
        for (int a = 0; a < 2; ++a)
#pragma unroll
            for (int b = 0; b < 2; ++b)
#pragma unroll
                for (int m = 0; m < 4; ++m)
#pragma unroll
                    for (int n = 0; n < 2; ++n) acc[a][b][m][n] = (f32x4){0.f, 0.f, 0.f, 0.f};
        cur = nxt; cA = nA; cB = nB; ++ui;
        if constexpr (Sched::GATHER) { vAc[0][0] = vAn[0][0]; vAc[0][1] = vAn[0][1]; vAc[1][0] = vAn[1][0]; vAc[1][1] = vAn[1][1]; }
    }
    G8_WAIT_V(0);
    if (wr == 0) G8_BAR;
    G8_BAR;
#undef G8_SA
#undef G8_SB
#undef G8_STAGE
#undef G8_STAGE_A
#undef G8_LDA
#undef G8_LDB
#undef G8_MMA
#undef G8_WAIT_V
#undef G8_WAIT_L
#undef G8_BAR
#undef G8_SCHED
}
struct SchedCached {
    static constexpr bool GATHER = false;
    const LAS int* t; int K; int lda;
    __device__ __forceinline__ bool next(int i, GUnit& u) const {
        if (i >= 32) return false;
        const LAS int* r = t + i * 12;
        if (r[0] == 0) return false;
        const unsigned long long a = (unsigned long long)(unsigned)r[1] | ((unsigned long long)(unsigned)r[2] << 32), b = (unsigned long long)(unsigned)r[3] | ((unsigned long long)(unsigned)r[4] << 32);
        u.a = (const char*)a; u.b = (const char*)b; u.pm = r[5]; u.pn = r[6]; u.x0 = r[7]; u.x1 = r[8]; u.xi = r[9];
        return true;
    }
};
template <class Epi, class Sched>
__device__ __forceinline__ void gemm_call(LAS unsigned char* lds, Sched S, Epi E) { gemm_phase(lds, S, E); }
template <class Epi, class Sched>
__device__ __forceinline__ void gemm_call_cached(LAS unsigned char* lds, Sched S, Epi E) {
    LAS int* t = (LAS int*)(lds + 131072 + 1024);
    const int tid = tid_fresh();
    __syncthreads();
    if (tid < 32) { GUnit u; u.a = nullptr; u.b = nullptr; u.pm = 0; u.pn = 0; u.x0 = 0; u.x1 = 0; u.xi = 0;
        const bool ok = S.next(tid, u); LAS int* r = t + tid * 12; const unsigned long long a = (unsigned long long)u.a, b = (unsigned long long)u.b;
        r[0] = ok ? 1 : 0; r[1] = (int)(unsigned)a; r[2] = (int)(unsigned)(a >> 32); r[3] = (int)(unsigned)b; r[4] = (int)(unsigned)(b >> 32); r[5] = u.pm; r[6] = u.pn; r[7] = u.x0; r[8] = u.x1; r[9] = u.xi; }
    __syncthreads();
    SchedCached C{t, S.K, S.lda};
    gemm_phase(lds, C, E);
}
}
using g8::GUnit;

__device__ __forceinline__ int skipctx_pm(int pmc) { return (pmc >> 5) * 33 + 1 + (pmc & 31); }
struct SchedDense {       static constexpr bool GATHER = false;
    const bf16_t* A; const bf16_t* B; size_t strideA, strideB; int lda, K, nM, nN, nNb; bool skipctx; bool qkvswap;
    __device__ __forceinline__ bool next(int i, GUnit& u) const {
        int pm, pn; if (!g8::static_tile(i, gridDim.x, blockIdx.x, nM, nN, pm, pn)) return false;
        if (skipctx) pm = skipctx_pm(pm);
        const int br = pn / nNb, pl = pn - br * nNb;
        u.pm = pm; u.pn = pn; u.x0 = br; u.x1 = pl;
        u.a = (const char*)(A + (size_t)br * strideA + (size_t)pm * 256 * lda);
        u.b = (const char*)(B + (size_t)br * strideB + (size_t)pl * 256 * K);
        { const bool vt_ = qkvswap && ((0x3C20F0u >> pn) & 1u); const unsigned long long x_ = ((unsigned long long)u.a ^ (unsigned long long)u.b) & (vt_ ? ~0ull : 0ull); u.a = (const char*)((unsigned long long)u.a ^ x_); u.b = (const char*)((unsigned long long)u.b ^ x_); }
        return true;
    }
};
struct SchedZG {
    static constexpr bool GATHER = false;
    const bf16_t* Y; const bf16_t* WB; const bf16_t* Hm; const bf16_t* WG; int nM; bool skipctx; bool ctxonly;
    static constexpr int lda = 1024, K = 1024;
    __device__ __forceinline__ bool next(int i, GUnit& u) const {
        int pm, pn; if (!g8::static_tile(i >> 1, gridDim.x, blockIdx.x, nM, 12, pm, pn)) return false;
        if (skipctx) pm = skipctx_pm(pm);
        if (ctxonly) pm = pm * 33;
        const int sub = i & 1, br = pn >> 2, pl = pn & 3;
        u.pm = pm; u.pn = pn; u.x0 = sub; u.x1 = 0;
        if (sub == 0) { u.a = (const char*)(Y + (size_t)br * TG * 1024 + (size_t)pm * 256 * 1024); u.b = (const char*)(WB + (size_t)br * 1024 * 1024 + (size_t)pl * 256 * 1024); }
        else { u.a = (const char*)(Hm + (size_t)pm * 256 * 1024); u.b = (const char*)(WG + (size_t)pn * 256 * 1024); }
        return true;
    }
};
struct SchedZGc {
    static constexpr bool GATHER = false;
    const bf16_t* Y; const bf16_t* WB; const bf16_t* Hm; const bf16_t* WG; int nM; bool skipctx;
    static constexpr int lda = 1024, K = 1024;
    __device__ __forceinline__ bool next(int i, GUnit& u) const {
        const int q = i / 6, st = i - q * 6;
        int pm, pc; if (!g8::static_tile(q, gridDim.x, blockIdx.x, nM, 4, pm, pc)) return false;
        if (skipctx) pm = skipctx_pm(pm);
        const int sub = st & 1, br = st >> 1, pn = br * 4 + pc;
        u.pm = pm; u.pn = pn; u.x0 = sub; u.x1 = br;
        if (sub == 0) { u.a = (const char*)(Y + (size_t)br * TG * 1024 + (size_t)pm * 256 * 1024); u.b = (const char*)(WB + (size_t)br * 1024 * 1024 + (size_t)pc * 256 * 1024); }
        else { u.a = (const char*)(Hm + (size_t)pm * 256 * 1024); u.b = (const char*)(WG + (size_t)pn * 256 * 1024); }
        return true;
    }
};
struct SchedOut2 {
    static constexpr bool GATHER = false;
    const bf16_t* Z0; const bf16_t* Z1; const bf16_t* B; bool skipctx; int K; bool ctxonly; bool skew;
    static constexpr int lda = 3072;
    __device__ __forceinline__ bool next(int i, GUnit& u) const {
        int pm, pn;
        if (skew && gridDim.x == 256) {
            int L; const int b = (int)blockIdx.x;
            if (b < 32) { if (i >= 2) return false; L = b + 32 * i; } else { L = 64 + i * 224 + (b - 32); if (L >= 1024) return false; }
            g8::static_tile(0, 1, L, 256, 4, pm, pn);
        } else if (!g8::static_tile(i, gridDim.x, blockIdx.x, ctxonly ? 8 : (skipctx ? 256 : 2 * (TG / 256)), 4, pm, pn)) return false;
        if (skipctx) pm = skipctx_pm(pm);
        if (ctxonly) pm = pm * 33;
        u.pm = pm; u.pn = pn; u.x0 = 0; u.x1 = 0;
        const bf16_t* z1adj = Z1 - (size_t)(TG / 256) * 256 * 3072; const long long d = (pm < TG / 256) ? (long long)(Z0 - z1adj) : 0ll;
        u.a = (const char*)(z1adj + d + (size_t)pm * 256 * 3072);
        u.b = (const char*)(B + (size_t)pn * 256 * K);
        return true;
    }
};
struct SchedMoe {
    static constexpr bool GATHER = false;
    const bf16_t* A; const bf16_t* B; int lda, K, npn, brows;
    const LAS int* tab;
    const LAS int* uinf;
    __device__ __forceinline__ bool next(int i, GUnit& u) const {
        if (i >= 22) return false;
        const int slot0 = uinf[4 * i]; if (slot0 < 0) return false;
        const int L = i * (int)gridDim.x + (int)blockIdx.x; const int pn = L % npn; const int e = uinf[4 * i + 2];
        u.pm = slot0; u.pn = pn; u.x0 = e; u.x1 = uinf[4 * i + 1];
        u.a = (const char*)(A + (size_t)slot0 * lda);
        u.b = (const char*)(B + ((size_t)e * brows + (size_t)pn * 256) * K);
        return true;
    }
};

struct SchedMoeG {
    static constexpr bool GATHER = true;
    const bf16_t* Hm; const bf16_t* B; const LAS int* tab; const LAS int* tok;
    static constexpr int lda = 1024, K = 1024;
    __device__ __forceinline__ bool next(int i, GUnit& u) const {
        if (i >= 22) return false;
        const LAS int* uinf = tok + 22 * 256;
        const int slot0 = uinf[4 * i]; if (slot0 < 0) return false;
        const int L = i * (int)gridDim.x + (int)blockIdx.x; const int pn = L & 7; const int e = uinf[4 * i + 2];
        u.pm = slot0; u.pn = pn; u.x0 = e; u.x1 = uinf[4 * i + 1]; u.xi = i;
        u.a = (const char*)Hm;
        u.b = (const char*)(B + ((size_t)e * 2048 + (size_t)pn * 256) * 1024);
        return true;
    }
    __device__ __forceinline__ void aoff(const GUnit& u, const int (&R)[2], const int (&C)[2], unsigned (&vo)[2][2]) const {
        const LAS int* tk = tok + u.xi * 256;
#pragma unroll
        for (int h = 0; h < 2; ++h)
#pragma unroll
            for (int q = 0; q < 2; ++q) vo[h][q] = (unsigned)(tk[h * 128 + R[q]] * 1024 + C[q]) * 2u;
    }
};

struct EpiQKV {
    static constexpr bool PERM = true;
    unsigned char* reg; int g;
    const f32x2* atab; const f32x2* rtab; bool dry;
    __device__ __forceinline__ void operator()(const f32x4 (&acc)[2][2][4][2], const GUnit& u, int wr, int wc, int fr, int fq) const {
        const int pn = u.pn;
        if (dry) { if (acc[0][0][0][0][0] == 1234.5678f) reg[0] = 1; return; }
        const int rg0 = u.pm * 256;
        const int bl = rg0 / TB, t0 = rg0 - bl * TB;
        bf16_t* GQK = (bf16_t*)(reg + R_GQK); bf16_t* GVT = (bf16_t*)(reg + R_GVT); float* GLR = (float*)(reg + R_GLR);
        bf16_t* AQ = (bf16_t*)(reg + R_AQ); bf16_t* AK = (bf16_t*)(reg + R_AK); bf16_t* AVT = (bf16_t*)(reg + R_AVT);
        bf16_t* RQK = (bf16_t*)(reg + R_RQK); bf16_t* RVT = (bf16_t*)(reg + R_RVT);
        if (pn < 4) {
            const float sc = pn < 2 ? 0.08838834764831845f : 1.0f;
#pragma unroll
            for (int ai = 0; ai < 2; ++ai)
#pragma unroll
                for (int m = 0; m < 4; ++m) { const int r = rg0 + ai * 128 + wr * 64 + m * 16 + fr; bf16_t* rowp = GQK + (size_t)r * 1024 + pn * 256 + wc * 32 + 8 * fq;
#pragma unroll
                    for (int bj = 0; bj < 2; ++bj) { const f32x4 v0 = acc[ai][bj][m][0] * sc, v1 = acc[ai][bj][m][1] * sc; u32x4 w; w.x = cvt_pk_bf16(v0[0], v0[1]); w.y = cvt_pk_bf16(v0[2], v0[3]); w.z = cvt_pk_bf16(v1[0], v1[1]); w.w = cvt_pk_bf16(v1[2], v1[3]);
                        *(u32x4*)(rowp + bj * 128) = w; } }
        } else if ((0x3C20F0u >> pn) & 1u) {
            bf16_t* VT; int dim0, nd;
            if (pn < 8) { VT = GVT; dim0 = (pn - 4) * 256; nd = 1024; } else if (pn == 13) { VT = AVT; dim0 = 0; nd = 256; } else { VT = RVT; dim0 = (pn - 18) * 256; nd = 1024; }
#pragma unroll
            for (int ai = 0; ai < 2; ++ai)
#pragma unroll
                for (int m = 0; m < 4; ++m) { const int dimr = ai * 128 + wr * 64 + m * 16 + fr; bf16_t* rowp = VT + ((size_t)bl * nd + dim0 + dimr) * TB + t0 + wc * 32 + 8 * fq;
#pragma unroll
                    for (int bj = 0; bj < 2; ++bj) { const f32x4 v0 = acc[ai][bj][m][0], v1 = acc[ai][bj][m][1]; u32x4 w; w.x = cvt_pk_bf16(v0[0], v0[1]); w.y = cvt_pk_bf16(v0[2], v0[3]); w.z = cvt_pk_bf16(v1[0], v1[1]); w.w = cvt_pk_bf16(v1[2], v1[3]);
                        *(u32x4*)(rowp + bj * 128) = w; } }
        } else if (pn == 22) {
            if (wc == 0) {
#pragma unroll
                for (int ai = 0; ai < 2; ++ai)
#pragma unroll
                    for (int m = 0; m < 4; ++m) { const int r = rg0 + ai * 128 + wr * 64 + m * 16 + fr;
#pragma unroll
                        for (int n = 0; n < 2; ++n) *(f32x4*)(GLR + (size_t)r * 32 + 8 * fq + 4 * n) = acc[ai][0][m][n]; }
            }
        } else {
            const bool isatt = pn <= 12;
            bf16_t* O; int ld, colbase; float sc;
            if (pn < 12)       { O = AQ;  ld = 1024; colbase = (pn - 8) * 256;  sc = 0.08838834764831845f * LOG2E; }
            else if (pn == 12) { O = AK;  ld = 256;  colbase = 0;               sc = 1.0f; }
            else if (pn < 16)  { O = RQK; ld = 1024; colbase = (pn - 14) * 256; sc = 1.0f; }
            else               { O = RQK; ld = 1024; colbase = 512 + (pn - 16) * 256; sc = 0.08838834764831845f; }
            const int hb = isatt ? ((wc & 1) * 16 + (wc >> 1) * 64) : 16 * wc;
            const int pstep = isatt ? 32 : 64;
            const int fi = isatt ? ((wc & 1) * 16 + 4 * fq) : (16 * wc + 4 * fq);
#pragma unroll
            for (int ai = 0; ai < 2; ++ai) {
                f32x4 tb[4][2];
#pragma unroll
                for (int m = 0; m < 4; ++m) { const int t = t0 + ai * 128 + wr * 64 + m * 16 + fr;
                    const f32x4* tp;
                    if (isatt) { const int lt = t - NCTX; const int pos = (t < NCTX) ? 0 : ((wc < 2) ? (lt >> 6) : (lt & 63)); tp = (const f32x4*)(atab + pos * 32 + fi); }
                    else tp = (const f32x4*)(rtab + (size_t)t * 64 + fi);
                    tb[m][0] = tp[0]; tb[m][1] = tp[1]; }
#pragma unroll
                for (int m = 0; m < 4; ++m) {
                    const int rl = ai * 128 + wr * 64 + m * 16 + fr; const int r = rg0 + rl;
                    f32x2 cs[4]; { const f32x4 a = tb[m][0], b = tb[m][1]; cs[0] = (f32x2){a[0], a[1]}; cs[1] = (f32x2){a[2], a[3]}; cs[2] = (f32x2){b[0], b[1]}; cs[3] = (f32x2){b[2], b[3]}; }
#pragma unroll
                    for (int bj = 0; bj < 2; ++bj) {
                        const f32x4 x1 = acc[ai][bj][m][0], x2 = acc[ai][bj][m][1];
                        float o1[4], o2[4];
#pragma unroll
                        for (int j = 0; j < 4; ++j) { o1[j] = (x1[j] * cs[j].x - x2[j] * cs[j].y) * sc; o2[j] = (x2[j] * cs[j].x + x1[j] * cs[j].y) * sc; }
                        bf16_t* p = O + (size_t)r * ld + colbase + bj * 128 + hb + 4 * fq;
                        u32x2 w1, w2; w1.x = cvt_pk_bf16(o1[0], o1[1]); w1.y = cvt_pk_bf16(o1[2], o1[3]); w2.x = cvt_pk_bf16(o2[0], o2[1]); w2.y = cvt_pk_bf16(o2[2], o2[3]);
                        *(u32x2*)p = w1; *(u32x2*)(p + pstep) = w2;
                    }
                }
            }
        }
    }
};

struct EpiGateR {
    static constexpr bool PERM = true;
    unsigned char* reg; const f32x2* stats; const float* gng; const float* rng; bool dry;
    __device__ __forceinline__ void operator()(const f32x4 (&acc)[2][2][4][2], const GUnit& u, int wr, int wc, int fr, int fq) const {
        const int mix = u.pn >> 2, head = u.pn & 3;
        bf16_t* O = (bf16_t*)(reg + (mix ? R_ORF : R_OGF));
        const float* gn = (mix ? rng : gng) + head * 256;
        const f32x2* st = stats + (size_t)mix * TG * 4;
        f32x4 ga[2], gb[2];
#pragma unroll
        for (int bj = 0; bj < 2; ++bj) { const int c0 = bj * 128 + wc * 32 + 8 * fq; ga[bj] = *(const f32x4*)(gn + c0); gb[bj] = *(const f32x4*)(gn + c0 + 4); }
#pragma unroll
        for (int ai = 0; ai < 2; ++ai) {
            u32x4 ov[4][2]; f32x2 sv[4];
#pragma unroll
            for (int m = 0; m < 4; ++m) { const int r = u.pm * 256 + ai * 128 + wr * 64 + m * 16 + fr; sv[m] = st[(size_t)r * 4 + head];
#pragma unroll
                for (int bj = 0; bj < 2; ++bj) ov[m][bj] = *(const u32x4*)(O + (size_t)r * 1024 + head * 256 + bj * 128 + wc * 32 + 8 * fq); }
#pragma unroll
            for (int m = 0; m < 4; ++m) { const int r = u.pm * 256 + ai * 128 + wr * 64 + m * 16 + fr; const float mu = sv[m].x, rs = sv[m].y;
#pragma unroll
                for (int bj = 0; bj < 2; ++bj) {
                    const u32x4 o4 = ov[m][bj]; const f32x4 a0 = acc[ai][bj][m][0], a1 = acc[ai][bj][m][1]; const f32x4 g0 = ga[bj], g1 = gb[bj];
                    float y[8];
                    y[0] = (bflo(o4.x) - mu) * rs * g0[0] * silu_f(a0[0]); y[1] = (bfhi(o4.x) - mu) * rs * g0[1] * silu_f(a0[1]);
                    y[2] = (bflo(o4.y) - mu) * rs * g0[2] * silu_f(a0[2]); y[3] = (bfhi(o4.y) - mu) * rs * g0[3] * silu_f(a0[3]);
                    y[4] = (bflo(o4.z) - mu) * rs * g1[0] * silu_f(a1[0]); y[5] = (bfhi(o4.z) - mu) * rs * g1[1] * silu_f(a1[1]);
                    y[6] = (bflo(o4.w) - mu) * rs * g1[2] * silu_f(a1[2]); y[7] = (bfhi(o4.w) - mu) * rs * g1[3] * silu_f(a1[3]);
                    u32x4 w; w.x = cvt_pk_bf16(y[0], y[1]); w.y = cvt_pk_bf16(y[2], y[3]); w.z = cvt_pk_bf16(y[4], y[5]); w.w = cvt_pk_bf16(y[6], y[7]);
                    if (!dry) *(u32x4*)(O + (size_t)r * 1024 + head * 256 + bj * 128 + wc * 32 + 8 * fq) = w;
                } }
        }
    }
};

struct EpiBf16 {
    static constexpr bool PERM = true;
    bf16_t* O; int ld;
    __device__ __forceinline__ void operator()(const f32x4 (&acc)[2][2][4][2], const GUnit& u, int wr, int wc, int fr, int fq) const {
#pragma unroll
        for (int ai = 0; ai < 2; ++ai)
#pragma unroll
            for (int m = 0; m < 4; ++m) { bf16_t* rowp = O + (size_t)(u.pm * 256 + ai * 128 + wr * 64 + m * 16 + fr) * ld + u.pn * 256 + wc * 32 + 8 * fq;
#pragma unroll
                for (int bj = 0; bj < 2; ++bj) { const f32x4 v0 = acc[ai][bj][m][0], v1 = acc[ai][bj][m][1]; u32x4 w; w.x = cvt_pk_bf16(v0[0], v0[1]); w.y = cvt_pk_bf16(v0[2], v0[3]); w.z = cvt_pk_bf16(v1[0], v1[1]); w.w = cvt_pk_bf16(v1[2], v1[3]);
                    *(u32x4*)(rowp + bj * 128) = w; } }
    }
};
struct EpiGZ {
    static constexpr bool PERM = true;
    bf16_t* Z; bool dry;
    __device__ __forceinline__ void operator()(const f32x4 (&acc)[2][2][4][2], const GUnit& u, int wr, int wc, int fr, int fq) const {
#pragma unroll
        for (int ai = 0; ai < 2; ++ai) {
            u32x4 zv[4][2];
#pragma unroll
            for (int m = 0; m < 4; ++m)
#pragma unroll
                for (int bj = 0; bj < 2; ++bj) zv[m][bj] = *(const u32x4*)(Z + (size_t)(u.pm * 256 + ai * 128 + wr * 64 + m * 16 + fr) * 3072 + u.pn * 256 + wc * 32 + 8 * fq + bj * 128);
#pragma unroll
            for (int m = 0; m < 4; ++m) { bf16_t* rowp = Z + (size_t)(u.pm * 256 + ai * 128 + wr * 64 + m * 16 + fr) * 3072 + u.pn * 256 + wc * 32 + 8 * fq;
#pragma unroll
                for (int bj = 0; bj < 2; ++bj) { const f32x4 v0 = acc[ai][bj][m][0], v1 = acc[ai][bj][m][1]; const u32x4 z = zv[m][bj]; u32x4 w;
                    w.x = cvt_pk_bf16(sigmoid_f(v0[0]) * bflo(z.x), sigmoid_f(v0[1]) * bfhi(z.x)); w.y = cvt_pk_bf16(sigmoid_f(v0[2]) * bflo(z.y), sigmoid_f(v0[3]) * bfhi(z.y));
                    w.z = cvt_pk_bf16(sigmoid_f(v1[0]) * bflo(z.z), sigmoid_f(v1[1]) * bfhi(z.z)); w.w = cvt_pk_bf16(sigmoid_f(v1[2]) * bflo(z.w), sigmoid_f(v1[3]) * bfhi(z.w));
                    if (!dry) *(u32x4*)(rowp + bj * 128) = w; } }
        }
    }
};
struct EpiZG {
    static constexpr bool PERM = true;
    bf16_t* Z; bool dry;
    __device__ __forceinline__ void operator()(const f32x4 (&acc)[2][2][4][2], const GUnit& u, int wr, int wc, int fr, int fq) const {
        if (dry) { if (acc[0][0][0][0][0] == 1234.5678f) Z[0] = 1; return; }
        if (u.x0 == 0) { EpiBf16 e{Z, 3072}; e(acc, u, wr, wc, fr, fq); } else { EpiGZ e{Z, false}; e(acc, u, wr, wc, fr, fq); }
    }
};
struct EpiZGc {
    static constexpr bool PERM = true;
    bf16_t* Z;
    __device__ __forceinline__ void operator()(const f32x4 (&acc)[2][2][4][2], const GUnit& u, int wr, int wc, int fr, int fq) const {
        if (u.x0 == 0) { EpiBf16 e{Z, 3072}; e(acc, u, wr, wc, fr, fq); return; }
        const int br = u.x1, pc = u.pn - br * 4;
#pragma unroll
        for (int ai = 0; ai < 2; ++ai) {
            u32x4 zv[4][2], mv[4][2];
#pragma unroll
            for (int m = 0; m < 4; ++m)
#pragma unroll
                for (int bj = 0; bj < 2; ++bj) { const bf16_t* rp = Z + (size_t)(u.pm * 256 + ai * 128 + wr * 64 + m * 16 + fr) * 3072 + wc * 32 + 8 * fq + bj * 128;
                    zv[m][bj] = *(const u32x4*)(rp + u.pn * 256); mv[m][bj] = (br > 0) ? *(const u32x4*)(rp + pc * 256) : (u32x4){0u, 0u, 0u, 0u}; }
#pragma unroll
            for (int m = 0; m < 4; ++m) { bf16_t* rowp = Z + (size_t)(u.pm * 256 + ai * 128 + wr * 64 + m * 16 + fr) * 3072 + pc * 256 + wc * 32 + 8 * fq;
#pragma unroll
                for (int bj = 0; bj < 2; ++bj) { const f32x4 v0 = acc[ai][bj][m][0], v1 = acc[ai][bj][m][1]; const u32x4 z = zv[m][bj], mm = mv[m][bj]; u32x4 w;
                    w.x = cvt_pk_bf16(bflo(mm.x) + sigmoid_f(v0[0]) * bflo(z.x), bfhi(mm.x) + sigmoid_f(v0[1]) * bfhi(z.x)); w.y = cvt_pk_bf16(bflo(mm.y) + sigmoid_f(v0[2]) * bflo(z.y), bfhi(mm.y) + sigmoid_f(v0[3]) * bfhi(z.y));
                    w.z = cvt_pk_bf16(bflo(mm.z) + sigmoid_f(v1[0]) * bflo(z.z), bfhi(mm.z) + sigmoid_f(v1[1]) * bfhi(z.z)); w.w = cvt_pk_bf16(bflo(mm.w) + sigmoid_f(v1[2]) * bflo(z.w), bfhi(mm.w) + sigmoid_f(v1[3]) * bfhi(z.w));
                    *(u32x4*)(rowp + bj * 128) = w; } }
        }
    }
};
struct EpiOut {
    static constexpr bool PERM = false;
    const float* xin_lat; const float* xin_ctx; float* xout_lat; float* xout_ctx; const float* mod; int g; bool dry;
    __device__ __forceinline__ void operator()(const f32x4 (&acc)[2][2][4][2], const GUnit& u, int wr, int wc, int fr, int fq) const {
        const int rg0 = u.pm * 256; const int bl = rg0 / TB, t0 = rg0 - bl * TB; const int b = g * BG + bl;
        const bool isctx = t0 < NCTX;
        const float* g1 = mod + (size_t)(isctx ? 8 : b) * 6144 + 2048 + u.pn * 256 + wc * 32 + 4 * fq;
        f32x4 gv[2][2];
#pragma unroll
        for (int bj = 0; bj < 2; ++bj)
#pragma unroll
            for (int n = 0; n < 2; ++n) gv[bj][n] = *(const f32x4*)(g1 + bj * 128 + n * 16);
#pragma unroll
        for (int ai = 0; ai < 2; ++ai) {
            f32x4 xv[4][2][2];
#pragma unroll
            for (int m = 0; m < 4; ++m) { const int t = t0 + ai * 128 + wr * 64 + m * 16 + fr;
                const float* ip = (isctx ? xin_ctx : xin_lat) + (isctx ? ctx_off(b, t) : lat_off(b, t)) + u.pn * 256 + wc * 32 + 4 * fq;
#pragma unroll
                for (int bj = 0; bj < 2; ++bj)
#pragma unroll
                    for (int n = 0; n < 2; ++n) xv[m][bj][n] = *(const f32x4*)(ip + bj * 128 + n * 16); }
#pragma unroll
            for (int m = 0; m < 4; ++m) { const int t = t0 + ai * 128 + wr * 64 + m * 16 + fr;
                float* op = (isctx ? xout_ctx : xout_lat) + (isctx ? ctx_off(b, t) : lat_off(b, t)) + u.pn * 256 + wc * 32 + 4 * fq;
#pragma unroll
                for (int bj = 0; bj < 2; ++bj)
#pragma unroll
                    for (int n = 0; n < 2; ++n) { if (!dry) *(f32x4*)(op + bj * 128 + n * 16) = xv[m][bj][n] + gv[bj][n] * acc[ai][bj][m][n]; } }
        }
    }
};
struct EpiMoe1 {
    static constexpr bool PERM = true;
    bf16_t* Hm;
    __device__ __forceinline__ void operator()(const f32x4 (&acc)[2][2][4][2], const GUnit& u, int wr, int wc, int fr, int fq) const {
#pragma unroll
        for (int ai = 0; ai < 2; ++ai)
#pragma unroll
            for (int m = 0; m < 4; ++m) { const int rl = ai * 128 + wr * 64 + m * 16 + fr;
                if (rl < u.x1) { bf16_t* p = Hm + (size_t)(u.pm + rl) * 1024 + u.pn * 128 + wc * 32 + 8 * fq;
                    const f32x4 a0 = acc[ai][0][m][0], a1 = acc[ai][0][m][1], b0 = acc[ai][1][m][0], b1 = acc[ai][1][m][1]; u32x4 w;
                    w.x = cvt_pk_bf16(silu_f(a0[0]) * b0[0], silu_f(a0[1]) * b0[1]); w.y = cvt_pk_bf16(silu_f(a0[2]) * b0[2], silu_f(a0[3]) * b0[3]);
                    w.z = cvt_pk_bf16(silu_f(a1[0]) * b1[0], silu_f(a1[1]) * b1[1]); w.w = cvt_pk_bf16(silu_f(a1[2]) * b1[2], silu_f(a1[3]) * b1[3]);
                    *(u32x4*)p = w; } }
    }
};
struct EpiMoe2 {
    static constexpr bool PERM = true;
    bf16_t* Y; const float* slotw;
    __device__ __forceinline__ void operator()(const f32x4 (&acc)[2][2][4][2], const GUnit& u, int wr, int wc, int fr, int fq) const {
        float sw[2][4];
#pragma unroll
        for (int ai = 0; ai < 2; ++ai)
#pragma unroll
            for (int m = 0; m < 4; ++m) sw[ai][m] = slotw[u.pm + ai * 128 + wr * 64 + m * 16 + fr];
#pragma unroll
        for (int ai = 0; ai < 2; ++ai)
#pragma unroll
            for (int m = 0; m < 4; ++m) { const int rl = ai * 128 + wr * 64 + m * 16 + fr;
                if (rl < u.x1) { const float w8 = sw[ai][m]; bf16_t* rowp = Y + (size_t)(u.pm + rl) * 1024 + u.pn * 256 + wc * 32 + 8 * fq;
#pragma unroll
                    for (int bj = 0; bj < 2; ++bj) { const f32x4 v0 = acc[ai][bj][m][0] * w8, v1 = acc[ai][bj][m][1] * w8; u32x4 w; w.x = cvt_pk_bf16(v0[0], v0[1]); w.y = cvt_pk_bf16(v0[2], v0[3]); w.z = cvt_pk_bf16(v1[0], v1[1]); w.w = cvt_pk_bf16(v1[2], v1[3]);
                        *(u32x4*)(rowp + bj * 128) = w; } } }
    }
};

template <class F>
__device__ __forceinline__ void conv_tile(LAS float* tile, F f, int n0, int k0src, size_t ldsrc, bf16_t* dst, size_t dst_ld, int k0dst) {
    const int tid = tid_fresh(), c4 = tid & 31, kb = tid >> 5;
    const float* colp = f(n0 + 4 * c4);
#pragma unroll
    for (int i = 0; i < 4; ++i) { const int kl = kb + 16 * i; const f32x4 v = colp ? *(const f32x4*)(colp + (size_t)(k0src + kl) * ldsrc) : (f32x4){0.f, 0.f, 0.f, 0.f}; *(LAS f32x4*)(tile + kl * 132 + 4 * c4) = v; }
    __syncthreads();
    const int n2 = tid >> 2, k16 = (tid & 3) * 16;
    u32x4 w0, w1;
    w0.x = cvt_pk_bf16(tile[(k16 + 0) * 132 + n2], tile[(k16 + 1) * 132 + n2]); w0.y = cvt_pk_bf16(tile[(k16 + 2) * 132 + n2], tile[(k16 + 3) * 132 + n2]);
    w0.z = cvt_pk_bf16(tile[(k16 + 4) * 132 + n2], tile[(k16 + 5) * 132 + n2]); w0.w = cvt_pk_bf16(tile[(k16 + 6) * 132 + n2], tile[(k16 + 7) * 132 + n2]);
    w1.x = cvt_pk_bf16(tile[(k16 + 8) * 132 + n2], tile[(k16 + 9) * 132 + n2]); w1.y = cvt_pk_bf16(tile[(k16 + 10) * 132 + n2], tile[(k16 + 11) * 132 + n2]);
    w1.z = cvt_pk_bf16(tile[(k16 + 12) * 132 + n2], tile[(k16 + 13) * 132 + n2]); w1.w = cvt_pk_bf16(tile[(k16 + 14) * 132 + n2], tile[(k16 + 15) * 132 + n2]);
    bf16_t* dp = dst + (size_t)(n0 + n2) * dst_ld + k0dst + k16;
    *(u32x4*)dp = w0; *(u32x4*)(dp + 8) = w1;
    __syncthreads();
}
__device__ __forceinline__ int win_col(int np) {
    if (np < 5888) {
        const int tile = np >> 8, p = np & 255, hh = p >> 7, pp = p & 127, wc = pp >> 5, n = (pp >> 2) & 1, q = 4 * ((pp >> 3) & 3) + (pp & 3);
        const int fatt = (wc & 1) * 16 + (wc >> 1) * 64 + q + 32 * n, fret = 16 * wc + q + 64 * n;
        if (tile < 8) return np;
        if (tile < 12) return 3104 + (2 * (tile - 8) + hh) * 128 + fatt;
        if (tile == 12) return 4128 + hh * 128 + fatt;
        if (tile == 13) return 4384 + p;
        if (tile < 16) return 4640 + (2 * (tile - 14) + hh) * 128 + fret;
        if (tile < 18) return 5152 + (2 * (tile - 16) + hh) * 128 + fret;
        if (tile < 22) return 5664 + (np - 18 * 256);
        return p < 32 ? 3072 + p : -1;
    }
    if (np < 7936) { const int m = np - 5888; return m < 1024 ? 2048 + m : 6688 + (m - 1024); }
    return 7712 + (np - 7936);
}
struct FWin { const float* w; __device__ __forceinline__ const float* operator()(int np) const { const int c = win_col(np); return c < 0 ? nullptr : w + c; } };
struct FPlain { const float* w; __device__ __forceinline__ const float* operator()(int n) const { return w + n; } };
struct FW13 { const float* w1; const float* w3; __device__ __forceinline__ const float* operator()(int np) const { const int tile = np >> 8, r = np & 255; return r < 128 ? w1 + tile * 128 + r : w3 + tile * 128 + (r - 128); } };

constexpr int PRO_MOD = 384, PRO_TAB = 8 + 1056, PRO_WR = 192, PRO_WIN = 2 * 86 * 16, PRO_WBR = 2 * 3 * 8 * 16, PRO_WO3 = 2 * 8 * 48, PRO_WO1 = 2 * 8 * 16;
constexpr int PRO_UNITS = PRO_MOD + PRO_TAB + PRO_WR + PRO_WIN + PRO_WBR + PRO_WO3 + PRO_WO1;

__device__ __forceinline__ void prologue1(KP p, LAS unsigned char* lds) {
    unsigned char* ws = p.ws; const int tid = tid_fresh();
    LAS float* tile = (LAS float*)lds;
    for (int u = blockIdx.x; u < PRO_UNITS; u += gridDim.x) {
        int idx = u;
        if (idx < PRO_MOD) {
            const int l = idx / 192, rem = idx % 192, cb = rem / 16, ks = rem % 16, k0 = ks * 64;
            LAS float* sv = tile;
            for (int e = tid; e < 9 * 64; e += 512) { const int r = e >> 6, kk = e & 63; const float cv = (r < 8) ? p.in[1][r * 1024 + k0 + kk] : p.in[3][k0 + kk]; sv[e] = cv / (1.0f + expf(-cv)); }
            __syncthreads();
            const int n = cb * 512 + tid; const float* w = p.in[4] + ((size_t)l * 1024 + k0) * 6144 + n;
            float a[9];
#pragma unroll
            for (int r = 0; r < 9; ++r) a[r] = 0.f;
            for (int kk = 0; kk < 64; ++kk) { const float wv = w[(size_t)kk * 6144];
#pragma unroll
                for (int r = 0; r < 9; ++r) a[r] += sv[r * 64 + kk] * wv; }
            float* mp = (float*)(ws + OFF_MODP);
#pragma unroll
            for (int r = 0; r < 9; ++r) mp[((size_t)(ks * 2 + l) * 9 + r) * 6144 + n] = a[r];
            __syncthreads();
            continue;
        }
        idx -= PRO_MOD;
        if (idx < PRO_TAB) {
            const int e = idx * 512 + tid;
            if (e < 4096) { const int pos = e >> 5, i = e & 31; const float inv = powf(10000.0f, -(float)i / 32.0f); const float ang = (float)pos * inv; float s, c; sincosf(ang, &s, &c); ((f32x2*)(ws + OFF_ATAB))[e] = (f32x2){c, s}; }
            else { const int e2 = e - 4096; if (e2 < TB * 64) { const int pos = e2 >> 6, i = e2 & 63; const float inv = powf(10000.0f, -(float)i / 64.0f); const float ang = (float)pos * inv; float s, c; sincosf(ang, &s, &c); ((f32x2*)(ws + OFF_RTAB))[e2] = (f32x2){c, s}; } }
            continue;
        }
        idx -= PRO_TAB;
        if (idx < PRO_WR) {
            const int e = idx * 512 + tid; const int k = e & 1023, n = (e >> 10) % 48, l = e / (48 * 1024);
            const float v = n < 4 ? p.in[18][((size_t)l * 1024 + k) * 4 + n] : (n < 36 ? p.in[20][((size_t)l * 1024 + k) * 32 + (n - 4)] : 0.f);
            const bf16_t hi = f2bf(v); const bf16_t lo = f2bf(v - bf2f(hi));
            bf16_t* W = (bf16_t*)(ws + OFF_WR) + (size_t)l * 2 * 48 * 1024;
            W[(size_t)n * 1024 + k] = hi; W[(size_t)(48 + n) * 1024 + k] = lo;
            continue;
        }
        idx -= PRO_WR;
        if (idx < PRO_WIN) {
            const int l = idx / (86 * 16), rem = idx % (86 * 16), nt = rem / 16, kt = rem % 16;
            FWin f{p.in[8] + (size_t)l * 1024 * NIN};
            conv_tile(tile, f, nt * 128, kt * 64, NIN, (bf16_t*)(ws + OFF_WINT) + (size_t)l * WIN_ROWS * 1024, 1024, kt * 64);
            continue;
        }
        idx -= PRO_WIN;
        if (idx < PRO_WBR) {
            const int lb = idx / 128, rem = idx % 128, nt = rem / 16, kt = rem % 16; const int l = lb / 3, br = lb % 3;
            FPlain f{p.in[14 + br] + (size_t)l * 1024 * 1024};
            conv_tile(tile, f, nt * 128, kt * 64, 1024, (bf16_t*)(ws + OFF_WBRT) + (size_t)lb * 1024 * 1024, 1024, kt * 64);
            continue;
        }
        idx -= PRO_WBR;
        if (idx < PRO_WO3) {
            const int l = idx / (8 * 48), rem = idx % (8 * 48), nt = rem / 48, kt = rem % 48;
            FPlain f{p.in[17] + (size_t)l * 1024 * 1024};
            conv_tile(tile, f, nt * 128, (kt % 16) * 64, 1024, (bf16_t*)(ws + OFF_WO3T) + (size_t)l * 1024 * 3072, 3072, kt * 64);
            continue;
        }
        idx -= PRO_WO3;
        {
            const int l = idx / 128, rem = idx % 128, nt = rem / 16, kt = rem % 16;
            FPlain f{p.in[17] + (size_t)l * 1024 * 1024};
            conv_tile(tile, f, nt * 128, kt * 64, 1024, (bf16_t*)(ws + OFF_WO1T) + (size_t)l * 1024 * 1024, 1024, kt * 64);
        }
    }
}
__device__ __forceinline__ void prologue2(KP p) {

    const float* mp = (const float*)(p.ws + OFF_MODP); float* mo = (float*)(p.ws + OFF_MOD);
    for (int e = blockIdx.x * 512 + tid_fresh(); e < 2 * 9 * 6144; e += gridDim.x * 512) {
        const int l = e / (9 * 6144), n = e % 6144;
        float s = p.in[5][l * 6144 + n];
#pragma unroll
        for (int ks = 0; ks < 16; ++ks) s += mp[(size_t)ks * 2 * 9 * 6144 + e];
        mo[e] = s;
    }
}
__device__ __forceinline__ void moe_convert(KP p, int layer, LAS unsigned char* lds) {
    bf16_t* W13T = (bf16_t*)(p.ws + OFF_REG + M_W13T); bf16_t* W2T = (bf16_t*)(p.ws + OFF_REG + M_W2T);
    const int tid = tid_fresh(), n2 = tid >> 2, k16 = (tid & 3) * 16;
    const float* w1 = p.in[22] + (size_t)layer * 32 * 1024 * 1024; const float* w3 = p.in[23] + (size_t)layer * 32 * 1024 * 1024; const float* w2 = p.in[24] + (size_t)layer * 32 * 1024 * 1024;
    constexpr int NT = 32 * 16 * 16 + 32 * 8 * 16;
#pragma unroll 2
    for (int u = blockIdx.x; u < NT; u += gridDim.x) {
        const float* sp; bf16_t* dp;
        if (u < 32 * 16 * 16) { const int e = u >> 8, rem = u & 255, nt = rem >> 4, kt = rem & 15; const int np = nt * 128 + n2, tl = np >> 8, r = np & 255;
            sp = (r < 128 ? w1 + tl * 128 + r : w3 + tl * 128 + (r - 128)) + (size_t)e * 1024 * 1024 + (size_t)(kt * 64 + k16) * 1024;
            dp = W13T + ((size_t)e * 2048 + np) * 1024 + kt * 64 + k16; }
        else { const int v = u - 32 * 16 * 16; const int e = v >> 7, rem = v & 127, nt = rem >> 4, kt = rem & 15;
            sp = w2 + (size_t)e * 1024 * 1024 + (size_t)(kt * 64 + k16) * 1024 + nt * 128 + n2;
            dp = W2T + ((size_t)e * 1024 + nt * 128 + n2) * 1024 + kt * 64 + k16; }
        float v[16];
#pragma unroll
        for (int i = 0; i < 16; ++i) v[i] = sp[(size_t)i * 1024];
        u32x4 w0, w1v;
        w0.x = cvt_pk_bf16(v[0], v[1]); w0.y = cvt_pk_bf16(v[2], v[3]); w0.z = cvt_pk_bf16(v[4], v[5]); w0.w = cvt_pk_bf16(v[6], v[7]);
        w1v.x = cvt_pk_bf16(v[8], v[9]); w1v.y = cvt_pk_bf16(v[10], v[11]); w1v.z = cvt_pk_bf16(v[12], v[13]); w1v.w = cvt_pk_bf16(v[14], v[15]);
        *(u32x4*)dp = w0; *(u32x4*)(dp + 8) = w1v;
    }
}

template <int MODE>
__device__ __forceinline__ void norm_phase(KP p, int layer, bool dry) {
    unsigned char* ws = p.ws; const int tid_ = tid_fresh(); const int lane = tid_ & 63, wid = tid_ >> 6;
    const float* MOD = (const float*)(ws + OFF_MOD); float* CTXS = (float*)(ws + OFF_CTXS); bf16_t* H = (bf16_t*)(ws + OFF_H);
    const int* TOKSL = (const int*)(ws + OFF_TOKSL); const bf16_t* YS = (const bf16_t*)(ws + OFF_REG + M_XG);
    for (int R = blockIdx.x * 8 + wid; R < TALL; R += gridDim.x * 8) {
        const int b = R / TB, t = R - b * TB; const bool isctx = t < NCTX; const int r9 = isctx ? 8 : b;
        if ((MODE == 3 || (MODE == 2 && layer == 1)) && isctx) continue;
        const float* src; float* dstx;
        if (MODE == 0) { src = isctx ? p.in[2] + ctx_off(b, t) : p.in[0] + lat_off(b, t); dstx = nullptr; }
        else { dstx = isctx ? CTXS + ctx_off(b, t) : p.out + lat_off(b, t); src = dstx; }
        f32x4 x[4];
#pragma unroll
        for (int i = 0; i < 4; ++i) x[i] = *(const f32x4*)(src + 256 * i + 4 * lane);
        if (MODE == 1 || MODE == 3) {
            const int pl = (MODE == 1) ? layer - 1 : 1;
            const float* g2 = MOD + ((size_t)pl * 9 + r9) * 6144 + 5120;
            const int sa = TOKSL[R * 2], sb = TOKSL[R * 2 + 1];
#pragma unroll
            for (int i = 0; i < 4; ++i) { const int c = 256 * i + 4 * lane; const u32x2 ya = *(const u32x2*)(YS + (size_t)sa * 1024 + c), yb = *(const u32x2*)(YS + (size_t)sb * 1024 + c); const f32x4 gv = *(const f32x4*)(g2 + c);
                x[i][0] += gv[0] * (bflo(ya.x) + bflo(yb.x)); x[i][1] += gv[1] * (bfhi(ya.x) + bfhi(yb.x)); x[i][2] += gv[2] * (bflo(ya.y) + bflo(yb.y)); x[i][3] += gv[3] * (bfhi(ya.y) + bfhi(yb.y)); }
            if (MODE == 1 && !dry) {
#pragma unroll
                for (int i = 0; i < 4; ++i) *(f32x4*)(dstx + 256 * i + 4 * lane) = x[i];
            }
        }
        float ss = 0.f;
#pragma unroll
        for (int i = 0; i < 4; ++i) ss += x[i][0] * x[i][0] + x[i][1] * x[i][1] + x[i][2] * x[i][2] + x[i][3] * x[i][3];
        ss = wave_sum(ss, lane);
        const float rstd = rsqrtf(ss * (1.0f / 1024.0f) + 1e-6f);
        if (MODE == 3) {
#pragma unroll
            for (int i = 0; i < 4; ++i) { const int c = 256 * i + 4 * lane; const f32x4 g = *(const f32x4*)(p.in[25] + c);
                if (!dry) *(f32x4*)(p.out + lat_off(b, t) + c) = x[i] * rstd * g; }
            continue;
        }
        const float* gain = (MODE == 2 ? p.in[7] : p.in[6]) + layer * 1024;
        const float* mrow = MOD + ((size_t)layer * 9 + r9) * 6144 + (MODE == 2 ? 3072 : 0);
        f32x4 h[4];
#pragma unroll
        for (int i = 0; i < 4; ++i) { const int c = 256 * i + 4 * lane; const f32x4 g = *(const f32x4*)(gain + c), sh = *(const f32x4*)(mrow + c), sc = *(const f32x4*)(mrow + 1024 + c);
            h[i] = (x[i] * rstd * g) * (sc + 1.0f) + sh;
            u32x2 w; w.x = cvt_pk_bf16(h[i][0], h[i][1]); w.y = cvt_pk_bf16(h[i][2], h[i][3]); *(u32x2*)(H + (size_t)R * 1024 + c) = w; }
        if (MODE == 2) {
            const float* WR = (const float*)(ws + OFF_WR) + (size_t)layer * 1024 * 36;
            float a[36];
#pragma unroll
            for (int o = 0; o < 36; ++o) a[o] = 0.f;
#pragma unroll
            for (int i = 0; i < 4; ++i)
#pragma unroll
                for (int jj = 0; jj < 4; ++jj) { const float hv = h[i][jj]; const f32x4* wrow = (const f32x4*)(WR + (size_t)(256 * i + 4 * lane + jj) * 36);
#pragma unroll
                    for (int o4 = 0; o4 < 9; ++o4) { const f32x4 w = wrow[o4]; a[4 * o4] += hv * w[0]; a[4 * o4 + 1] += hv * w[1]; a[4 * o4 + 2] += hv * w[2]; a[4 * o4 + 3] += hv * w[3]; } }
#pragma unroll
            for (int o = 0; o < 36; ++o) a[o] = wave_sum(a[o], lane);
            if (lane == 0) {
                const float* bg = p.in[19] + layer * 4; const float* be = p.in[21] + layer * 32;
                float gl[4];
#pragma unroll
                for (int j = 0; j < 4; ++j) gl[j] = a[j] + bg[j];
                int grp = 0; float gm = gl[0];
#pragma unroll
                for (int j = 1; j < 4; ++j) if (gl[j] > gm) { gm = gl[j]; grp = j; }
                float den = 0.f;
#pragma unroll
                for (int j = 0; j < 4; ++j) den += expf(gl[j] - gm);
                const float gp = 1.0f / den;
                float v1 = -3.0e38f, v2 = -3.0e38f; int i1 = 0, i2 = 0;
#pragma unroll
                for (int j = 0; j < 8; ++j) {
                    const float lv = (grp == 0 ? a[4 + j] : grp == 1 ? a[12 + j] : grp == 2 ? a[20 + j] : a[28 + j]) + be[grp * 8 + j];
                    if (lv > v1) { v2 = v1; i2 = i1; v1 = lv; i1 = j; } else if (lv > v2) { v2 = lv; i2 = j; }
                }
                const float e2 = expf(v2 - v1); const float w1 = gp / (1.0f + e2), w2 = gp * e2 / (1.0f + e2);
                const int ex1 = grp * 8 + i1, ex2 = grp * 8 + i2;
                unsigned* cnt = (unsigned*)(ws + OFF_CNT) + layer * 32;
                const unsigned r1 = atomicAdd(cnt + ex1, 1u), r2 = atomicAdd(cnt + ex2, 1u);
                int* EX = (int*)(ws + OFF_EXPID); float* GW = (float*)(ws + OFF_GATEW); int* RK = (int*)(ws + OFF_RANK);
                EX[R * 2] = ex1; EX[R * 2 + 1] = ex2; GW[R * 2] = w1; GW[R * 2 + 1] = w2; RK[R * 2] = (int)r1; RK[R * 2 + 1] = (int)r2;
            }
        }
    }
}

template <int MODE>
__device__ __forceinline__ void norm_phase2(KP p, int layer, bool dry) {
    unsigned char* ws = p.ws; const int tid_ = tid_fresh(); const int lane = tid_ & 63, wid = tid_ >> 6;
    const float* MOD = (const float*)(ws + OFF_MOD); float* CTXS = (float*)(ws + OFF_CTXS); bf16_t* H = (bf16_t*)(ws + OFF_H);
    const int* TOKSL = (const int*)(ws + OFF_TOKSL); const bf16_t* YS = (const bf16_t*)(ws + OFF_REG + M_XG);
    const int stride = gridDim.x * 8;
    for (int R0 = blockIdx.x * 8 + wid; R0 < TALL; R0 += 2 * stride) {
        int Rr[2], bb[2], tt[2]; bool ok[2], ic[2];
#pragma unroll
        for (int rr = 0; rr < 2; ++rr) { const int R = R0 + rr * stride; ok[rr] = R < TALL; Rr[rr] = ok[rr] ? R : R0; bb[rr] = Rr[rr] / TB; tt[rr] = Rr[rr] - bb[rr] * TB; ic[rr] = tt[rr] < NCTX; if (MODE == 3 && ic[rr]) ok[rr] = false; }
        f32x4 x[2][4]; int sa[2], sb[2];
#pragma unroll
        for (int rr = 0; rr < 2; ++rr) {
            const float* src;
            if (MODE == 0) src = ic[rr] ? p.in[2] + ctx_off(bb[rr], tt[rr]) : p.in[0] + lat_off(bb[rr], tt[rr]);
            else src = ic[rr] ? CTXS + ctx_off(bb[rr], tt[rr]) : p.out + lat_off(bb[rr], tt[rr]);
#pragma unroll
            for (int i = 0; i < 4; ++i) x[rr][i] = *(const f32x4*)(src + 256 * i + 4 * lane);
            if (MODE == 1 || MODE == 3) { sa[rr] = TOKSL[Rr[rr] * 2]; sb[rr] = TOKSL[Rr[rr] * 2 + 1]; }
        }
        u32x2 ya[2][4], yb[2][4];
        if (MODE == 1 || MODE == 3) {
#pragma unroll
            for (int rr = 0; rr < 2; ++rr)
#pragma unroll
                for (int i = 0; i < 4; ++i) { const int c = 256 * i + 4 * lane; ya[rr][i] = *(const u32x2*)(YS + (size_t)sa[rr] * 1024 + c); yb[rr][i] = *(const u32x2*)(YS + (size_t)sb[rr] * 1024 + c); }
        }
#pragma unroll
        for (int rr = 0; rr < 2; ++rr) {
            if (!ok[rr]) continue;
            const int R = Rr[rr], b = bb[rr], t = tt[rr]; const int r9 = ic[rr] ? 8 : b;
            if (MODE == 1 || MODE == 3) {
                const int pl = (MODE == 1) ? layer - 1 : 1;
                const float* g2 = MOD + ((size_t)pl * 9 + r9) * 6144 + 5120;
#pragma unroll
                for (int i = 0; i < 4; ++i) { const int c = 256 * i + 4 * lane; const f32x4 gv = *(const f32x4*)(g2 + c); const u32x2 a = ya[rr][i], b2 = yb[rr][i];
                    x[rr][i][0] += gv[0] * (bflo(a.x) + bflo(b2.x)); x[rr][i][1] += gv[1] * (bfhi(a.x) + bfhi(b2.x)); x[rr][i][2] += gv[2] * (bflo(a.y) + bflo(b2.y)); x[rr][i][3] += gv[3] * (bfhi(a.y) + bfhi(b2.y)); }
                if (MODE == 1 && !dry) { float* dstx = ic[rr] ? CTXS + ctx_off(b, t) : p.out + lat_off(b, t);
#pragma unroll
                    for (int i = 0; i < 4; ++i) *(f32x4*)(dstx + 256 * i + 4 * lane) = x[rr][i]; }
            }
            float ss = 0.f;
#pragma unroll
            for (int i = 0; i < 4; ++i) ss += x[rr][i][0] * x[rr][i][0] + x[rr][i][1] * x[rr][i][1] + x[rr][i][2] * x[rr][i][2] + x[rr][i][3] * x[rr][i][3];
            ss = wave_sum(ss, lane);
            const float rstd = rsqrtf(ss * (1.0f / 1024.0f) + 1e-6f);
            if (MODE == 3) {
#pragma unroll
                for (int i = 0; i < 4; ++i) { const int c = 256 * i + 4 * lane; const f32x4 g = *(const f32x4*)(p.in[25] + c);
                    if (!dry) *(f32x4*)(p.out + lat_off(b, t) + c) = x[rr][i] * rstd * g; }
            } else {
                const float* gain = p.in[6] + layer * 1024;
                const float* mrow = MOD + ((size_t)layer * 9 + r9) * 6144;
#pragma unroll
                for (int i = 0; i < 4; ++i) { const int c = 256 * i + 4 * lane; const f32x4 g = *(const f32x4*)(gain + c), sh = *(const f32x4*)(mrow + c), sc = *(const f32x4*)(mrow + 1024 + c);
                    const f32x4 h = (x[rr][i] * rstd * g) * (sc + 1.0f) + sh;
                    u32x2 w; w.x = cvt_pk_bf16(h[0], h[1]); w.y = cvt_pk_bf16(h[2], h[3]); *(u32x2*)(H + (size_t)R * 1024 + c) = w; }
            }
        }
    }
}

__device__ __forceinline__ void norm2_router(KP p, int layer, LAS unsigned char* lds, bool dry) {
    (void)dry;
    unsigned char* ws = p.ws; const int tid_ = tid_fresh(); const int lane = tid_ & 63, wid = tid_ >> 6, fr = lane & 15, fq = lane >> 4;
    const float* MOD = (const float*)(ws + OFF_MOD); const float* CTXS = (const float*)(ws + OFF_CTXS); bf16_t* H = (bf16_t*)(ws + OFF_H);
    const bf16_t* WH = (const bf16_t*)(ws + OFF_WR) + (size_t)layer * 2 * 48 * 1024; const bf16_t* WL = WH + 48 * 1024;
    LAS float* ssp = (LAS float*)lds;
    LAS float* part = (LAS float*)(lds + 512);
    LAS float* lgf = (LAS float*)(lds + 512 + 8 * 16 * 48 * 4);
    LAS unsigned* lcnt = (LAS unsigned*)(lds + 512 + 8 * 16 * 48 * 4 + 16 * 48 * 4);
    __syncthreads();
    if (tid_ < 64) lcnt[tid_] = 0u;
    __syncthreads();
    const float* gain = p.in[7] + layer * 1024;
    const int cw = 128 * wid + 8 * fq;
    const int ntask = TALL / 16;
    auto xrow = [&](int task) -> const float* { const int R0 = task * 16; const int b = R0 / TB, t = R0 - b * TB; return (t < NCTX ? CTXS + ctx_off(b, t + fr) : p.out + lat_off(b, t + fr)) + cw; };
    auto skip = [&](int task) -> bool { return layer == 1 && ((task * 16) % TB) < NCTX; };
    f32x4 xn[4][2];
    int task = blockIdx.x; while (task < ntask && skip(task)) task += gridDim.x;
    if (task < ntask) { const float* src = xrow(task);
#pragma unroll
        for (int s2 = 0; s2 < 4; ++s2) { xn[s2][0] = *(const f32x4*)(src + 32 * s2); xn[s2][1] = *(const f32x4*)(src + 32 * s2 + 4); } }
    while (task < ntask) {
        const int R0 = task * 16; const int b = R0 / TB, t = R0 - b * TB; const bool isctx = t < NCTX; const int r9 = isctx ? 8 : b;
        f32x4 x[4][2];
#pragma unroll
        for (int s2 = 0; s2 < 4; ++s2) { x[s2][0] = xn[s2][0]; x[s2][1] = xn[s2][1]; }
        int nxt = task + gridDim.x; while (nxt < ntask && skip(nxt)) nxt += gridDim.x;
        if (nxt < ntask) { const float* src = xrow(nxt);
#pragma unroll
            for (int s2 = 0; s2 < 4; ++s2) { xn[s2][0] = *(const f32x4*)(src + 32 * s2); xn[s2][1] = *(const f32x4*)(src + 32 * s2 + 4); } }
        float ss = 0.f;
#pragma unroll
        for (int s2 = 0; s2 < 4; ++s2) { const f32x4 a = x[s2][0], c = x[s2][1]; ss += a[0] * a[0] + a[1] * a[1] + a[2] * a[2] + a[3] * a[3] + c[0] * c[0] + c[1] * c[1] + c[2] * c[2] + c[3] * c[3]; }
        ss += sx(ss, 16, lane); ss += sx(ss, 32, lane);
        if (fq == 0) ssp[wid * 16 + fr] = ss;
        __syncthreads();
        float tot = 0.f;
#pragma unroll
        for (int w2 = 0; w2 < 8; ++w2) tot += ssp[w2 * 16 + fr];
        const float rstd = rsqrtf(tot * (1.0f / 1024.0f) + 1e-6f);
        const float* mrow = MOD + ((size_t)layer * 9 + r9) * 6144 + 3072 + cw;
        const float* grow = gain + cw;
        bf16_t* hrow = H + (size_t)(R0 + fr) * 1024 + cw;
        f32x4 acc[3];
#pragma unroll
        for (int nb = 0; nb < 3; ++nb) acc[nb] = (f32x4){0.f, 0.f, 0.f, 0.f};
#pragma unroll
        for (int s2 = 0; s2 < 4; ++s2) {
            const int c = 32 * s2;
            const f32x4 g0 = *(const f32x4*)(grow + c), g1 = *(const f32x4*)(grow + c + 4);
            const f32x4 sh0 = *(const f32x4*)(mrow + c), sh1 = *(const f32x4*)(mrow + c + 4), sc0 = *(const f32x4*)(mrow + 1024 + c), sc1 = *(const f32x4*)(mrow + 1024 + c + 4);
            const f32x4 h0 = (x[s2][0] * rstd * g0) * (sc0 + 1.0f) + sh0, h1 = (x[s2][1] * rstd * g1) * (sc1 + 1.0f) + sh1;
            u32x4 hw; hw.x = cvt_pk_bf16(h0[0], h0[1]); hw.y = cvt_pk_bf16(h0[2], h0[3]); hw.z = cvt_pk_bf16(h1[0], h1[1]); hw.w = cvt_pk_bf16(h1[2], h1[3]);
            *(u32x4*)(hrow + c) = hw;
            u32x4 lw; lw.x = cvt_pk_bf16(h0[0] - bflo(hw.x), h0[1] - bfhi(hw.x)); lw.y = cvt_pk_bf16(h0[2] - bflo(hw.y), h0[3] - bfhi(hw.y));
            lw.z = cvt_pk_bf16(h1[0] - bflo(hw.z), h1[1] - bfhi(hw.z)); lw.w = cvt_pk_bf16(h1[2] - bflo(hw.w), h1[3] - bfhi(hw.w));
            const bf16x8 ahi = __builtin_bit_cast(bf16x8, hw), alo = __builtin_bit_cast(bf16x8, lw);
#pragma unroll
            for (int nb = 0; nb < 3; ++nb) {
                const bf16x8 bhi = *(const bf16x8*)(WH + (size_t)(16 * nb + fr) * 1024 + cw + c), blo = *(const bf16x8*)(WL + (size_t)(16 * nb + fr) * 1024 + cw + c);
                acc[nb] = __builtin_amdgcn_mfma_f32_16x16x32_bf16(ahi, bhi, acc[nb], 0, 0, 0);
                acc[nb] = __builtin_amdgcn_mfma_f32_16x16x32_bf16(alo, bhi, acc[nb], 0, 0, 0);
                acc[nb] = __builtin_amdgcn_mfma_f32_16x16x32_bf16(ahi, blo, acc[nb], 0, 0, 0);
            }
        }
#pragma unroll
        for (int nb = 0; nb < 3; ++nb)
#pragma unroll
            for (int jj = 0; jj < 4; ++jj) part[(wid * 16 + 4 * fq + jj) * 48 + 16 * nb + fr] = acc[nb][jj];
        __syncthreads();
        for (int e = tid_; e < 16 * 48; e += 512) { float sm = 0.f;
#pragma unroll
            for (int w2 = 0; w2 < 8; ++w2) sm += part[w2 * 16 * 48 + e];
            lgf[e] = sm; }
        __syncthreads();
        if (tid_ < 16) {
            const LAS float* a = lgf + tid_ * 48; const int R = R0 + tid_;
            const float* bg = p.in[19] + layer * 4; const float* be = p.in[21] + layer * 32;
            float gl[4];
#pragma unroll
            for (int j = 0; j < 4; ++j) gl[j] = a[j] + bg[j];
            int grp = 0; float gm = gl[0];
#pragma unroll
            for (int j = 1; j < 4; ++j) if (gl[j] > gm) { gm = gl[j]; grp = j; }
            float den = 0.f;
#pragma unroll
            for (int j = 0; j < 4; ++j) den += expf(gl[j] - gm);
            const float gp = 1.0f / den;
            float v1 = -3.0e38f, v2 = -3.0e38f; int i1 = 0, i2 = 0;
#pragma unroll
            for (int j = 0; j < 8; ++j) { const float lv = a[4 + grp * 8 + j] + be[grp * 8 + j];
                if (lv > v1) { v2 = v1; i2 = i1; v1 = lv; i1 = j; } else if (lv > v2) { v2 = lv; i2 = j; } }
            const float e2 = expf(v2 - v1); const float w1 = gp / (1.0f + e2), w2 = gp * e2 / (1.0f + e2);
            const int ex1 = grp * 8 + i1, ex2 = grp * 8 + i2;
            const unsigned r1 = __hip_atomic_fetch_add(lcnt + ex1, 1u, __ATOMIC_RELAXED, __HIP_MEMORY_SCOPE_WORKGROUP), r2 = __hip_atomic_fetch_add(lcnt + ex2, 1u, __ATOMIC_RELAXED, __HIP_MEMORY_SCOPE_WORKGROUP);
            int* EX = (int*)(ws + OFF_EXPID); float* GW = (float*)(ws + OFF_GATEW); int* RK = (int*)(ws + OFF_RANK);
            EX[R * 2] = ex1; EX[R * 2 + 1] = ex2; GW[R * 2] = w1; GW[R * 2 + 1] = w2; RK[R * 2] = (int)r1; RK[R * 2 + 1] = (int)r2;
        }
        task = nxt;
    }
    __syncthreads();
    if (tid_ < 32) { unsigned* cnt = (unsigned*)(ws + OFF_CNT) + layer * 32; const unsigned c = lcnt[tid_]; lcnt[32 + tid_] = c ? atomicAdd(cnt + tid_, c) : 0u; }
    __syncthreads();
    if (tid_ < 16) {
        int* EX = (int*)(ws + OFF_EXPID); int* RK = (int*)(ws + OFF_RANK);
        for (int tk = blockIdx.x; tk < ntask; tk += gridDim.x) {
            if (skip(tk)) continue;
            const int R = tk * 16 + tid_;
            RK[R * 2] += (int)lcnt[32 + EX[R * 2]]; RK[R * 2 + 1] += (int)lcnt[32 + EX[R * 2 + 1]];
        }
    }
}

__device__ __forceinline__ void moe_table(KP p, int layer, LAS int* tab) {
    if (tid_fresh() == 0) {
        const unsigned* cnt = (const unsigned*)(p.ws + OFF_CNT) + layer * 32; int s = 0, tl = 0;
        for (int e = 0; e < 32; ++e) { const int c = (int)__hip_atomic_load(cnt + e, __ATOMIC_RELAXED, __HIP_MEMORY_SCOPE_AGENT); tab[e] = c; tab[32 + e] = s; tab[64 + e] = tl; s += c; tl += (c + 255) >> 8; }
        tab[96] = tl;
    }
    __syncthreads();
}
__device__ __forceinline__ void dispatch_phase(KP p, int layer, LAS int* tab) {
    unsigned char* ws = p.ws; const int tid_ = tid_fresh();
    moe_table(p, layer, tab);
    const int* EX = (const int*)(ws + OFF_EXPID); const float* GW = (const float*)(ws + OFF_GATEW); const int* RK = (const int*)(ws + OFF_RANK);
    int* TOKSL = (int*)(ws + OFF_TOKSL); float* SLOTW = (float*)(ws + OFF_SLOTW); int* SLOTTOK = (int*)(ws + OFF_SLOTTOK);
    for (int idx = blockIdx.x * 512 + tid_; idx < TALL * 2; idx += gridDim.x * 512) {
        const int R = idx >> 1;
        if (layer == 1 && (R % TB) < NCTX) continue;
        const int slot = tab[32 + EX[idx]] + RK[idx];
        TOKSL[idx] = slot; SLOTW[slot] = GW[idx]; SLOTTOK[slot] = R;
    }
}
__device__ __forceinline__ void moe_unit_table(const LAS int* tab, LAS int* uinf, int npn) {
    const int tid_ = tid_fresh();
    const int ntile = tab[96];
    if (tid_ < 22) {
        const int L = tid_ * (int)gridDim.x + (int)blockIdx.x; int s0 = -1, vl = 0, e = 0;
        if (L < ntile * npn) { const int tg = L / npn;
#pragma unroll 1
            for (int j = 1; j < 32; ++j) e = (tab[64 + j] <= tg) ? j : e;
            const int mt = tg - tab[64 + e]; s0 = tab[32 + e] + 256 * mt; vl = tab[e] - 256 * mt; }
        uinf[4 * tid_] = s0; uinf[4 * tid_ + 1] = vl; uinf[4 * tid_ + 2] = e; uinf[4 * tid_ + 3] = 0;
    }
    __syncthreads();
}
__device__ __forceinline__ void moe_tok_table(KP p, const LAS int* tab, LAS int* tok) {
    const int tid_ = tid_fresh(); const int* SLOTTOK = (const int*)(p.ws + OFF_SLOTTOK);
    LAS int* uinf = tok + 22 * 256;
    moe_unit_table(tab, uinf, 8);
    int tv[11];
#pragma unroll
    for (int k = 0; k < 11; ++k) { const int j = tid_ + 512 * k; const int i = j >> 8, r = j & 255; const int s0 = uinf[4 * i], vl = uinf[4 * i + 1];
        tv[k] = SLOTTOK[s0 >= 0 ? s0 + (r < vl ? r : 0) : 0]; }
#pragma unroll
    for (int k = 0; k < 11; ++k) { const int j = tid_ + 512 * k; if (uinf[4 * (j >> 8)] >= 0) tok[j] = tv[k]; }
    __syncthreads();
}

__device__ __forceinline__ void gate_phase(KP p, int layer, int g, LAS unsigned char* lds) {
    unsigned char* reg = p.ws + OFF_REG; const int tid = tid_fresh();
    const bf16_t* GQK = (const bf16_t*)(reg + R_GQK); bf16_t* GIN = (bf16_t*)(reg + R_GIN); float* GDEC = (float*)(reg + R_GDEC); const float* GLR = (const float*)(reg + R_GLR);
    LAS float* lr = (LAS float*)lds;
    const float* wa = p.in[9] + (size_t)layer * 2 * 16 * 512; const float* ba = p.in[10] + layer * 2 * 512;
    for (int u = blockIdx.x; u < BG * NCH * 2; u += gridDim.x) {
        const int dir = u & 1, rest = u >> 1, bl = rest / NCH, ch = rest - bl * NCH; const int r0 = bl * TB + ch * CH;
        float w[16];
#pragma unroll
        for (int r = 0; r < 16; ++r) w[r] = wa[(dir * 16 + r) * 512 + tid] * LOG2E;
        const float bav = ba[dir * 512 + tid] * LOG2E;
        __syncthreads();
        for (int e = tid; e < 64 * 16; e += 512) lr[e] = GLR[(size_t)(r0 + (e >> 4)) * 32 + dir * 16 + (e & 15)];
        __syncthreads();
        bf16_t* GO = GIN + (size_t)dir * TG * 1024;
        float cum = 0.f;
#pragma unroll 1
        for (int hh = 0; hh < 2; ++hh) {
            unsigned short qv[32], kv[32];
#pragma unroll
            for (int s2 = 0; s2 < 32; ++s2) { const int st = hh * 32 + s2; const int j = dir ? CH - 1 - st : st; const size_t ro = (size_t)(r0 + j) * 1024; qv[s2] = GQK[ro + tid]; kv[s2] = GQK[ro + 512 + tid]; }
#pragma unroll
            for (int s2 = 0; s2 < 32; ++s2) {
                const int st = hh * 32 + s2; const int j = dir ? CH - 1 - st : st;
                const LAS f32x4* l4 = (const LAS f32x4*)(lr + j * 16);
                const f32x4 a0 = l4[0], a1 = l4[1], a2 = l4[2], a3 = l4[3];
                float z = bav;
                z += a0[0] * w[0] + a0[1] * w[1] + a0[2] * w[2] + a0[3] * w[3] + a1[0] * w[4] + a1[1] * w[5] + a1[2] * w[6] + a1[3] * w[7]
                   + a2[0] * w[8] + a2[1] * w[9] + a2[2] * w[10] + a2[3] * w[11] + a3[0] * w[12] + a3[1] * w[13] + a3[2] * w[14] + a3[3] * w[15];
                const float la = -(fmaxf(-z, 0.f) + __builtin_amdgcn_logf(1.0f + __builtin_amdgcn_exp2f(-fabsf(z)))) * (1.0f / 16.0f);
                cum += la; const float e = __builtin_amdgcn_exp2f(cum), ei = __builtin_amdgcn_exp2f(-cum);
                const size_t ro = (size_t)(r0 + j) * 1024;
                GO[ro + tid] = f2bf(bf2f(qv[s2]) * e); GO[ro + 512 + tid] = f2bf(bf2f(kv[s2]) * ei);
            }
        }
        GDEC[((size_t)(dir * BG + bl) * NCH + ch) * 512 + tid] = __builtin_amdgcn_exp2f(cum);
    }
}
__device__ __forceinline__ void stats_phase(KP p, int g, bool dry) {
    unsigned char* reg = p.ws + OFF_REG; const int tid_ = tid_fresh(); const int lane = tid_ & 63, wid = tid_ >> 6;
    f32x2* ST = (f32x2*)(p.ws + OFF_STATS);
    const int stride = gridDim.x * 8;
    for (int R0 = blockIdx.x * 8 + wid; R0 < TG; R0 += 2 * stride) {
        const int R1 = R0 + stride; const bool two = R1 < TG; const int R1c = two ? R1 : R0;
        u32x2 av[2][2][4], bv[2][2][4];
#pragma unroll
        for (int rr = 0; rr < 2; ++rr)
#pragma unroll
            for (int mix = 0; mix < 2; ++mix) {
                const bf16_t* of = (const bf16_t*)(reg + (mix ? R_ORF : R_OGF)) + (size_t)(rr ? R1c : R0) * 1024; const bf16_t* ob = (const bf16_t*)(reg + (mix ? R_ORB : R_OGB)) + (size_t)(rr ? R1c : R0) * 1024;
#pragma unroll
                for (int i = 0; i < 4; ++i) { av[rr][mix][i] = *(const u32x2*)(of + 256 * i + 4 * lane); bv[rr][mix][i] = *(const u32x2*)(ob + 256 * i + 4 * lane); }
            }
#pragma unroll
        for (int rr = 0; rr < 2; ++rr) {
            if (rr == 1 && !two) break;
            const int R = rr ? R1 : R0;
#pragma unroll
            for (int mix = 0; mix < 2; ++mix) {
                bf16_t* of = (bf16_t*)(reg + (mix ? R_ORF : R_OGF)) + (size_t)R * 1024;
#pragma unroll
                for (int i = 0; i < 4; ++i) {
                    const int c = 256 * i + 4 * lane; const u32x2 a = av[rr][mix][i], b2 = bv[rr][mix][i];
                    const float o0 = bflo(a.x) + bflo(b2.x), o1 = bfhi(a.x) + bfhi(b2.x), o2 = bflo(a.y) + bflo(b2.y), o3 = bfhi(a.y) + bfhi(b2.y);
                    const float mean = wave_sum(o0 + o1 + o2 + o3, lane) * (1.0f / 256.0f);
                    const float d0 = o0 - mean, d1 = o1 - mean, d2 = o2 - mean, d3 = o3 - mean;
                    const float var = wave_sum(d0 * d0 + d1 * d1 + d2 * d2 + d3 * d3, lane) * (1.0f / 256.0f);
                    u32x2 w; w.x = cvt_pk_bf16(o0, o1); w.y = cvt_pk_bf16(o2, o3); if (!dry) *(u32x2*)(of + c) = w;
                    if (lane == 0) ST[((size_t)mix * TG + R) * 4 + i] = (f32x2){mean, rsqrtf(var + 1e-6f)};
                }
            }
        }
    }
}

#if 1
__device__ __forceinline__ void scan_naive(KP p, int layer, int g, LAS unsigned char* lds) {
    unsigned char* reg = p.ws + OFF_REG; const int tid = tid_fresh(), sub = tid >> 8, e = tid & 255;
    LAS float* sh = (LAS float*)lds + sub * 512;
    for (int u = blockIdx.x; u < 32; u += gridDim.x) {
        const int chain = u * 2 + sub; const int dir = chain & 1, h = (chain >> 1) & 3, bl = (chain >> 3) & 3, mix = chain >> 5;
        if (!SCAN_E1 && ((SCAN_MASK >> (mix * 2 + dir)) & 1)) continue;
        const bf16_t* QK = (const bf16_t*)(reg + (mix ? R_RQK : R_GQK)); const bf16_t* VT = (const bf16_t*)(reg + (mix ? R_RVT : R_GVT));
        bf16_t* O = (bf16_t*)(reg + (mix ? (dir ? R_ORB : R_ORF) : (dir ? R_OGB : R_OGF)));
        const float* GLR = (const float*)(reg + R_GLR);
        float wa[16]; float bav = 0.f;
        if (e < 128) {
#pragma unroll
            for (int r = 0; r < 16; ++r) wa[r] = p.in[9][(((size_t)layer * 2 + dir) * 16 + r) * 512 + h * 128 + e];
            bav = p.in[10][((size_t)layer * 2 + dir) * 512 + h * 128 + e];
        }
        const float gam = 1.0f - exp2f(-5.0f - (float)h);
        float S[128];
#pragma unroll
        for (int d = 0; d < 128; ++d) S[d] = 0.f;
        const bf16_t* vrow = VT + ((size_t)bl * 1024 + h * 256 + e) * TB;
        for (int s = 0; s < TB; ++s) {
            const int t = dir == 0 ? s : (s < NCTX ? NCTX - 1 - s : TB - 1 - (s - NCTX));
            const size_t ro = (size_t)(bl * TB + t);
            __syncthreads();
            if (e < 128) {
                sh[e] = bf2f(QK[ro * 1024 + h * 128 + e]); sh[128 + e] = bf2f(QK[ro * 1024 + 512 + h * 128 + e]);
                float a;
                if (mix == 0) { float z = bav;
#pragma unroll
                    for (int r = 0; r < 16; ++r) z += GLR[ro * 32 + dir * 16 + r] * wa[r];
                    a = expf(-(fmaxf(-z, 0.f) + log1pf(expf(-fabsf(z)))) * (1.0f / 16.0f)); }
                else a = gam;
                sh[256 + e] = a;
            }
            __syncthreads();
            const float v = bf2f(vrow[t]);
            float o = 0.f;
            if (dir == 0) {
#pragma unroll
                for (int d = 0; d < 128; ++d) { S[d] = sh[256 + d] * S[d] + sh[128 + d] * v; o += sh[d] * S[d]; }
            } else {
#pragma unroll
                for (int d = 0; d < 128; ++d) { const float sd = sh[256 + d] * S[d]; o += sh[d] * sd; S[d] = sd + sh[128 + d] * v; }
            }
            O[ro * 1024 + h * 256 + e] = f2bf(o);
        }
    }
}
#endif


#if 1
constexpr int SC_QS = 272, SC_VS = 144;
constexpr int SC_QB = 0, SC_KB = SC_QB + 2 * 64 * SC_QS, SC_VB = SC_KB + 2 * 64 * SC_QS, SC_ST = SC_VB + 2 * 64 * SC_VS,
              SC_DEC = SC_ST + 2 * 64 * SC_QS, SC_SCL = SC_DEC + 2 * 128 * 4, SC_END = SC_SCL + 128 * 4, SC_PB = 132096, SC_OB = SC_PB + 64 * SC_VS;
static_assert(SC_OB + 64 * SC_VS <= LDS_BYTES, "scan LDS tail");
static_assert(SC_END <= 131072, "scan LDS");
__device__ __forceinline__ u32x4 scale8(u32x4 v, float s) {
    u32x4 r; r.x = cvt_pk_bf16(bflo(v.x) * s, bfhi(v.x) * s); r.y = cvt_pk_bf16(bflo(v.y) * s, bfhi(v.y) * s); r.z = cvt_pk_bf16(bflo(v.z) * s, bfhi(v.z) * s); r.w = cvt_pk_bf16(bflo(v.w) * s, bfhi(v.w) * s); return r;
}
__device__ __forceinline__ void scan_mfma(KP p, int layer, int g, LAS unsigned char* lds, bool cmp_mode) {
    unsigned char* reg = p.ws + OFF_REG; const int tid = tid_fresh(), wid = tid >> 6, lane = tid & 63, fr = lane & 15, fq = lane >> 4;
#if SCAN_DELAY
    { const long long t0_ = clock64(); while (clock64() - t0_ < 4000000ll) __builtin_amdgcn_s_sleep(8); }
#endif
    for (int u = blockIdx.x; u < 256; u += gridDim.x) {
        const int dvq = (u >> 3) & 3, chain = (u & 7) + 8 * (u >> 5); const int dir = chain & 1, h = (chain >> 1) & 3, bl = (chain >> 3) & 3, mix = chain >> 5;
        if (!((SCAN_MASK >> (mix * 2 + dir)) & 1)) continue;
        const bf16_t* QI; const bf16_t* KI;
        if (mix == 0) { QI = (const bf16_t*)(reg + R_GIN) + (size_t)dir * TG * 1024; KI = QI + 512; } else { QI = (const bf16_t*)(reg + R_RQK); KI = QI + 512; }
        const bf16_t* VT = (const bf16_t*)(reg + (mix ? R_RVT : R_GVT)) + ((size_t)bl * 1024 + h * 256 + dvq * 64) * TB;
        bf16_t* O = (bf16_t*)(reg + (mix ? (dir ? R_ORB : R_ORF) : (dir ? R_OGB : R_OGF)));
        const float* GDEC = (const float*)(reg + R_GDEC) + ((size_t)(dir * BG + bl) * NCH) * 512 + h * 128;
        const float lam = logf(1.0f - exp2f(-5.0f - (float)h));
        __syncthreads();
        for (int e = tid; e < 2 * 64 * SC_QS / 16; e += 512) *(LAS u32x4*)(lds + SC_ST + e * 16) = (u32x4){0u, 0u, 0u, 0u};
        __syncthreads();
        const bool po = wid < 4; const int wq = wid & 3, t2_ = tid & 255;
        const int jb2 = 2 * (wq & 1), ib2 = 2 * (wq >> 1);
        const int db2 = 2 * wq;
        f32x4 R[8];
#pragma unroll
        for (int x = 0; x < 8; ++x) R[x] = (f32x4){0.f, 0.f, 0.f, 0.f};
        const int qrow0 = t2_ >> 4, qc8 = t2_ & 15;
        const int ve = t2_ >> 3, vj8 = t2_ & 7;
        u32x4 rq[4], rk[4], rv[2]; float rdec = 0.f;
        const float rdecay = expf(64.0f * lam);
        auto chunk_of = [&](int s) { return dir == 0 ? s : (s < 4 ? 3 - s : 131 - (s - 4)); };
        auto gload = [&](int ch) {
            const size_t r0 = (size_t)bl * TB + (size_t)ch * CH;
#pragma unroll
            for (int x = 0; x < 4; ++x) { const size_t ro = (r0 + qrow0 + 16 * x) * 1024 + h * 128 + qc8 * 8; rq[x] = *(const u32x4*)(QI + ro); rk[x] = *(const u32x4*)(KI + ro); }
#pragma unroll
            for (int x = 0; x < 2; ++x) rv[x] = *(const u32x4*)(VT + (size_t)(ve + 32 * x) * TB + ch * CH + vj8 * 8);
            const float gd = GDEC[(size_t)ch * 512 + (t2_ & 127)];
            rdec = mix ? rdecay : gd;
        };
        const float vs0 = mix ? expf(-(dir == 0 ? (float)(vj8 * 8 + 1) : (float)(64 - vj8 * 8)) * lam) : 1.0f;
        const float rr = mix ? expf(dir == 0 ? -lam : lam) : 1.0f; const float vs1 = vs0 * rr, rr2 = rr * rr;
        auto lstore = [&](int buf) {
#pragma unroll
            for (int x = 0; x < 4; ++x) {
                *(LAS u32x4*)(lds + SC_QB + buf * 64 * SC_QS + (qrow0 + 16 * x) * SC_QS + qc8 * 16) = rq[x];
                *(LAS u32x4*)(lds + SC_KB + buf * 64 * SC_QS + (qrow0 + 16 * x) * SC_QS + qc8 * 16) = rk[x]; }
#pragma unroll
            for (int x = 0; x < 2; ++x) { const u32x4 r = rv[x];
                float fa = vs0, fb = vs1; u32x4 v2; v2.x = cvt_pk_bf16(bflo(r.x) * fa, bfhi(r.x) * fb); fa *= rr2; fb *= rr2; v2.y = cvt_pk_bf16(bflo(r.y) * fa, bfhi(r.y) * fb); fa *= rr2; fb *= rr2;
                v2.z = cvt_pk_bf16(bflo(r.z) * fa, bfhi(r.z) * fb); fa *= rr2; fb *= rr2; v2.w = cvt_pk_bf16(bflo(r.w) * fa, bfhi(r.w) * fb);
                *(LAS u32x4*)(lds + SC_VB + buf * 64 * SC_VS + (ve + 32 * x) * SC_VS + vj8 * 16) = v2; }
            if (t2_ < 128) ((LAS float*)(lds + SC_DEC))[buf * 128 + t2_] = rdec;
        };
        if (!po) { gload(chunk_of(0)); lstore(0); gload(chunk_of(1)); }
        __syncthreads();
        float fo[2];
#pragma unroll
        for (int x = 0; x < 2; ++x) { const int i = 16 * (ib2 + x) + fr; fo[x] = mix ? expf((dir == 0 ? (float)(i + 1) : (float)(64 - i)) * lam) : 1.0f; }
        auto ostore = [&](int chp, int ob) {
            const size_t r0 = (size_t)bl * TB + (size_t)chp * CH;
#pragma unroll
            for (int k = 0; k < 2; ++k) { const int i = 32 * k + (t2_ >> 3);
                const u32x4 v = *(const LAS u32x4*)(lds + SC_PB + ob * 64 * SC_VS + i * SC_VS + (t2_ & 7) * 16);
                *(u32x4*)(O + (r0 + i) * 1024 + h * 256 + dvq * 64 + (t2_ & 7) * 8) = v; }
        };
        const int ebp = 2 * (wq & 1);
        for (int s = 0; s < NCH; ++s) {
            const int cur = s & 1, stb = s & 1;
            const LAS unsigned char* Qc = lds + SC_QB + cur * 64 * SC_QS; const LAS unsigned char* Kc = lds + SC_KB + cur * 64 * SC_QS; const LAS unsigned char* Vc = lds + SC_VB + cur * 64 * SC_VS;
            if (po) {
#pragma unroll
                for (int x = 0; x < 2; ++x)
#pragma unroll
                    for (int ks = 0; ks < 4; ++ks) R[4 * x + ks] = __builtin_bit_cast(f32x4, *(const LAS bf16x8*)(Qc + (16 * (ib2 + x) + fr) * SC_QS + ks * 64 + fq * 16));
                bf16x8 pb[2][2];
#pragma unroll
                for (int s2 = 0; s2 < 2; ++s2) {
                    bf16x8 kfr[2][4];
#pragma unroll
                    for (int y = 0; y < 2; ++y)
#pragma unroll
                        for (int ks = 0; ks < 4; ++ks) kfr[y][ks] = *(const LAS bf16x8*)(Kc + (16 * (2 * s2 + y) + fr) * SC_QS + ks * 64 + fq * 16);
                    __builtin_amdgcn_sched_barrier(0);
                    f32x4 c[2][2];
#pragma unroll
                    for (int y = 0; y < 2; ++y)
#pragma unroll
                        for (int x = 0; x < 2; ++x) c[y][x] = (f32x4){0.f, 0.f, 0.f, 0.f};
#pragma unroll
                    for (int ks = 0; ks < 4; ++ks)
#pragma unroll
                        for (int y = 0; y < 2; ++y)
#pragma unroll
                            for (int x = 0; x < 2; ++x) c[y][x] = __builtin_amdgcn_mfma_f32_16x16x32_bf16(kfr[y][ks], __builtin_bit_cast(bf16x8, R[4 * x + ks]), c[y][x], 0, 0, 0);
#pragma unroll
                    for (int x = 0; x < 2; ++x) { const int i = 16 * (ib2 + x) + fr; u32x4 w4;
#pragma unroll
                        for (int y = 0; y < 2; ++y) { const int j0 = 16 * (2 * s2 + y) + 4 * fq; float v[4];
#pragma unroll
                            for (int jj = 0; jj < 4; ++jj) { const int j = j0 + jj; const bool keep = dir == 0 ? (j <= i) : (j > i); v[jj] = keep ? c[y][x][jj] : 0.f; }
                            if (y == 0) { w4.x = cvt_pk_bf16(v[0], v[1]); w4.y = cvt_pk_bf16(v[2], v[3]); } else { w4.z = cvt_pk_bf16(v[0], v[1]); w4.w = cvt_pk_bf16(v[2], v[3]); } }
                        pb[x][s2] = __builtin_bit_cast(bf16x8, w4); }
                }
                bf16x8 va[2][2], st[2][4];
#pragma unroll
                for (int y = 0; y < 2; ++y)
#pragma unroll
                    for (int s2 = 0; s2 < 2; ++s2) {
                        const u32x2 lo = *(const LAS u32x2*)(Vc + (16 * (ebp + y) + fr) * SC_VS + (32 * s2 + 4 * fq) * 2), hi = *(const LAS u32x2*)(Vc + (16 * (ebp + y) + fr) * SC_VS + (32 * s2 + 16 + 4 * fq) * 2);
                        va[y][s2] = __builtin_bit_cast(bf16x8, (u32x4){lo.x, lo.y, hi.x, hi.y}); }
#pragma unroll
                for (int y = 0; y < 2; ++y)
#pragma unroll
                    for (int ks = 0; ks < 4; ++ks) st[y][ks] = *(const LAS bf16x8*)(lds + SC_ST + stb * 64 * SC_QS + (16 * (ebp + y) + fr) * SC_QS + ks * 64 + fq * 16);
                __builtin_amdgcn_sched_barrier(0);
                f32x4 co[2][2];
#pragma unroll
                for (int y = 0; y < 2; ++y)
#pragma unroll
                    for (int x = 0; x < 2; ++x) co[y][x] = (f32x4){0.f, 0.f, 0.f, 0.f};
#pragma unroll
                for (int ks = 0; ks < 4; ++ks)
#pragma unroll
                    for (int y = 0; y < 2; ++y)
#pragma unroll
                        for (int x = 0; x < 2; ++x) co[y][x] = __builtin_amdgcn_mfma_f32_16x16x32_bf16(st[y][ks], __builtin_bit_cast(bf16x8, R[4 * x + ks]), co[y][x], 0, 0, 0);
#pragma unroll
                for (int s2 = 0; s2 < 2; ++s2)
#pragma unroll
                    for (int y = 0; y < 2; ++y)
#pragma unroll
                        for (int x = 0; x < 2; ++x) co[y][x] = __builtin_amdgcn_mfma_f32_16x16x32_bf16(va[y][s2], pb[x][s2], co[y][x], 0, 0, 0);
#pragma unroll
                for (int y = 0; y < 2; ++y)
#pragma unroll
                    for (int x = 0; x < 2; ++x) { const f32x4 cc = co[y][x] * fo[x]; const int i = 16 * (ib2 + x) + fr;
                        u32x2 w; w.x = cvt_pk_bf16(cc[0], cc[1]); w.y = cvt_pk_bf16(cc[2], cc[3]);
                        *(LAS u32x2*)(lds + SC_PB + (s & 1) * 64 * SC_VS + i * SC_VS + (16 * (ebp + y) + 4 * fq) * 2) = w; }
            } else {
                if (s > 0) ostore(chunk_of(s - 1), (s - 1) & 1);
                bf16x8 ka[2][2], vb[2][4];
#pragma unroll
                for (int x = 0; x < 2; ++x)
#pragma unroll
                    for (int ks = 0; ks < 2; ++ks) {
                        typedef short s16x4_t __attribute__((ext_vector_type(4)));
                        const LAS unsigned char* tp = Kc + (32 * ks + 8 * fq + (fr >> 2)) * SC_QS + (16 * (db2 + x) + 4 * (fr & 3)) * 2;
                        const s16x4_t t0 = __builtin_amdgcn_ds_read_tr16_b64_v4i16((LAS s16x4_t*)tp), t1 = __builtin_amdgcn_ds_read_tr16_b64_v4i16((LAS s16x4_t*)(tp + 4 * SC_QS));
                        ka[x][ks] = (bf16x8){t0[0], t0[1], t0[2], t0[3], t1[0], t1[1], t1[2], t1[3]};
                    }
#pragma unroll
                for (int ks = 0; ks < 2; ++ks)
#pragma unroll
                    for (int eb = 0; eb < 4; ++eb) vb[ks][eb] = *(const LAS bf16x8*)(Vc + (16 * eb + fr) * SC_VS + ks * 64 + fq * 16);
                f32x4 dv[2];
#pragma unroll
                for (int x = 0; x < 2; ++x) dv[x] = *(const LAS f32x4*)(lds + SC_DEC + (cur * 128 + 16 * (db2 + x) + 4 * fq) * 4);
                __builtin_amdgcn_sched_barrier(0);
#pragma unroll
                for (int ks = 0; ks < 2; ++ks)
#pragma unroll
                    for (int x = 0; x < 2; ++x)
#pragma unroll
                        for (int eb = 0; eb < 4; ++eb) R[4 * x + eb] = __builtin_amdgcn_mfma_f32_16x16x32_bf16(ka[x][ks], vb[ks][eb], R[4 * x + eb], 0, 0, 0);
#pragma unroll
                for (int x = 0; x < 2; ++x)
#pragma unroll
                    for (int eb = 0; eb < 4; ++eb) { const f32x4 sv = R[4 * x + eb] * dv[x]; R[4 * x + eb] = sv;
                        u32x2 w; w.x = cvt_pk_bf16(sv[0], sv[1]); w.y = cvt_pk_bf16(sv[2], sv[3]);
                        *(LAS u32x2*)(lds + SC_ST + (stb ^ 1) * 64 * SC_QS + (16 * eb + fr) * SC_QS + (16 * (db2 + x) + 4 * fq) * 2) = w; }
                lstore(cur ^ 1);
                gload(chunk_of(s + 2 < NCH ? s + 2 : NCH - 1));
            }
            __syncthreads();
        }
        if (!po) ostore(chunk_of(NCH - 1), (NCH - 1) & 1);
    }
}
#endif

#if NAIVE_ATTN
__device__ __forceinline__ void attn_naive(KP p, int layer, int g, LAS unsigned char* lds) {
    unsigned char* reg = p.ws + OFF_REG; const int tid_ = tid_fresh(); const int lane = tid_ & 63, wid = tid_ >> 6;
    bf16_t* AQ = (bf16_t*)(reg + R_AQ); const bf16_t* AK = (const bf16_t*)(reg + R_AK); const bf16_t* AVT = (const bf16_t*)(reg + R_AVT);
    LAS float* qs = (LAS float*)lds + wid * 1024; LAS float* ps = qs + 128;
    for (int u = blockIdx.x; u < TG / 64; u += gridDim.x) {
#pragma unroll 1
        for (int pr = wid; pr < 512; pr += 8) {
            const int R = u * 64 + (pr >> 3), hq = pr & 7, hkv = hq >> 2; const int bl = R / TB, t = R - bl * TB;
            { const unsigned w = *(const unsigned*)(AQ + (size_t)R * 1024 + hq * 128 + 2 * lane); qs[2 * lane] = bflo(w); qs[2 * lane + 1] = bfhi(w); }
            const bool lat = t >= NCTX; const int i = t - NCTX;
            const int jlo = lat ? (i - 128 < 0 ? 0 : i - 128) : 0, jhi = lat ? (i + 128 > LSEQ - 1 ? LSEQ - 1 : i + 128) : -1;
            const float sink2 = p.in[12][layer * 8 + hq] * LOG2E;
            float mx = sink2;
#pragma unroll 1
            for (int rd = 0; rd < 9; ++rd) {
                int key; bool valid;
                if (rd < 4) { key = rd * 64 + lane; valid = true; } else { const int j = jlo + (rd - 4) * 64 + lane; key = NCTX + j; valid = j <= jhi; }
                float s = -3.0e38f;
                if (valid) { const bf16_t* kr = AK + (size_t)(bl * TB + key) * 256 + hkv * 128; s = 0.f;
#pragma unroll 4
                    for (int d8 = 0; d8 < 16; ++d8) { const u32x4 kv = *(const u32x4*)(kr + d8 * 8); const LAS float* q = qs + d8 * 8;
                        s += q[0] * bflo(kv.x) + q[1] * bfhi(kv.x) + q[2] * bflo(kv.y) + q[3] * bfhi(kv.y) + q[4] * bflo(kv.z) + q[5] * bfhi(kv.z) + q[6] * bflo(kv.w) + q[7] * bfhi(kv.w); } }
                ps[rd * 64 + lane] = s; mx = fmaxf(mx, s);
            }
            mx = wave_max(mx, lane);
            float sum = 0.f;
#pragma unroll 1
            for (int rd = 0; rd < 9; ++rd) { const float sv = ps[rd * 64 + lane]; const float pv = sv > -1.0e38f ? exp2f(sv - mx) : 0.f; ps[rd * 64 + lane] = pv; sum += pv; }
            sum = wave_sum(sum, lane) + exp2f(sink2 - mx);
            const float inv = 1.0f / sum;
            float o0 = 0.f, o1 = 0.f;
            const bf16_t* v0 = AVT + ((size_t)bl * 256 + hkv * 128 + 2 * lane) * TB; const bf16_t* v1 = v0 + TB;
#pragma unroll 4
            for (int k = 0; k < NCTX; ++k) { const float pv = ps[k]; o0 += pv * bf2f(v0[k]); o1 += pv * bf2f(v1[k]); }
#pragma unroll 4
            for (int j = jlo; j <= jhi; ++j) { const float pv = ps[256 + (j - jlo)]; o0 += pv * bf2f(v0[NCTX + j]); o1 += pv * bf2f(v1[NCTX + j]); }
            *(unsigned*)(AQ + (size_t)R * 1024 + hq * 128 + 2 * lane) = cvt_pk_bf16(o0 * inv, o1 * inv);
        }
    }
}
#endif


#if !NAIVE_ATTN
constexpr int AT_KS = 272, AT_VS = 144;
constexpr int AT_KB = 0, AT_VB = AT_KB + 2 * 64 * AT_KS, AT_END = AT_VB + 2 * 128 * AT_VS;
static_assert(AT_END <= 131072, "attn LDS");
__device__ __forceinline__ void attn_mfma(KP p, int layer, int g, LAS unsigned char* lds, bool to_spare) {
    unsigned char* reg = p.ws + OFF_REG; const int tid = tid_fresh(), wid = tid >> 6, lane = tid & 63, fr = lane & 15, fq = lane >> 4;
    bf16_t* AQ = (bf16_t*)(reg + R_AQ); const bf16_t* AK = (const bf16_t*)(reg + R_AK); const bf16_t* AVT = (const bf16_t*)(reg + R_AVT);
    const int nqb = layer == 1 ? NCH - 4 : NCH;
    const int nunits = BG * 2 * nqb;
    for (int it = 0;; ++it) {
        const int u = gridDim.x == 256 ? (it * 8 + (int)(blockIdx.x & 7)) * 32 + (int)(blockIdx.x >> 3) : it * (int)gridDim.x + (int)blockIdx.x;
        if (gridDim.x == 256 ? (it * 256 >= nunits) : (u >= nunits)) break;
        if (u >= nunits) continue;
        const int qblk = u < 1024 ? 4 + (u & 127) : (u & 3), hkv = u < 1024 ? (u >> 7) & 1 : (u >> 2) & 1, bl = u < 1024 ? u >> 8 : (u - 1024) >> 3;
        const int t0 = qblk * 64; const bool isctx = t0 < NCTX;
        const int hq = hkv * 4 + (wid >> 1); const int qoff = (wid & 1) * 32;
        const size_t qrow0 = (size_t)bl * TB + t0 + qoff;
        bf16x8 qf[2][4];
#pragma unroll
        for (int qb = 0; qb < 2; ++qb)
#pragma unroll
            for (int ks = 0; ks < 4; ++ks) qf[qb][ks] = *(const bf16x8*)(AQ + (qrow0 + 16 * qb + fr) * 1024 + hq * 128 + 32 * ks + 8 * fq);
        int mlo = 0, nloc = 0;
        if (!isctx) { mlo = (384 - t0) > 0 ? (384 - t0) / 64 : 0; int mhi = (TB + 64 - t0) / 64; mhi = mhi > 4 ? 4 : mhi; nloc = mhi - mlo + 1; }
        const int ntile = 4 + nloc;
        const float sink2 = p.in[12][layer * 8 + hq] * LOG2E;
        float mrun[2], lrun[2];
        mrun[0] = mrun[1] = sink2; lrun[0] = lrun[1] = (fq == 0) ? 1.0f : 0.0f;
        f32x4 oT[8][2];
#pragma unroll
        for (int db = 0; db < 8; ++db) { oT[db][0] = (f32x4){0.f, 0.f, 0.f, 0.f}; oT[db][1] = oT[db][0]; }
        const int krow = tid >> 4, kc = tid & 15;
        const int vrow = tid >> 3, vc = tid & 7;
        u32x4 rk[2], rv[2];
        auto tile_tok = [&](int ti) { return ti < 4 ? ti * 64 : t0 - 128 + 64 * (mlo + ti - 4); };
        auto gload = [&](int ti) {
            const int k0 = tile_tok(ti);
#pragma unroll
            for (int x = 0; x < 2; ++x) {
                rk[x] = *(const u32x4*)(AK + ((size_t)bl * TB + k0 + krow + 32 * x) * 256 + hkv * 128 + kc * 8);
                rv[x] = *(const u32x4*)(AVT + ((size_t)bl * 256 + hkv * 128 + vrow + 64 * x) * TB + k0 + vc * 8);
            }
        };
        auto lstore = [&](int buf) {
#pragma unroll
            for (int x = 0; x < 2; ++x) {
                *(LAS u32x4*)(lds + AT_KB + buf * 64 * AT_KS + (krow + 32 * x) * AT_KS + kc * 16) = rk[x];
                *(LAS u32x4*)(lds + AT_VB + buf * 128 * AT_VS + (vrow + 64 * x) * AT_VS + vc * 16) = rv[x];
            }
        };
        __syncthreads();
        gload(0); lstore(0);
        __syncthreads();
        for (int ti = 0; ti < ntile; ++ti) {
            const int cur = ti & 1;
            if (ti + 1 < ntile) gload(ti + 1);
            const LAS unsigned char* Kc = lds + AT_KB + cur * 64 * AT_KS; const LAS unsigned char* Vc = lds + AT_VB + cur * 128 * AT_VS;
            f32x4 sT[4][2];
#pragma unroll
            for (int kb = 0; kb < 4; ++kb) { sT[kb][0] = (f32x4){0.f, 0.f, 0.f, 0.f}; sT[kb][1] = sT[kb][0]; }
#pragma unroll
            for (int ks = 0; ks < 4; ++ks)
#pragma unroll
                for (int kb = 0; kb < 4; ++kb) { const bf16x8 a = *(const LAS bf16x8*)(Kc + (16 * kb + fr) * AT_KS + ks * 64 + fq * 16);
                    sT[kb][0] = __builtin_amdgcn_mfma_f32_16x16x32_bf16(a, qf[0][ks], sT[kb][0], 0, 0, 0);
                    sT[kb][1] = __builtin_amdgcn_mfma_f32_16x16x32_bf16(a, qf[1][ks], sT[kb][1], 0, 0, 0);
                    if (kb & 1) __builtin_amdgcn_sched_barrier(0); }
            if (ti >= 4) { const int m = mlo + ti - 4;
                if (m == 0 || m == 4) { const int k0 = tile_tok(ti);
#pragma unroll
                    for (int kb = 0; kb < 4; ++kb)
#pragma unroll
                        for (int qb = 0; qb < 2; ++qb)
#pragma unroll
                            for (int jj = 0; jj < 4; ++jj) { const int dt = (t0 + qoff + 16 * qb + fr) - (k0 + 16 * kb + 4 * fq + jj); if (dt > 128 || dt < -128) sT[kb][qb][jj] = -1.0e30f; } } }
            bf16x8 pb[2][2];
#pragma unroll
            for (int qb = 0; qb < 2; ++qb) {
                float tmax = -1.0e30f;
#pragma unroll
                for (int kb = 0; kb < 4; ++kb) tmax = fmaxf(tmax, fmaxf(fmaxf(sT[kb][qb][0], sT[kb][qb][1]), fmaxf(sT[kb][qb][2], sT[kb][qb][3])));
                tmax = fmaxf(tmax, sx(tmax, 16, lane)); tmax = fmaxf(tmax, sx(tmax, 32, lane));
                if (__any(tmax > mrun[qb] + 8.0f)) {
                    const float mnew_ = fmaxf(mrun[qb], tmax); const float alpha = __builtin_amdgcn_exp2f(mrun[qb] - mnew_); mrun[qb] = mnew_;
                    lrun[qb] = lrun[qb] * alpha;
#pragma unroll
                    for (int db = 0; db < 8; ++db) oT[db][qb] = oT[db][qb] * alpha;
                }
                const float mnew = mrun[qb];
                float psum = 0.f;
#pragma unroll
                for (int kb = 0; kb < 4; ++kb)
#pragma unroll
                    for (int jj = 0; jj < 4; ++jj) { const float pv = __builtin_amdgcn_exp2f(sT[kb][qb][jj] - mnew); psum += pv; sT[kb][qb][jj] = pv; }
                lrun[qb] = lrun[qb] + psum;
#pragma unroll
                for (int s2 = 0; s2 < 2; ++s2) { u32x4 w;
                    w.x = cvt_pk_bf16(sT[2 * s2][qb][0], sT[2 * s2][qb][1]); w.y = cvt_pk_bf16(sT[2 * s2][qb][2], sT[2 * s2][qb][3]);
                    w.z = cvt_pk_bf16(sT[2 * s2 + 1][qb][0], sT[2 * s2 + 1][qb][1]); w.w = cvt_pk_bf16(sT[2 * s2 + 1][qb][2], sT[2 * s2 + 1][qb][3]);
                    pb[qb][s2] = __builtin_bit_cast(bf16x8, w); }
            }
#pragma unroll
            for (int s2 = 0; s2 < 2; ++s2)
#pragma unroll
                for (int db = 0; db < 8; ++db) {
                    const u32x2 lo = *(const LAS u32x2*)(Vc + (16 * db + fr) * AT_VS + (32 * s2 + 4 * fq) * 2), hi = *(const LAS u32x2*)(Vc + (16 * db + fr) * AT_VS + (32 * s2 + 16 + 4 * fq) * 2);
                    const bf16x8 a = __builtin_bit_cast(bf16x8, (u32x4){lo.x, lo.y, hi.x, hi.y});
                    oT[db][0] = __builtin_amdgcn_mfma_f32_16x16x32_bf16(a, pb[0][s2], oT[db][0], 0, 0, 0);
                    oT[db][1] = __builtin_amdgcn_mfma_f32_16x16x32_bf16(a, pb[1][s2], oT[db][1], 0, 0, 0);
                    if (db & 1) __builtin_amdgcn_sched_barrier(0);
                }
            __syncthreads();
            if (ti + 1 < ntile) lstore(cur ^ 1);
            __syncthreads();
        }
#pragma unroll
        for (int qb = 0; qb < 2; ++qb) {
            float l = lrun[qb]; l += sx(l, 16, lane); l += sx(l, 32, lane);
            const float inv = 1.0f / l;
            bf16_t* orow = (to_spare ? (bf16_t*)(p.ws + WS_NEED) : AQ) + (qrow0 + 16 * qb + fr) * 1024 + hq * 128 + 4 * fq;
#pragma unroll
            for (int db = 0; db < 8; ++db) { const f32x4 v = oT[db][qb] * inv; u32x2 w; w.x = cvt_pk_bf16(v[0], v[1]); w.y = cvt_pk_bf16(v[2], v[3]); *(u32x2*)(orow + 16 * db) = w; }
        }
    }
}
#endif

__global__ void __launch_bounds__(512, 2) mega(Params pv) {
    extern __shared__ __attribute__((aligned(16))) unsigned char smem_raw[];
    LAS unsigned char* lds = (LAS unsigned char*)smem_raw;
    LAS unsigned* xbw = (LAS unsigned*)(lds + 131072);
    LAS int* tab = (LAS int*)(lds + 131072 + 256);
#if LDS_POISON
    for (int e = threadIdx.x; e < LDS_BYTES / 4; e += 512) ((LAS unsigned*)lds)[e] = 0x447A447Au;
    __syncthreads();
#endif
    if (threadIdx.x == 0) { xbw[0] = 0u; xbw[1] = 0u; xbw[2] = 0u; xbw[3] = 0u; }
    __syncthreads();
    KPS* kp = (KPS*)__builtin_amdgcn_kernarg_segment_ptr();
    const int ph0 = pv.ph0, ph1 = pv.ph1;
    XcdBarrier bar = xcd_barrier_post((unsigned*)(pv.ws + OFF_BAR), (volatile LAS unsigned*)xbw);
    int ph = 0;
#define PH_RUN(tag, ...) do { if (ph >= ph0 && ph < ph1 && PSEL_OK(tag)) { for (int rep_ = 0; rep_ < (((REP_MASK >> (tag)) & 1) ? REP_N : 1); ++rep_) { KPS* q_ = kp; asm volatile("" : "+s"(q_)); KP p = *q_; __VA_ARGS__ } } \
        if (ph >= ph0 && ph + 1 < ph1) xcd_barrier(bar); ++ph; } while (0)
    PH_RUN(0, prologue1(p, lds););
    PH_RUN(1, prologue2(p););
    for (int layer = 0; layer < 2; ++layer) {
        PH_RUN(2, const bool dry_ = rep_ + 1 < (((REP_MASK >> 2) & 1) ? REP_N : 1); if (layer == 0) norm_phase2<0>(p, 0, dry_); else norm_phase2<1>(p, 1, dry_););
        for (int g = 0; g < NGRP; ++g) {
            PH_RUN(3,
                unsigned char* ws = p.ws; const bf16_t* Hg = (const bf16_t*)(ws + OFF_H) + (size_t)g * TG * 1024; const bf16_t* WIN = (const bf16_t*)(ws + OFF_WINT) + (size_t)layer * WIN_ROWS * 1024;
                SchedDense S{}; S.A = Hg; S.B = WIN; S.lda = 1024; S.K = 1024; S.nM = TG / 256; S.nN = 23; S.nNb = 23; S.qkvswap = true;
                EpiQKV E{ws + OFF_REG, g, (const f32x2*)(ws + OFF_ATAB), (const f32x2*)(ws + OFF_RTAB), rep_ + 1 < (((REP_MASK >> 3) & 1) ? REP_N : 1)};
                g8::gemm_call_cached(lds, S, E););
            PH_RUN(4, gate_phase(p, layer, g, lds););
                        PH_RUN(5, scan_mfma(p, layer, g, lds, false); __syncthreads(); attn_mfma(p, layer, g, lds, false););
            PH_RUN(7, stats_phase(p, g, false););
            PH_RUN(8,
                unsigned char* ws = p.ws; const bf16_t* Hg = (const bf16_t*)(ws + OFF_H) + (size_t)g * TG * 1024; const bf16_t* WIN = (const bf16_t*)(ws + OFF_WINT) + (size_t)layer * WIN_ROWS * 1024;
                SchedDense S{}; S.A = Hg; S.B = WIN + (size_t)5888 * 1024; S.lda = 1024; S.K = 1024; S.nM = layer == 1 ? 128 : TG / 256; S.nN = 8; S.nNb = 8; S.skipctx = layer == 1;
                EpiGateR E{ws + OFF_REG, (const f32x2*)(ws + OFF_STATS), p.in[11] + layer * 1024, p.in[13] + layer * 1024, rep_ + 1 < (((REP_MASK >> 8) & 1) ? REP_N : 1)};
                g8::gemm_call_cached(lds, S, E););
            PH_RUN(9,
                unsigned char* ws = p.ws; unsigned char* reg = ws + OFF_REG;
                const bf16_t* Yb = (const bf16_t*)(reg + R_OGF); const bf16_t* WBb = (const bf16_t*)(ws + OFF_WBRT) + (size_t)layer * 3 * 1024 * 1024; const bf16_t* Hb = (const bf16_t*)(ws + OFF_H) + (size_t)g * TG * 1024;
                const bf16_t* WGb = (const bf16_t*)(ws + OFF_WINT) + (size_t)layer * WIN_ROWS * 1024 + (size_t)7936 * 1024; bf16_t* Zb = (bf16_t*)(reg + (g == 0 ? R_ZG0 : R_GQK));
                { SchedZGc S{Yb, WBb, Hb, WGb, 128, true}; EpiZGc E{Zb}; g8::gemm_call_cached(lds, S, E); }
                if (layer == 0) { SchedZG S{Yb, WBb, Hb, WGb, BG, false, true}; EpiZG E{Zb, false}; g8::gemm_call(lds, S, E); });
        }
        PH_RUN(11,
            unsigned char* ws = p.ws;
            EpiOut E{layer == 0 ? p.in[0] : p.out, layer == 0 ? p.in[2] : (const float*)(ws + OFF_CTXS), p.out, (float*)(ws + OFF_CTXS), (const float*)(ws + OFF_MOD) + (size_t)layer * 9 * 6144, 0, false};
            for (int d_ = 0; d_ < (int)(blockIdx.x & 7); ++d_) __builtin_amdgcn_s_sleep(64);
            if (layer == 0) { SchedOut2 S{(const bf16_t*)(ws + OFF_REG + R_ZG0), (const bf16_t*)(ws + OFF_REG + R_GQK), (const bf16_t*)(ws + OFF_WO3T), false, 3072, true, false}; g8::gemm_call(lds, S, E); }
            { SchedOut2 S{(const bf16_t*)(ws + OFF_REG + R_ZG0), (const bf16_t*)(ws + OFF_REG + R_GQK), (const bf16_t*)(ws + OFF_WO1T) + (size_t)layer * 1024 * 1024, true, 1024, false, layer == 0}; g8::gemm_call(lds, S, E); });
        PH_RUN(13, moe_convert(p, layer, lds); __syncthreads(); norm2_router(p, layer, lds, false););
        PH_RUN(14, dispatch_phase(p, layer, tab););
        PH_RUN(15,
            unsigned char* ws = p.ws;
            moe_table(p, layer, tab);
            LAS int* tok = (LAS int*)(lds + 131072 + 1024);
            moe_tok_table(p, tab, tok);
            SchedMoeG S{(const bf16_t*)(ws + OFF_H), (const bf16_t*)(ws + OFF_REG + M_W13T), tab, tok};
            EpiMoe1 E{(bf16_t*)(ws + OFF_REG + M_HMID)};
            g8::gemm_call(lds, S, E););
        PH_RUN(16,
            unsigned char* ws = p.ws;
            moe_table(p, layer, tab);
            LAS int* uinf2 = (LAS int*)(lds + 131072 + 1024);
            moe_unit_table(tab, uinf2, 4);
            SchedMoe S{(const bf16_t*)(ws + OFF_REG + M_HMID), (const bf16_t*)(ws + OFF_REG + M_W2T), 1024, 1024, 4, 1024, tab, uinf2};
            EpiMoe2 E{(bf16_t*)(ws + OFF_REG + M_XG), (const float*)(ws + OFF_SLOTW)};
            g8::gemm_call(lds, S, E););
    }
    PH_RUN(17, norm_phase2<3>(p, 1, rep_ + 1 < (((REP_MASK >> 17) & 1) ? REP_N : 1)););
#if BAR_PROBE
    if (ph1 - ph0 > 1) for (int i_ = 0; i_ < 100; ++i_) xcd_barrier(bar);
#endif
}
constexpr int N_PHASES = 2 + 2 * (1 + NGRP * 6 + 1 + 4) + 1;

extern "C" void kernel_launch(void* const* d_in, const int* in_sizes, int n_in, void* d_out, int out_size, void* d_ws, size_t ws_size, hipStream_t stream) {
    static int grid = 0;
    if (!grid) {
        int dev = 0, cus = 0, per_cu = 0;
        hipGetDevice(&dev);
        hipDeviceGetAttribute(&cus, hipDeviceAttributeMultiprocessorCount, dev);
        hipFuncSetAttribute((const void*)mega, hipFuncAttributeMaxDynamicSharedMemorySize, LDS_BYTES);
        hipOccupancyMaxActiveBlocksPerMultiprocessor(&per_cu, mega, 512, LDS_BYTES);
        grid = per_cu >= 1 ? cus : 0;
    }
    if (!grid || ws_size < WS_NEED || n_in < 26) { fprintf(stderr, "kernel_launch: cannot run (grid %d, ws %zu need %zu)\n", grid, ws_size, (size_t)WS_NEED); return; }
    hipMemsetAsync(d_ws, 0, ZERO_BYTES, stream);
    Params p{};
    for (int i = 0; i < 26; ++i) p.in[i] = (const float*)d_in[i];
    p.out = (float*)d_out; p.ws = (unsigned char*)d_ws;
#if MK_MULTI
    for (int ph = 0; ph < N_PHASES; ++ph) { p.ph0 = ph; p.ph1 = ph + 1; hipLaunchKernelGGL(mega, dim3(grid), dim3(512), LDS_BYTES, stream, p); }
#else
    p.ph0 = 0; p.ph1 = N_PHASES;
    hipLaunchKernelGGL(mega, dim3(grid), dim3(512), LDS_BYTES, stream, p);
#endif
}
```
